# Optimizing an MI355X kernel written in HIP

```python
import math
import jax, jax.numpy as jnp
from jax import lax
import numpy as np

D_MODEL = 1024
BATCH = 4
SEQ = 4096
DEPTH = 1

N_MEM = 256
EPS = 1e-6
GLA_HEADS = 4
GLA_DK = D_MODEL // (2 * GLA_HEADS)
GLA_DV = D_MODEL // GLA_HEADS
GLA_RANK = 16
GLA_GATE_NORM = 16.0
GLA_CHUNK = 64
DSA_HEADS = 8
DSA_KV_HEADS = 2
DSA_HD = D_MODEL // DSA_HEADS
IDX_HEADS = 8
IDX_DIM = 64
TOPK_MAX = 256
Q_BLOCK = 128
REL_BUCKETS = 32
REL_MAX_DIST = 128
X_HEADS = 4
X_HD = D_MODEL // X_HEADS
N_BRANCH = 3

SPLIT_SIZES = (
    GLA_HEADS * GLA_DK,
    GLA_HEADS * GLA_DK,
    GLA_HEADS * GLA_DV,
    GLA_RANK,
    GLA_HEADS * GLA_DV,
    DSA_HEADS * DSA_HD,
    DSA_KV_HEADS * DSA_HD,
    DSA_KV_HEADS * DSA_HD,
    IDX_HEADS * IDX_DIM,
    IDX_DIM,
    IDX_HEADS,
    DSA_HEADS * DSA_HD,
    X_HEADS * X_HD,
    X_HEADS * X_HD,
    N_BRANCH * D_MODEL,
)
W_IN_COLS = 11352

kernel_name = "hybrid_gla_dsa_memxattn_gated_merge"


def rmsnorm(x, g):
    xf = x.astype(jnp.float32)
    y = xf * lax.rsqrt(jnp.mean(xf * xf, axis=-1, keepdims=True) + EPS)
    return (y * g.astype(jnp.float32)).astype(x.dtype)


def split_cols(u):
    offsets = np.cumsum(np.array(SPLIT_SIZES))[:-1].tolist()
    return jnp.split(u, offsets, axis=-1)


def t5_bucket(dist):
    max_exact = REL_BUCKETS // 2
    d = jnp.maximum(dist, 1).astype(jnp.float32)
    large = max_exact + (jnp.log(d / max_exact) / math.log(REL_MAX_DIST / max_exact)
                         * (REL_BUCKETS - max_exact)).astype(jnp.int32)
    large = jnp.minimum(large, REL_BUCKETS - 1)
    return jnp.where(dist < max_exact, dist, large)


def gla_mixer(q, k, v, a_low, z, w_a_up, b_a, g_head):
    B, L, _ = q.shape
    H, dk, dv, C = GLA_HEADS, GLA_DK, GLA_DV, GLA_CHUNK
    nc = L // C
    q = q.reshape(B, nc, C, H, dk) * (dk ** -0.5)
    k = k.reshape(B, nc, C, H, dk)
    v = v.reshape(B, nc, C, H, dv)
    log_a = jax.nn.log_sigmoid((a_low @ w_a_up + b_a).astype(jnp.float32)) / GLA_GATE_NORM
    b = jnp.cumsum(log_a.reshape(B, nc, C, H, dk), axis=2)
    b_last = b[:, :, -1:]
    q_d = q * jnp.exp(b).astype(q.dtype)
    k_d = k * jnp.exp(-b).astype(k.dtype)
    k_t = k * jnp.exp(b_last - b).astype(k.dtype)
    decay = jnp.exp(b_last[:, :, 0]).astype(q.dtype)
    causal = jnp.tril(jnp.ones((C, C), dtype=bool))
    att = jnp.einsum('bnthd,bnshd->bnhts', q_d, k_d)
    att = jnp.where(causal, att, jnp.zeros_like(att))
    o_intra = jnp.einsum('bnhts,bnshv->bnthv', att, v)

    def step(state, inp):
        qc, kc, vc, dc = inp
        o = jnp.einsum('bthd,bhdv->bthv', qc, state)
        state = dc[..., None] * state + jnp.einsum('bthd,bthv->bhdv', kc, vc)
        return state, o

    s0 = jnp.zeros((B, H, dk, dv), q.dtype)
    xs = (q_d.transpose(1, 0, 2, 3, 4), k_t.transpose(1, 0, 2, 3, 4),
          v.transpose(1, 0, 2, 3, 4), decay.transpose(1, 0, 2, 3))
    _, o_inter = lax.scan(step, s0, xs)
    o = o_intra + o_inter.transpose(1, 0, 2, 3, 4)
    o = rmsnorm(o.reshape(B, L, H, dv), g_head)
    return o.reshape(B, L, H * dv) * jax.nn.silu(z)


def dsa_mixer(q, k, v, iq, ik, iw, z, rel_bias):
    B, L, _ = q.shape
    topk = min(TOPK_MAX, L // 4)
    nb = L // Q_BLOCK
    KV = DSA_KV_HEADS
    G = DSA_HEADS // KV
    q = q.reshape(B, nb, Q_BLOCK, KV, G, DSA_HD) * (DSA_HD ** -0.5)
    k = k.reshape(B, L, KV, DSA_HD)
    v = v.reshape(B, L, KV, DSA_HD)
    iq = iq.reshape(B, nb, Q_BLOCK, IDX_HEADS, IDX_DIM)
    iw = iw.reshape(B, nb, Q_BLOCK, IDX_HEADS) * (IDX_HEADS ** -0.5) * (IDX_DIM ** -0.5)
    ik_f = ik.astype(jnp.float32)
    key_pos = jnp.arange(L, dtype=jnp.int32)

    def block(inp):
        qb, iqb, iwb, start = inp
        q_pos = start + jnp.arange(Q_BLOCK, dtype=jnp.int32)
        s = jax.nn.relu(jnp.einsum('bqhd,bsd->bqhs', iqb.astype(jnp.float32), ik_f))
        score = jnp.einsum('bqhs,bqh->bqs', s, iwb.astype(jnp.float32))
        visible = key_pos[None, :] <= q_pos[:, None]
        score = jnp.where(visible[None], score, -jnp.inf)
        _, idx = lax.top_k(score, topk)
        valid = idx <= q_pos[None, :, None]
        k_sel = jax.vmap(lambda kb, ib: kb[ib])(k, idx)
        v_sel = jax.vmap(lambda vb, ib: vb[ib])(v, idx)
        logits = jnp.einsum('bqcgd,bqncd->bqcgn', qb, k_sel).astype(jnp.float32)
        bucket = t5_bucket(jnp.maximum(q_pos[None, :, None] - idx, 0))
        bias = rel_bias[bucket].reshape(B, Q_BLOCK, topk, KV, G).transpose(0, 1, 3, 4, 2)
        logits = logits + bias.astype(jnp.float32)
        logits = jnp.where(valid[:, :, None, None, :], logits, -1e30)
        p = jax.nn.softmax(logits, axis=-1).astype(v.dtype)
        o = jnp.einsum('bqcgn,bqncd->bqcgd', p, v_sel)
        return o.reshape(B, Q_BLOCK, DSA_HEADS * DSA_HD)

    starts = jnp.arange(nb, dtype=jnp.int32) * Q_BLOCK
    xs = (q.transpose(1, 0, 2, 3, 4, 5), iq.transpose(1, 0, 2, 3, 4),
          iw.transpose(1, 0, 2, 3), starts)
    o = lax.map(block, xs)
    o = o.transpose(1, 0, 2, 3).reshape(B, L, DSA_HEADS * DSA_HD)
    return o * jax.nn.silu(z)


def cross_mixer(q, z, mem_n, w_mem_kv):
    B, L, _ = q.shape
    M = mem_n.shape[1]
    mk, mv = jnp.split(mem_n @ w_mem_kv, 2, axis=-1)
    mk = mk.reshape(B, M, X_HEADS, X_HD)
    mv = mv.reshape(B, M, X_HEADS, X_HD)
    q = q.reshape(B, L, X_HEADS, X_HD) * (X_HD ** -0.5)
    logits = jnp.einsum('bthd,bmhd->bhtm', q, mk).astype(jnp.float32)
    p = jax.nn.softmax(logits, axis=-1).astype(mv.dtype)
    o = jnp.einsum('bhtm,bmhd->bthd', p, mv).reshape(B, L, X_HEADS * X_HD)
    return o * jax.nn.silu(z)


def setup_inputs(seed: int = 0) -> dict:
    key = jax.random.key(seed)
    ks = jax.random.split(key, 16)
    D = D_MODEL

    def w(k, shape, fan_in):
        return jax.random.normal(k, shape, jnp.float32) * (fan_in ** -0.5)

    def gain(k, shape):
        return 1.0 + 0.05 * jax.random.normal(k, shape, jnp.float32)

    return {
        "x": jax.random.normal(ks[0], (BATCH, SEQ, D), jnp.float32),
        "mem": jax.random.normal(ks[1], (BATCH, N_MEM, D), jnp.float32),
        "g_pre": gain(ks[2], (DEPTH, D)),
        "g_post": gain(ks[3], (DEPTH, D)),
        "g_mem": gain(ks[4], (DEPTH, D)),
        "w_in": w(ks[5], (DEPTH, D, W_IN_COLS), D),
        "w_gla_a_up": w(ks[6], (DEPTH, GLA_RANK, GLA_HEADS * GLA_DK), GLA_RANK),
        "b_gla_a": 0.1 * jax.random.normal(ks[7], (DEPTH, GLA_HEADS * GLA_DK), jnp.float32),
        "g_gla": gain(ks[8], (DEPTH, GLA_DV)),
        "rel_bias": 0.5 * jax.random.normal(ks[9], (REL_BUCKETS, DSA_HEADS), jnp.float32),
        "w_mem_kv": w(ks[10], (DEPTH, D, 2 * X_HEADS * X_HD), D),
        "w_gla_out": w(ks[11], (DEPTH, GLA_HEADS * GLA_DV, D), GLA_HEADS * GLA_DV),
        "w_dsa_out": w(ks[12], (DEPTH, DSA_HEADS * DSA_HD, D), DSA_HEADS * DSA_HD),
        "w_x_out": w(ks[13], (DEPTH, X_HEADS * X_HD, D), X_HEADS * X_HD),
        "w_o": w(ks[14], (DEPTH, D, D), D),
    }


def reference(x, mem, g_pre, g_post, g_mem, w_in, w_gla_a_up, b_gla_a, g_gla,
              rel_bias, w_mem_kv, w_gla_out, w_dsa_out, w_x_out, w_o):
    for i in range(DEPTH):
        h = rmsnorm(x, g_pre[i])
        (gq, gk, gv, ga, gz, dq, dk, dv, iq, ik, iw, dz, xq, xz, gates) = split_cols(h @ w_in[i])
        y_gla = gla_mixer(gq, gk, gv, ga, gz, w_gla_a_up[i], b_gla_a[i], g_gla[i])
        y_dsa = dsa_mixer(dq, dk, dv, iq, ik, iw, dz, rel_bias)
        y_mem = cross_mixer(xq, xz, rmsnorm(mem, g_mem[i]), w_mem_kv[i])
        s_gla, s_dsa, s_mem = jnp.split(jax.nn.sigmoid(gates), N_BRANCH, axis=-1)
        merged = (s_gla * (y_gla @ w_gla_out[i]) + s_dsa * (y_dsa @ w_dsa_out[i])
                  + s_mem * (y_mem @ w_x_out[i]))
        x = x + rmsnorm(merged @ w_o[i], g_post[i])
    return x
```

```cpp
#include <hip/hip_runtime.h>
#include <hip/hip_cooperative_groups.h>
#include <cstdio>
#include <cstdint>
namespace cg = cooperative_groups;

#ifndef ONE_LAUNCH
#define ONE_LAUNCH 0
#endif

typedef unsigned short bf16_t;
typedef short bf16x8 __attribute__((ext_vector_type(8)));
typedef float f32x4 __attribute__((ext_vector_type(4)));
typedef unsigned u32x2 __attribute__((ext_vector_type(2)));
typedef unsigned u32x4 __attribute__((ext_vector_type(4)));

constexpr int NBATCH = 4, SEQ = 4096, DM = 1024, MTOK = NBATCH * SEQ;
constexpr int NMEM = 256, MMEM = NBATCH * NMEM;
constexpr int WIN_COLS = 11352;
constexpr float EPS = 1e-6f;
constexpr int NTHREADS = 512, NWAVES = 8;
constexpr int LDU = 6400;
constexpr int C_H = 0, C_GV = 1024, C_DQ = 2048, C_XQ = 3072, C_GQ = 4096, C_GK = 4608, C_DK = 5120, C_DV = 5376, C_IQ = 5632, C_IK = 6144, C_GA = 6208, C_IW = 6224;
constexpr int C_SM = 4096;
constexpr int C_MG = 5120;
constexpr int N1 = 5376;
constexpr int WT_Z = 5376, WT_G = 8448, WT_ROWS = 11520;
constexpr size_t MiB = 1u << 20;
constexpr size_t WS_WTALL = 0, WS_WTMKV = 23 * MiB, WS_WTGO = 27 * MiB, WS_WTDO = 29 * MiB, WS_WTXO = 31 * MiB, WS_WTO = 33 * MiB;
constexpr size_t WS_MEMN = 35 * MiB, WS_MKV = 37 * MiB, WS_U = 44 * MiB, WS_END = 244 * MiB;
static_assert(WS_U + (size_t)MTOK * LDU * 2 == WS_END && WS_END <= 256 * MiB, "ws map");

struct Params {
    const float *x, *mem, *g_pre, *g_post, *g_mem, *w_in, *w_a_up, *b_a, *g_gla, *rel_bias, *w_mem_kv, *w_gla_out, *w_dsa_out, *w_x_out, *w_o;
    float* out; unsigned char* ws;
};

__device__ const unsigned char T5B[128] = {0, 1, 2, 3, 4, 5, 6, 7, 8, 9, 10, 11, 12, 13, 14, 15, 16, 16, 16, 17, 17, 18, 18, 18, 19, 19, 19, 20, 20, 20, 20, 21, 21, 21, 21, 22, 22, 22, 22, 22, 23, 23, 23, 23, 23, 23, 24, 24, 24, 24, 24, 24, 25, 25, 25, 25, 25, 25, 25, 26, 26, 26, 26, 26, 26, 26, 26, 27, 27, 27, 27, 27, 27, 27, 27, 27, 27, 28, 28, 28, 28, 28, 28, 28, 28, 28, 28, 29, 29, 29, 29, 29, 29, 29, 29, 29, 29, 29, 29, 30, 30, 30, 30, 30, 30, 30, 30, 30, 30, 30, 30, 30, 30, 31, 31, 31, 31, 31, 31, 31, 31, 31, 31, 31, 31, 31, 31, 31};

__device__ __forceinline__ float bf2f(bf16_t b) { return __uint_as_float((unsigned)b << 16); }
__device__ __forceinline__ unsigned f2bf(float f) { unsigned u = __float_as_uint(f); return (u + 0x7fffu + ((u >> 16) & 1u)) >> 16; }
__device__ __forceinline__ unsigned pk2(float lo, float hi) { return f2bf(lo) | (f2bf(hi) << 16); }
__device__ __forceinline__ float wave_sum(float v) {
#pragma unroll
    for (int o = 1; o < 64; o <<= 1) v += __shfl_xor(v, o);
    return v;
}
__device__ __forceinline__ float wave_max(float v) {
#pragma unroll
    for (int o = 1; o < 64; o <<= 1) v = fmaxf(v, __shfl_xor(v, o));
    return v;
}
__device__ __forceinline__ bf16_t* Uptr(const Params& p) { return (bf16_t*)(p.ws + WS_U); }

__device__ __forceinline__ int win_src_col(int r) {
    if (r < 1024) return 1024 + r;
    if (r < 2048) return 3088 + (r - 1024);
    if (r < 3072) return 6232 + (r - 2048);
    if (r < 3584) return r - 3072;
    if (r < 4096) return 512 + (r - 3584);
    if (r < 4352) return 4112 + (r - 4096);
    if (r < 4608) return 4368 + (r - 4352);
    if (r < 5120) return 4624 + (r - 4608);
    if (r < 5184) return 5136 + (r - 5120);
    if (r < 5200) return 2048 + (r - 5184);
    if (r < 5208) return 5200 + (r - 5200);
    if (r < 5376) return -1;
    if (r < 6400) return 2064 + (r - 5376);
    if (r < 7424) return 5208 + (r - 6400);
    if (r < 8448) return 7256 + (r - 7424);
    return 8280 + (r - 8448);
}

template <bool MAP>
__device__ __forceinline__ void transpose_item(const float* W, int ldw, int K, bf16_t* WT, float* scr, int item, int lane) {
    const int nkb = K / 64, nb = item / nkb, kb = item % nkb, k0 = 64 * kb, n0 = 32 * nb;
    const int n = n0 + (lane & 31);
    const int c = MAP ? win_src_col(n) : n;
#pragma unroll 8
    for (int i = 0; i < 32; ++i) { const int kk = 2 * i + (lane >> 5); scr[kk * 33 + (lane & 31)] = (c >= 0) ? W[(size_t)(k0 + kk) * ldw + c] : 0.f; }
    asm volatile("s_waitcnt lgkmcnt(0)" ::: "memory");
    const int c8 = lane & 7;
#pragma unroll
    for (int j = 0; j < 4; ++j) {
        const int nn = (lane >> 3) + 8 * j; const float* s = scr + (8 * c8) * 33 + nn;
        u32x4 o; o.x = pk2(s[0 * 33], s[1 * 33]); o.y = pk2(s[2 * 33], s[3 * 33]); o.z = pk2(s[4 * 33], s[5 * 33]); o.w = pk2(s[6 * 33], s[7 * 33]);
        *(u32x4*)(WT + (size_t)(n0 + nn) * K + k0 + 8 * c8) = o;
    }
    asm volatile("s_waitcnt lgkmcnt(0)" ::: "memory");
}
__device__ __forceinline__ void rms_row_to_bf16(const float* xrow, const float* g, bf16_t* orow, int lane) {
    const f32x4* xr = (const f32x4*)xrow + lane; const f32x4* gr = (const f32x4*)g + lane;
    f32x4 v[4]; float s = 0.f;
#pragma unroll
    for (int j = 0; j < 4; ++j) { v[j] = xr[64 * j]; s += (v[j].x * v[j].x + v[j].y * v[j].y) + (v[j].z * v[j].z + v[j].w * v[j].w); }
    const float rstd = 1.f / sqrtf(wave_sum(s) * (1.f / DM) + EPS);
    unsigned long long* o8 = (unsigned long long*)orow + lane;
#pragma unroll
    for (int j = 0; j < 4; ++j) { const f32x4 gg = gr[64 * j];
        o8[64 * j] = (unsigned long long)pk2(v[j].x * rstd * gg.x, v[j].y * rstd * gg.y) | ((unsigned long long)pk2(v[j].z * rstd * gg.z, v[j].w * rstd * gg.w) << 32); }
}
__device__ void phase_prep(const Params& p, int bid, int nb, unsigned char* lds) {
    const int tid = threadIdx.x, lane = tid & 63, wave = tid >> 6;
    float* scr = (float*)lds + wave * (64 * 33);
    const int gw = bid * NWAVES + wave, NGW = nb * NWAVES;
    constexpr int I_ALL = (WT_ROWS / 32) * (DM / 64), I_MKV = (2048 / 32) * (DM / 64), I_SQ = (DM / 32) * (DM / 64);
    constexpr int NITEMS = I_ALL + I_MKV + 4 * I_SQ;
    for (int it = gw; it < NITEMS; it += NGW) {
        int r = it;
        if (r < I_ALL) { transpose_item<true>(p.w_in, WIN_COLS, DM, (bf16_t*)(p.ws + WS_WTALL), scr, r, lane); continue; } r -= I_ALL;
        if (r < I_MKV) { transpose_item<false>(p.w_mem_kv, 2048, DM, (bf16_t*)(p.ws + WS_WTMKV), scr, r, lane); continue; } r -= I_MKV;
        if (r < I_SQ) { transpose_item<false>(p.w_gla_out, DM, DM, (bf16_t*)(p.ws + WS_WTGO), scr, r, lane); continue; } r -= I_SQ;
        if (r < I_SQ) { transpose_item<false>(p.w_dsa_out, DM, DM, (bf16_t*)(p.ws + WS_WTDO), scr, r, lane); continue; } r -= I_SQ;
        if (r < I_SQ) { transpose_item<false>(p.w_x_out, DM, DM, (bf16_t*)(p.ws + WS_WTXO), scr, r, lane); continue; } r -= I_SQ;
        transpose_item<false>(p.w_o, DM, DM, (bf16_t*)(p.ws + WS_WTO), scr, r, lane);
    }
    bf16_t* U = Uptr(p);
    for (int m = gw; m < MTOK + MMEM; m += NGW) {
        if (m < MTOK) rms_row_to_bf16(p.x + (size_t)m * DM, p.g_pre, U + (size_t)m * LDU + C_H, lane);
        else rms_row_to_bf16(p.mem + (size_t)(m - MTOK) * DM, p.g_mem, (bf16_t*)(p.ws + WS_MEMN) + (size_t)(m - MTOK) * DM, lane);
    }
}

struct OpStoreBf16 { bf16_t* C; int ldc, coff;
    __device__ __forceinline__ void operator()(int r, int c, f32x4 v) const { u32x2 w; w.x = pk2(v[0], v[1]); w.y = pk2(v[2], v[3]); *(u32x2*)(C + (size_t)r * ldc + coff + c) = w; } };
__device__ __forceinline__ f32x4 ld4bf(const bf16_t* q) { const u32x2 w = *(const u32x2*)q; f32x4 o; o[0] = __uint_as_float(w.x << 16); o[1] = __uint_as_float(w.x & 0xffff0000u); o[2] = __uint_as_float(w.y << 16); o[3] = __uint_as_float(w.y & 0xffff0000u); return o; }
__device__ __forceinline__ void st4bf(bf16_t* q, f32x4 v) { u32x2 w; w.x = pk2(v[0], v[1]); w.y = pk2(v[2], v[3]); *(u32x2*)q = w; }
__device__ __forceinline__ float sigmoidf_(float x) { return 1.f / (1.f + __expf(-x)); }
struct OpZGate { bf16_t* U;
    __device__ __forceinline__ void operator()(int r, int c, f32x4 z) const { bf16_t* q = U + (size_t)r * LDU + 1024 + c; f32x4 o = ld4bf(q);
#pragma unroll
        for (int i = 0; i < 4; ++i) o[i] = o[i] * z[i] * sigmoidf_(z[i]);
        st4bf(q, o); } };
struct OpSig { bf16_t* S2; bf16_t* U;
    __device__ __forceinline__ void operator()(int r, int c, f32x4 g) const { f32x4 s;
#pragma unroll
        for (int i = 0; i < 4; ++i) s[i] = sigmoidf_(g[i]);
        bf16_t* q = (c < 2048) ? S2 + (size_t)r * 2048 + c : U + (size_t)r * LDU + C_SM + (c - 2048);
        st4bf(q, s); } };
template <int B> struct OpMerge { const bf16_t* S2; bf16_t* U;
    __device__ __forceinline__ void operator()(int r, int c, f32x4 v) const {
        const bf16_t* sq = (B == 0) ? S2 + (size_t)r * 2048 + c : (B == 1) ? S2 + (size_t)r * 2048 + 1024 + c : U + (size_t)r * LDU + C_SM + c;
        const f32x4 s = ld4bf(sq); bf16_t* q = U + (size_t)r * LDU + C_MG + c;
        f32x4 o = s * v; if (B != 0) o = o + ld4bf(q);
        st4bf(q, o); } };
struct OpOutF32 { float* O;
    __device__ __forceinline__ void operator()(int r, int c, f32x4 v) const { *(f32x4*)(O + (size_t)r * DM + c) = v; } };

template <class Op>
__device__ void gemm_simple(const bf16_t* A, int lda, const bf16_t* Bt, int M, int N, int K, const Op& op, int bid, int nb) {
    const int tid = threadIdx.x, lane = tid & 63, wave = tid >> 6, fr = lane & 15, fq = lane >> 4;
    const int ntn = N / 64, nitems = (M / 128) * ntn;
    for (int it = bid; it < nitems; it += nb) {
        const int tm = it / ntn, tn = it % ntn;
        const int row = tm * 128 + wave * 16 + fr;
        const bf16_t* ap = A + (size_t)row * lda + fq * 8;
        const bf16_t* bp = Bt + (size_t)(tn * 64 + fr) * K + fq * 8;
        f32x4 acc[4];
#pragma unroll
        for (int n = 0; n < 4; ++n) acc[n] = (f32x4){0.f, 0.f, 0.f, 0.f};
#pragma unroll 2
        for (int k0 = 0; k0 < K; k0 += 32) {
            const bf16x8 a = *(const bf16x8*)(ap + k0);
#pragma unroll
            for (int n = 0; n < 4; ++n) { const bf16x8 b = *(const bf16x8*)(bp + (size_t)n * 16 * K + k0); acc[n] = __builtin_amdgcn_mfma_f32_16x16x32_bf16(b, a, acc[n], 0, 0, 0); }
        }
#pragma unroll
        for (int n = 0; n < 4; ++n) op(row, tn * 64 + n * 16 + fq * 4, acc[n]);
    }
}

__device__ void phase_gla_rec(const Params& p, float* oraw, int bid, int nb, unsigned char* lds) {
    constexpr int CH = 32, RS = 136;
    float* As = (float*)lds; float* Ks = As + CH * RS; float* Qs = Ks + CH * RS; float* Vs = Qs + CH * RS;
    const bf16_t* U = Uptr(p);
    const int tid = threadIdx.x, cl = tid >> 3, ds = tid & 7;
    for (int it = bid; it < 64; it += nb) {
        const int b = it >> 4, h = (it >> 2) & 3, q4 = it & 3;
        float s[16];
#pragma unroll
        for (int i = 0; i < 16; ++i) s[i] = 0.f;
        for (int t0 = 0; t0 < SEQ; t0 += CH) {
            __syncthreads();
            for (int e = tid; e < CH * 128; e += NTHREADS) {
                const int i = e >> 7, d = e & 127; const size_t m = (size_t)b * SEQ + t0 + i; const bf16_t* ur = U + m * LDU;
                float x = p.b_a[h * 128 + d];
#pragma unroll
                for (int r = 0; r < 16; ++r) x += bf2f(ur[C_GA + r]) * p.w_a_up[r * 512 + h * 128 + d];
                const float ls = fminf(x, 0.f) - log1pf(__expf(-fabsf(x)));
                const int o = i * RS + (d >> 4) * 17 + (d & 15);
                As[o] = __expf(ls * (1.f / 16.f));
                Ks[o] = bf2f(ur[C_GK + h * 128 + d]);
                Qs[o] = bf2f(ur[C_GQ + h * 128 + d]) * 0.08838834764831845f;
            }
            for (int e = tid; e < CH * 64; e += NTHREADS) { const int i = e >> 6, c = e & 63; Vs[e] = bf2f(U[((size_t)b * SEQ + t0 + i) * LDU + C_GV + h * 256 + q4 * 64 + c]); }
            __syncthreads();
            for (int i = 0; i < CH; ++i) {
                const float v = Vs[i * 64 + cl]; const float* a = As + i * RS + ds * 17; const float* k = Ks + i * RS + ds * 17; const float* q = Qs + i * RS + ds * 17;
                float o = 0.f;
#pragma unroll
                for (int dd = 0; dd < 16; ++dd) { s[dd] = a[dd] * s[dd] + k[dd] * v; o += q[dd] * s[dd]; }
                o += __shfl_xor(o, 1); o += __shfl_xor(o, 2); o += __shfl_xor(o, 4);
                if (ds == 0) oraw[((size_t)b * SEQ + t0 + i) * DM + h * 256 + q4 * 64 + cl] = o;
            }
        }
    }
}
__device__ void phase_gla_norm(const Params& p, const float* oraw, int bid, int nb) {
    bf16_t* U = Uptr(p);
    const int lane = threadIdx.x & 63, wave = threadIdx.x >> 6;
    for (int it = bid * NWAVES + wave; it < MTOK * 4; it += nb * NWAVES) {
        const int m = it >> 2, h = it & 3;
        const f32x4 v = *(const f32x4*)(oraw + (size_t)m * DM + h * 256 + lane * 4);
        const float ss = wave_sum((v[0] * v[0] + v[1] * v[1]) + (v[2] * v[2] + v[3] * v[3]));
        const float rstd = 1.f / sqrtf(ss * (1.f / 256.f) + EPS);
        const f32x4 g = *(const f32x4*)(p.g_gla + lane * 4);
        st4bf(U + (size_t)m * LDU + C_GV + h * 256 + lane * 4, v * g * rstd);
    }
}

__device__ __forceinline__ unsigned fkey(float f) { const unsigned u = __float_as_uint(f); return (u & 0x80000000u) ? ~u : (u | 0x80000000u); }
__device__ void phase_dsa_ref(const Params& p, int bid, int nb, unsigned char* lds) {
    float* sc = (float*)lds;
    float* iqs = sc + 4096;
    float* qs = iqs + 512;
    float* lg = qs + 1024;
    int* sel = (int*)(lg + 2048);
    unsigned* hist = (unsigned*)(sel + 256);
    unsigned* cnt = hist + 256;
    int* misc = (int*)(cnt + 512);
    float* ws8 = (float*)(misc + 8);
    bf16_t* U = Uptr(p);
    const int tid = threadIdx.x, lane = tid & 63, wave = tid >> 6;
    for (int it = bid; it < MTOK; it += nb) {
        const int b = it / SEQ, t = it % SEQ; const size_t m = (size_t)it; const bf16_t* ur = U + m * LDU; const bf16_t* ub = U + (size_t)b * SEQ * LDU;
        __syncthreads();
        iqs[tid] = bf2f(ur[C_IQ + tid]);
        qs[tid] = bf2f(ur[C_DQ + tid]) * 0.08838834764831845f; qs[tid + 512] = bf2f(ur[C_DQ + 512 + tid]) * 0.08838834764831845f;
        if (tid < 8) ws8[tid] = bf2f(ur[C_IW + tid]);
        if (tid == 0) misc[0] = 0;
        __syncthreads();
        const int n = t + 1, ksel = n < 256 ? n : 256;
#pragma unroll 1
        for (int j = 0; j < 8; ++j) {
            const int s = tid * 8 + j;
            if (s < n) {
                const bf16_t* kr = ub + (size_t)s * LDU + C_IK;
                float acc[8];
#pragma unroll
                for (int h = 0; h < 8; ++h) acc[h] = 0.f;
#pragma unroll 1
                for (int d0 = 0; d0 < 64; d0 += 8) {
                    const bf16x8 kv = *(const bf16x8*)(kr + d0);
#pragma unroll
                    for (int dd = 0; dd < 8; ++dd) { const float kd = bf2f((bf16_t)kv[dd]);
#pragma unroll
                        for (int h = 0; h < 8; ++h) acc[h] += iqs[h * 64 + d0 + dd] * kd; }
                }
                float score = 0.f;
#pragma unroll
                for (int h = 0; h < 8; ++h) score += ws8[h] * fmaxf(acc[h], 0.f);
                sc[s] = score;
            }
        }
        __syncthreads();
        if (n <= 256) { if (tid < n) sel[tid] = tid; }
        else {
            unsigned prefix = 0u, mask = 0u; int need = ksel;
            for (int pass = 3; pass >= 0; --pass) {
                const int shift = 8 * pass;
                if (tid < 256) hist[tid] = 0u;
                __syncthreads();
#pragma unroll 1
                for (int j = 0; j < 8; ++j) { const int s = tid * 8 + j; if (s < n) { const unsigned u = fkey(sc[s]); if ((u & mask) == prefix) atomicAdd(&hist[(u >> shift) & 255u], 1u); } }
                __syncthreads();
                if (tid == 0) { int cum = 0, d = 255; for (; d > 0; --d) { const int c = (int)hist[d]; if (cum + c >= need) break; cum += c; } misc[1] = d; misc[2] = need - cum; }
                __syncthreads();
                prefix |= (unsigned)misc[1] << shift; mask |= 0xFFu << shift; need = misc[2];
                __syncthreads();
            }
            unsigned myeq = 0u;
#pragma unroll 1
            for (int j = 0; j < 8; ++j) { const int s = tid * 8 + j; if (s < n && fkey(sc[s]) == prefix) ++myeq; }
            cnt[tid] = myeq;
            __syncthreads();
            int rank = 0; for (int i = 0; i < tid; ++i) rank += (int)cnt[i];
#pragma unroll 1
            for (int j = 0; j < 8; ++j) { const int s = tid * 8 + j; if (s < n) { const unsigned u = fkey(sc[s]);
                bool take = u > prefix; if (u == prefix) { take = rank < need; ++rank; }
                if (take) { const int pos = atomicAdd(&misc[0], 1); if (pos < 256) sel[pos] = s; } } }
        }
        __syncthreads();
        { const int j = tid & 255, c = tid >> 8;
          float l4[4];
          if (j < ksel) { const int s = sel[j]; const bf16_t* kr = ub + (size_t)s * LDU + C_DK + c * 128;
              float a0 = 0.f, a1 = 0.f, a2 = 0.f, a3 = 0.f;
#pragma unroll 1
              for (int d0 = 0; d0 < 128; d0 += 8) { const bf16x8 kv = *(const bf16x8*)(kr + d0);
#pragma unroll
                  for (int dd = 0; dd < 8; ++dd) { const float kd = bf2f((bf16_t)kv[dd]); const float* qq = qs + c * 512 + d0 + dd; a0 += qq[0] * kd; a1 += qq[128] * kd; a2 += qq[256] * kd; a3 += qq[384] * kd; } }
              int dist = t - s; if (dist < 0) dist = 0; const int bk = dist < 128 ? (int)T5B[dist] : 31; const float* rb = p.rel_bias + bk * 8 + c * 4;
              l4[0] = a0 + rb[0]; l4[1] = a1 + rb[1]; l4[2] = a2 + rb[2]; l4[3] = a3 + rb[3];
          } else { l4[0] = l4[1] = l4[2] = l4[3] = -1e30f; }
#pragma unroll
          for (int g = 0; g < 4; ++g) lg[(c * 4 + g) * 256 + j] = l4[g]; }
        __syncthreads();
        { float v[4]; float mx = -3e38f;
#pragma unroll
          for (int i = 0; i < 4; ++i) { v[i] = lg[wave * 256 + lane + 64 * i]; mx = fmaxf(mx, v[i]); }
          mx = wave_max(mx); float sm = 0.f;
#pragma unroll
          for (int i = 0; i < 4; ++i) { v[i] = __expf(v[i] - mx); sm += v[i]; }
          sm = wave_sum(sm); const float inv = 1.f / sm;
#pragma unroll
          for (int i = 0; i < 4; ++i) lg[wave * 256 + lane + 64 * i] = v[i] * inv; }
        __syncthreads();
        { const int h = wave, c = h >> 2; float o0 = 0.f, o1 = 0.f;
#pragma unroll 4
          for (int j = 0; j < ksel; ++j) { const float pj = lg[h * 256 + j]; const unsigned w = *(const unsigned*)(ub + (size_t)sel[j] * LDU + C_DV + c * 128 + lane * 2);
              o0 += pj * __uint_as_float(w << 16); o1 += pj * __uint_as_float(w & 0xffff0000u); }
          *(unsigned*)(U + m * LDU + C_DQ + h * 128 + lane * 2) = pk2(o0, o1); }
    }
}

__device__ void phase_cross_ref(const Params& p, int bid, int nb, unsigned char* lds) {
    float* qs = (float*)lds;
    float* lg = qs + 1024;
    bf16_t* U = Uptr(p); const bf16_t* MKV = (const bf16_t*)(p.ws + WS_MKV);
    const int tid = threadIdx.x, lane = tid & 63, wave = tid >> 6;
    for (int it = bid; it < MTOK; it += nb) {
        const int b = it / SEQ; const size_t m = (size_t)it; const bf16_t* mb = MKV + (size_t)b * NMEM * 2048;
        __syncthreads();
        qs[tid] = bf2f(U[m * LDU + C_XQ + tid]) * 0.0625f; qs[tid + 512] = bf2f(U[m * LDU + C_XQ + 512 + tid]) * 0.0625f;
        __syncthreads();
        { const int j = tid & 255, hp = tid >> 8;
          const bf16_t* kr = mb + (size_t)j * 2048 + hp * 512; float a0 = 0.f, a1 = 0.f;
          for (int d0 = 0; d0 < 256; d0 += 8) { const bf16x8 k0 = *(const bf16x8*)(kr + d0); const bf16x8 k1 = *(const bf16x8*)(kr + 256 + d0);
#pragma unroll
              for (int dd = 0; dd < 8; ++dd) { a0 += qs[hp * 512 + d0 + dd] * bf2f((bf16_t)k0[dd]); a1 += qs[hp * 512 + 256 + d0 + dd] * bf2f((bf16_t)k1[dd]); } }
          lg[(2 * hp) * 256 + j] = a0; lg[(2 * hp + 1) * 256 + j] = a1; }
        __syncthreads();
        if (wave < 4) { float v[4]; float mx = -3e38f;
#pragma unroll
            for (int i = 0; i < 4; ++i) { v[i] = lg[wave * 256 + lane + 64 * i]; mx = fmaxf(mx, v[i]); }
            mx = wave_max(mx); float sm = 0.f;
#pragma unroll
            for (int i = 0; i < 4; ++i) { v[i] = __expf(v[i] - mx); sm += v[i]; }
            sm = wave_sum(sm); const float inv = 1.f / sm;
#pragma unroll
            for (int i = 0; i < 4; ++i) lg[wave * 256 + lane + 64 * i] = v[i] * inv; }
        __syncthreads();
        { const int h = tid >> 7, d = (tid & 127) * 2; float o0 = 0.f, o1 = 0.f;
          for (int j = 0; j < NMEM; ++j) { const float pj = lg[h * 256 + j]; const unsigned w = *(const unsigned*)(mb + (size_t)j * 2048 + 1024 + h * 256 + d);
              o0 += pj * __uint_as_float(w << 16); o1 += pj * __uint_as_float(w & 0xffff0000u); }
          *(unsigned*)(U + m * LDU + C_XQ + h * 256 + d) = pk2(o0, o1); }
    }
}

__device__ void phase_final(const Params& p, int bid, int nb) {
    const int lane = threadIdx.x & 63, wave = threadIdx.x >> 6;
    for (int m = bid * NWAVES + wave; m < MTOK; m += nb * NWAVES) {
        f32x4* orow = (f32x4*)(p.out + (size_t)m * DM) + lane; const f32x4* xr = (const f32x4*)(p.x + (size_t)m * DM) + lane; const f32x4* gr = (const f32x4*)p.g_post + lane;
        f32x4 v[4]; float s = 0.f;
#pragma unroll
        for (int j = 0; j < 4; ++j) { v[j] = orow[64 * j]; s += (v[j].x * v[j].x + v[j].y * v[j].y) + (v[j].z * v[j].z + v[j].w * v[j].w); }
        const float rstd = 1.f / sqrtf(wave_sum(s) * (1.f / DM) + EPS);
#pragma unroll
        for (int j = 0; j < 4; ++j) orow[64 * j] = xr[64 * j] + v[j] * rstd * gr[64 * j];
    }
}

constexpr int NPHASE = 9;
constexpr int LDS_BYTES = 72 * 1024;
__device__ __forceinline__ void run_phase(const Params& p, int ph, int bid, int nb, unsigned char* lds) {
    bf16_t* U = Uptr(p); const bf16_t* WT = (const bf16_t*)(p.ws + WS_WTALL);
    bf16_t* S2 = (bf16_t*)p.out; float* oraw = p.out;
    switch (ph) {
    case 0: phase_prep(p, bid, nb, lds); break;
    case 1: { OpStoreBf16 o1{U, LDU, 1024}; gemm_simple(U + C_H, LDU, WT, MTOK, N1, DM, o1, bid, nb);
              OpStoreBf16 o2{(bf16_t*)(p.ws + WS_MKV), 2048, 0}; gemm_simple((const bf16_t*)(p.ws + WS_MEMN), DM, (const bf16_t*)(p.ws + WS_WTMKV), MMEM, 2048, DM, o2, bid, nb); } break;
    case 2: phase_gla_rec(p, oraw, bid, nb, lds); break;
    case 3: phase_gla_norm(p, oraw, bid, nb); phase_dsa_ref(p, bid, nb, lds); break;
    case 4: phase_cross_ref(p, bid, nb, lds); break;
    case 5: { OpZGate oz{U}; gemm_simple(U + C_H, LDU, WT + (size_t)WT_Z * DM, MTOK, 3072, DM, oz, bid, nb);
              OpSig os{S2, U}; gemm_simple(U + C_H, LDU, WT + (size_t)WT_G * DM, MTOK, 3072, DM, os, bid, nb); } break;
    case 6: { OpMerge<0> m0{S2, U}; gemm_simple(U + C_GV, LDU, (const bf16_t*)(p.ws + WS_WTGO), MTOK, DM, DM, m0, bid, nb);
              OpMerge<1> m1{S2, U}; gemm_simple(U + C_DQ, LDU, (const bf16_t*)(p.ws + WS_WTDO), MTOK, DM, DM, m1, bid, nb);
              OpMerge<2> m2{S2, U}; gemm_simple(U + C_XQ, LDU, (const bf16_t*)(p.ws + WS_WTXO), MTOK, DM, DM, m2, bid, nb); } break;
    case 7: { OpOutF32 oo{p.out}; gemm_simple(U + C_MG, LDU, (const bf16_t*)(p.ws + WS_WTO), MTOK, DM, DM, oo, bid, nb); } break;
    case 8: phase_final(p, bid, nb); break;
    }
}

#if ONE_LAUNCH
__global__ void __launch_bounds__(NTHREADS) fwd_mega(Params p) {
    extern __shared__ __attribute__((aligned(16))) unsigned char lds[];
    cg::grid_group grid = cg::this_grid();
    for (int ph = 0; ph < NPHASE; ++ph) { run_phase(p, ph, blockIdx.x, gridDim.x, lds); if (ph + 1 < NPHASE) grid.sync(); }
}
#else
template <int PH> __global__ void __launch_bounds__(NTHREADS) fwd_phase(Params p) {
    extern __shared__ __attribute__((aligned(16))) unsigned char lds[];
    run_phase(p, PH, blockIdx.x, gridDim.x, lds);
}
#endif

extern "C" void kernel_launch(void* const* d_in, const int* in_sizes, int n_in, void* d_out, int out_size, void* d_ws, size_t ws_size, hipStream_t stream) {
    if (n_in != 15 || out_size != MTOK * DM || ws_size < WS_END) { fprintf(stderr, "kernel_launch: unexpected shapes (n_in %d out %d ws %zu)\n", n_in, out_size, ws_size); return; }
    Params p{};
    p.x = (const float*)d_in[0]; p.mem = (const float*)d_in[1]; p.g_pre = (const float*)d_in[2]; p.g_post = (const float*)d_in[3]; p.g_mem = (const float*)d_in[4];
    p.w_in = (const float*)d_in[5]; p.w_a_up = (const float*)d_in[6]; p.b_a = (const float*)d_in[7]; p.g_gla = (const float*)d_in[8]; p.rel_bias = (const float*)d_in[9];
    p.w_mem_kv = (const float*)d_in[10]; p.w_gla_out = (const float*)d_in[11]; p.w_dsa_out = (const float*)d_in[12]; p.w_x_out = (const float*)d_in[13]; p.w_o = (const float*)d_in[14];
    p.out = (float*)d_out; p.ws = (unsigned char*)d_ws;
#if ONE_LAUNCH
    static int grid_blocks = 0;
    if (!grid_blocks) {
        int dev = 0, cus = 0, per_cu = 0;
        hipGetDevice(&dev); hipDeviceGetAttribute(&cus, hipDeviceAttributeMultiprocessorCount, dev);
        hipFuncSetAttribute((const void*)fwd_mega, hipFuncAttributeMaxDynamicSharedMemorySize, LDS_BYTES);
        hipOccupancyMaxActiveBlocksPerMultiprocessor(&per_cu, (const void*)fwd_mega, NTHREADS, LDS_BYTES);
        if (per_cu < 1) per_cu = 1;
        grid_blocks = cus * per_cu;
    }
    void* args[] = {&p};
    hipError_t e = hipLaunchCooperativeKernel((void*)fwd_mega, dim3(grid_blocks), dim3(NTHREADS), args, LDS_BYTES, stream);
    if (e != hipSuccess) fprintf(stderr, "cooperative launch failed: %s (grid %d)\n", hipGetErrorString(e), grid_blocks);
#else
    const int G = 1024;
    static bool attr_done = false;
#define LAUNCH(PH) do { if (!attr_done) (void)hipFuncSetAttribute((const void*)fwd_phase<PH>, hipFuncAttributeMaxDynamicSharedMemorySize, LDS_BYTES); hipLaunchKernelGGL(fwd_phase<PH>, dim3(G), dim3(NTHREADS), LDS_BYTES, stream, p); } while (0)
    LAUNCH(0); LAUNCH(1); LAUNCH(2); LAUNCH(3); LAUNCH(4); LAUNCH(5); LAUNCH(6); LAUNCH(7); LAUNCH(8);
    attr_done = true;
#undef LAUNCH
#endif
}
```

```cpp
#include <hip/hip_runtime.h>
#include <hip/hip_cooperative_groups.h>
#include <cstdio>
#include <cstdint>
namespace cg = cooperative_groups;

#define PROF_PHASE 31
#define PROF_STOP 21
#ifndef ONE_LAUNCH
#define ONE_LAUNCH 1
#endif

typedef unsigned short bf16_t;
typedef short bf16x8 __attribute__((ext_vector_type(8)));
typedef float f32x4 __attribute__((ext_vector_type(4)));
typedef unsigned u32x2 __attribute__((ext_vector_type(2)));
typedef unsigned u32x4 __attribute__((ext_vector_type(4)));

constexpr int NBATCH = 4, SEQ = 4096, DM = 1024, MTOK = NBATCH * SEQ;
constexpr int NMEM = 256, MMEM = NBATCH * NMEM;
constexpr int WIN_COLS = 11352;
constexpr float EPS = 1e-6f;
constexpr int NTHREADS = 512, NWAVES = 8;
constexpr int LDU = 6400;
constexpr int C_H = 0, C_GV = 1024, C_DQ = 2048, C_XQ = 3072, C_GQ = 4096, C_GK = 4608, C_DK = 5120, C_DV = 5376, C_IQ = 5632, C_IK = 6144, C_GA = 6208, C_IW = 6224;
constexpr int C_SM = 4096;
constexpr int C_MG = 5120;
constexpr int N1 = 5376;
constexpr int WT_Z = 5376, WT_G = 8448, WT_ROWS = 11520;
constexpr size_t MiB = 1u << 20;
constexpr size_t WS_WTALL = 0, WS_WTMKV = 23 * MiB, WS_WTGO = 27 * MiB, WS_WTDO = 29 * MiB, WS_WTXO = 31 * MiB, WS_WTO = 33 * MiB;
constexpr size_t WS_MKV = 35 * MiB, WS_MASK = 39 * MiB  , WS_U = 48 * MiB, WS_END = 248 * MiB;
static_assert(WS_U + (size_t)MTOK * LDU * 2 == WS_END && WS_END <= 256 * MiB, "ws map");

struct Params {
    const float *x, *mem, *g_pre, *g_post, *g_mem, *w_in, *w_a_up, *b_a, *g_gla, *rel_bias, *w_mem_kv, *w_gla_out, *w_dsa_out, *w_x_out, *w_o;
    float* out; unsigned char* ws;
};

__device__ const unsigned char T5B[128] = {0, 1, 2, 3, 4, 5, 6, 7, 8, 9, 10, 11, 12, 13, 14, 15, 16, 16, 16, 17, 17, 18, 18, 18, 19, 19, 19, 20, 20, 20, 20, 21, 21, 21, 21, 22, 22, 22, 22, 22, 23, 23, 23, 23, 23, 23, 24, 24, 24, 24, 24, 24, 25, 25, 25, 25, 25, 25, 25, 26, 26, 26, 26, 26, 26, 26, 26, 27, 27, 27, 27, 27, 27, 27, 27, 27, 27, 28, 28, 28, 28, 28, 28, 28, 28, 28, 28, 29, 29, 29, 29, 29, 29, 29, 29, 29, 29, 29, 29, 30, 30, 30, 30, 30, 30, 30, 30, 30, 30, 30, 30, 30, 30, 31, 31, 31, 31, 31, 31, 31, 31, 31, 31, 31, 31, 31, 31, 31};

__device__ __forceinline__ float bf2f(bf16_t b) { return __uint_as_float((unsigned)b << 16); }
__device__ __forceinline__ unsigned f2bf(float f) { unsigned u = __float_as_uint(f); return (u + 0x7fffu + ((u >> 16) & 1u)) >> 16; }
typedef float f32x2_t_ __attribute__((ext_vector_type(2))); typedef __bf16 bf16x2_t_ __attribute__((ext_vector_type(2)));
__device__ __forceinline__ unsigned pk2(float lo, float hi) { f32x2_t_ v = {lo, hi}; bf16x2_t_ b = __builtin_convertvector(v, bf16x2_t_); return __builtin_bit_cast(unsigned, b); }
__device__ __forceinline__ float wave_sum(float v) {
#pragma unroll
    for (int o = 1; o < 64; o <<= 1) v += __shfl_xor(v, o);
    return v;
}
__device__ __forceinline__ float wave_max(float v) {
#pragma unroll
    for (int o = 1; o < 64; o <<= 1) v = fmaxf(v, __shfl_xor(v, o));
    return v;
}
__device__ __forceinline__ int opaque_tid() { int t = threadIdx.x; asm volatile("" : "+v"(t)); return t; }
__device__ __forceinline__ bf16_t* Uptr(const Params& p) { return (bf16_t*)(p.ws + WS_U); }

__device__ __forceinline__ int win_src_col(int r) {
    if (r < 1024) return 1024 + r;
    if (r < 2048) return 3088 + (r - 1024);
    if (r < 3072) return 6232 + (r - 2048);
    if (r < 3584) return r - 3072;
    if (r < 4096) return 512 + (r - 3584);
    if (r < 4352) return 4112 + (r - 4096);
    if (r < 4608) return 4368 + (r - 4352);
    if (r < 5120) return 4624 + (r - 4608);
    if (r < 5184) return 5136 + (r - 5120);
    if (r < 5200) return 2048 + (r - 5184);
    if (r < 5208) return 5200 + (r - 5200);
    if (r < 5376) return -1;
    if (r < 6400) return 2064 + (r - 5376);
    if (r < 7424) return 5208 + (r - 6400);
    if (r < 8448) return 7256 + (r - 7424);
    return 8280 + (r - 8448);
}

template <bool MAP>
__device__ __forceinline__ void transpose_item(const float* W, int ldw, int K, bf16_t* WT, float* scr, int item, int lane) {
    const int nkb = K / 64, nb = item / nkb, kb = item % nkb, k0 = 64 * kb, n0 = 32 * nb;
    const int n = n0 + (lane & 31);
    const int c = MAP ? win_src_col(n) : n;
#pragma unroll 8
    for (int i = 0; i < 32; ++i) { const int kk = 2 * i + (lane >> 5); scr[kk * 33 + (lane & 31)] = (c >= 0) ? W[(size_t)(k0 + kk) * ldw + c] : 0.f; }
    asm volatile("s_waitcnt lgkmcnt(0)" ::: "memory");
    const int c8 = lane & 7;
#pragma unroll
    for (int j = 0; j < 4; ++j) {
        const int nn = (lane >> 3) + 8 * j; const float* s = scr + (8 * c8) * 33 + nn;
        u32x4 o; o.x = pk2(s[0 * 33], s[1 * 33]); o.y = pk2(s[2 * 33], s[3 * 33]); o.z = pk2(s[4 * 33], s[5 * 33]); o.w = pk2(s[6 * 33], s[7 * 33]);
        *(u32x4*)(WT + (size_t)(n0 + nn) * K + k0 + 8 * c8) = o;
    }
    asm volatile("s_waitcnt lgkmcnt(0)" ::: "memory");
}
__device__ __forceinline__ void rms_row_to_bf16(const float* xrow, const float* g, bf16_t* orow, int lane) {
    const f32x4* xr = (const f32x4*)xrow + lane; const f32x4* gr = (const f32x4*)g + lane;
    f32x4 v[4]; float s = 0.f;
#pragma unroll
    for (int j = 0; j < 4; ++j) { v[j] = xr[64 * j]; s += (v[j].x * v[j].x + v[j].y * v[j].y) + (v[j].z * v[j].z + v[j].w * v[j].w); }
    const float rstd = 1.f / sqrtf(wave_sum(s) * (1.f / DM) + EPS);
    unsigned long long* o8 = (unsigned long long*)orow + lane;
#pragma unroll
    for (int j = 0; j < 4; ++j) { const f32x4 gg = gr[64 * j];
        o8[64 * j] = (unsigned long long)pk2(v[j].x * rstd * gg.x, v[j].y * rstd * gg.y) | ((unsigned long long)pk2(v[j].z * rstd * gg.z, v[j].w * rstd * gg.w) << 32); }
}
__device__ void phase_prep(const Params& p, int bid, int nb, unsigned char* lds) {
    const int tid = threadIdx.x, lane = tid & 63, wave = tid >> 6;
    float* scr = (float*)lds + wave * (64 * 33);
    const int gw = bid * NWAVES + wave, NGW = nb * NWAVES;
    constexpr int I_ALL = (WT_ROWS / 32) * (DM / 64), I_MKV = (2048 / 32) * (DM / 64), I_SQ = (DM / 32) * (DM / 64);
    constexpr int NITEMS = I_ALL + I_MKV + 4 * I_SQ;
    for (int it = gw; it < NITEMS; it += NGW) {
        int r = it;
        if (r < I_ALL) { transpose_item<true>(p.w_in, WIN_COLS, DM, (bf16_t*)(p.ws + WS_WTALL), scr, r, lane); continue; } r -= I_ALL;
        if (r < I_MKV) { transpose_item<false>(p.w_mem_kv, 2048, DM, (bf16_t*)(p.ws + WS_WTMKV), scr, r, lane); continue; } r -= I_MKV;
        if (r < I_SQ) { transpose_item<false>(p.w_gla_out, DM, DM, (bf16_t*)(p.ws + WS_WTGO), scr, r, lane); continue; } r -= I_SQ;
        if (r < I_SQ) { transpose_item<false>(p.w_dsa_out, DM, DM, (bf16_t*)(p.ws + WS_WTDO), scr, r, lane); continue; } r -= I_SQ;
        if (r < I_SQ) { transpose_item<false>(p.w_x_out, DM, DM, (bf16_t*)(p.ws + WS_WTXO), scr, r, lane); continue; } r -= I_SQ;
        transpose_item<false>(p.w_o, DM, DM, (bf16_t*)(p.ws + WS_WTO), scr, r, lane);
    }
    bf16_t* U = Uptr(p);
    for (int m = gw; m < MTOK + MMEM; m += NGW) {
        if (m < MTOK) rms_row_to_bf16(p.x + (size_t)m * DM, p.g_pre, U + (size_t)m * LDU + C_H, lane);
        else rms_row_to_bf16(p.mem + (size_t)(m - MTOK) * DM, p.g_mem, (bf16_t*)p.out + (size_t)(m - MTOK) * LDU, lane);
    }
}

struct OpStoreBf16 { bf16_t* C; int ldc, coff;
    __device__ __forceinline__ void operator()(int r, int c, f32x4 v) const { u32x2 w; w.x = pk2(v[0], v[1]); w.y = pk2(v[2], v[3]); *(u32x2*)(C + (size_t)r * ldc + coff + c) = w; } };
__device__ __forceinline__ f32x4 ld4bf(const bf16_t* q) { const u32x2 w = *(const u32x2*)q; f32x4 o; o[0] = __uint_as_float(w.x << 16); o[1] = __uint_as_float(w.x & 0xffff0000u); o[2] = __uint_as_float(w.y << 16); o[3] = __uint_as_float(w.y & 0xffff0000u); return o; }
__device__ __forceinline__ void st4bf(bf16_t* q, f32x4 v) { u32x2 w; w.x = pk2(v[0], v[1]); w.y = pk2(v[2], v[3]); *(u32x2*)q = w; }
__device__ __forceinline__ float sigmoidf_(float x) { return 1.f / (1.f + __expf(-x)); }
struct OpZGate { bf16_t* U; bool dry;
    __device__ __forceinline__ void operator()(int r, int c, f32x4 z) const { bf16_t* q = U + (size_t)r * LDU + 1024 + c; f32x4 o = ld4bf(q);
#pragma unroll
        for (int i = 0; i < 4; ++i) o[i] = o[i] * z[i] * sigmoidf_(z[i]);
        if (!dry) st4bf(q, o); } };
struct OpSig { bf16_t* S2; bf16_t* U;
    __device__ __forceinline__ void operator()(int r, int c, f32x4 g) const { f32x4 s;
#pragma unroll
        for (int i = 0; i < 4; ++i) s[i] = sigmoidf_(g[i]);
        bf16_t* q = (c < 2048) ? S2 + (size_t)r * 2048 + c : U + (size_t)r * LDU + C_SM + (c - 2048);
        st4bf(q, s); } };
template <int B> struct OpMerge { const bf16_t* S2; bf16_t* U;
    __device__ __forceinline__ void operator()(int r, int c, f32x4 v) const {
        const bf16_t* sq = (B == 0) ? S2 + (size_t)r * 2048 + c : (B == 1) ? S2 + (size_t)r * 2048 + 1024 + c : U + (size_t)r * LDU + C_SM + c;
        const f32x4 s = ld4bf(sq); bf16_t* q = U + (size_t)r * LDU + C_MG + c;
        f32x4 o = s * v; if (B != 0) o = o + ld4bf(q);
        st4bf(q, o); } };
struct OpOutF32 { float* O;
    __device__ __forceinline__ void operator()(int r, int c, f32x4 v) const { *(f32x4*)(O + (size_t)r * DM + c) = v; } };

template <class Op>
__device__ void gemm_simple(const bf16_t* A, int lda, const bf16_t* Bt, int M, int N, int K, const Op& op, int bid, int nb) {
    const int tid = threadIdx.x, lane = tid & 63, wave = tid >> 6, fr = lane & 15, fq = lane >> 4;
    const int ntn = N / 64, nitems = (M / 128) * ntn;
    for (int it = bid; it < nitems; it += nb) {
        const int tm = it / ntn, tn = it % ntn;
        const int row = tm * 128 + wave * 16 + fr;
        const bf16_t* ap = A + (size_t)row * lda + fq * 8;
        const bf16_t* bp = Bt + (size_t)(tn * 64 + fr) * K + fq * 8;
        f32x4 acc[4];
#pragma unroll
        for (int n = 0; n < 4; ++n) acc[n] = (f32x4){0.f, 0.f, 0.f, 0.f};
#pragma unroll 2
        for (int k0 = 0; k0 < K; k0 += 32) {
            const bf16x8 a = *(const bf16x8*)(ap + k0);
#pragma unroll
            for (int n = 0; n < 4; ++n) { const bf16x8 b = *(const bf16x8*)(bp + (size_t)n * 16 * K + k0); acc[n] = __builtin_amdgcn_mfma_f32_16x16x32_bf16(b, a, acc[n], 0, 0, 0); }
        }
#pragma unroll
        for (int n = 0; n < 4; ++n) op(row, tn * 64 + n * 16 + fq * 4, acc[n]);
    }
}


namespace pg8 {
#define PG8_LAS __attribute__((address_space(3)))
constexpr int BM = 256, BK = 64, HALF = 128, HTB = HALF * BK * 2  , STAGE_BYTES = 8 * HTB, NXCD = 8, WGM = 8;
__host__ __device__ __forceinline__ int lds_byte(int r, int c) { const int st = (r >> 4) * 2 + (c >> 5), rr = r & 15, cc = c & 31, ob = rr * 64 + cc * 2; return st * 1024 + (ob ^ (((ob >> 9) & 1) << 5)); }
__host__ __device__ __forceinline__ void stage_rc(int b, int& R, int& C) { const int st = b / 1024, sb = b % 1024, swz = sb ^ (((sb >> 9) & 1) << 5); R = (st >> 1) * 16 + swz / 64; C = (st & 1) * 32 + (swz % 64) / 2; }
__host__ __device__ __forceinline__ int perm32(int rho) { const int n = rho >> 4, i = rho & 15; return 8 * (i >> 2) + 4 * n + (i & 3); }
struct Unit { int pm, pn, kind; const char* a; const char* b; };
struct Job { const bf16_t* A; const bf16_t* Bt; int nM, nN; };
struct Sched {
    Job j[2]; int njobs, rep, G, c, lda; long astride, bstride;
    __device__ __forceinline__ bool next(int i, Unit& u) const {
        const int ti = i / rep, v = i - ti * rep; long L = (long)ti * G + c;
#pragma unroll
        for (int q = 0; q < 2; ++q) { if (q < njobs) { const int nwg = j[q].nM * j[q].nN;
            if (L < nwg) { int wgid = (int)L; { const int qq = nwg / NXCD, r = nwg % NXCD, xcd = wgid % NXCD, off = wgid / NXCD; wgid = (xcd < r ? xcd * (qq + 1) : r * (qq + 1) + (xcd - r) * qq) + off; }
                const int nig = WGM * j[q].nN, gid = wgid / nig, fm = gid * WGM, gsz = (j[q].nM - fm) < WGM ? (j[q].nM - fm) : WGM;
                u.pm = fm + ((wgid % nig) % gsz); u.pn = (wgid % nig) / gsz; u.kind = 4 * q + v;
                u.a = (const char*)(j[q].A + (size_t)u.pm * BM * lda + (size_t)v * astride); u.b = (const char*)(j[q].Bt + (size_t)u.pn * BM * DM + (size_t)v * bstride); return true; }
            L -= nwg; } }
        return false;
    }
};
template <class Sel> struct Epi { static constexpr bool PERM = true; Sel sel;
    __device__ __forceinline__ void operator()(const f32x4 (&acc)[2][2][4][2], const Unit& u, int wr, int wc, int fr, int fq) const {
#pragma unroll
        for (int ai = 0; ai < 2; ++ai)
#pragma unroll
            for (int m = 0; m < 4; ++m) { const int row = u.pm * BM + ai * HALF + wr * 64 + m * 16 + fr;
#pragma unroll
                for (int bj = 0; bj < 2; ++bj) { const int col = u.pn * BM + bj * HALF + wc * 32 + 8 * fq; sel(u.kind, row, col, acc[ai][bj][m][0], acc[ai][bj][m][1]); } }
    }
};
template <class EpiT, bool ALIGN_EPI>
__device__ __forceinline__ void gemm_phase(PG8_LAS unsigned char* lds, const Sched& S, const EpiT& E) {
    int tid_ = threadIdx.x; asm volatile("" : "+v"(tid_));
    const int tid = tid_, wid = __builtin_amdgcn_readfirstlane(tid >> 6), lane = tid & 63, wr = wid >> 2, wc = wid & 3, fr = lane & 15, fq = lane >> 4;
    constexpr int K = DM, nt = K / BK; const int lda = S.lda;
    unsigned voffA[2], voffB[2];
#pragma unroll
    for (int i = 0; i < 2; ++i) { int R, C; stage_rc(tid * 16 + i * 8192, R, C); const int Rb = EpiT::PERM ? ((R & ~31) + perm32(R & 31)) : R;
        voffA[i] = (unsigned)(R * lda + C) * 2u; voffB[i] = (unsigned)(Rb * K + C) * 2u; }
    const size_t kstep = (size_t)(BK * 2);
    const size_t hstepA = (size_t)HALF * lda * 2, hstepB = (size_t)HALF * K * 2;
    const unsigned ldsw = (unsigned)wid * 1024u;
    const int aoff = lds_byte(wr * 64 + fr, fq * 8), boff = lds_byte(wc * 32 + fr, fq * 8);
#define PG8_SA(b, h) (((b) * 2 + (h)) * HTB)
#define PG8_SB(b, h) ((4 + (b) * 2 + (h)) * HTB)
#define PG8_STAGE(bufoff, gbase, voff) do { _Pragma("unroll") for (int _i = 0; _i < 2; ++_i) \
        __builtin_amdgcn_global_load_lds((const unsigned*)((const char*)(gbase) + (voff)[_i]), (PG8_LAS unsigned*)(lds + (bufoff) + ldsw + _i * 8192), 16, 0, 0); } while (0)
#define PG8_LDA(dst, b, h) do { _Pragma("unroll") for (int m = 0; m < 4; ++m) _Pragma("unroll") for (int k = 0; k < 2; ++k) dst[m][k] = *(const PG8_LAS bf16x8*)(lds + PG8_SA(b, h) + aoff + m * 2048 + k * 1024); } while (0)
#define PG8_LDB(dst, b, h) do { _Pragma("unroll") for (int n = 0; n < 2; ++n) _Pragma("unroll") for (int k = 0; k < 2; ++k) dst[n][k] = *(const PG8_LAS bf16x8*)(lds + PG8_SB(b, h) + boff + n * 2048 + k * 1024); } while (0)
#define PG8_MMA(ai, bj, At, Bt) do { __builtin_amdgcn_s_setprio(1); _Pragma("unroll") for (int m = 0; m < 4; ++m) _Pragma("unroll") for (int n = 0; n < 2; ++n) _Pragma("unroll") for (int k = 0; k < 2; ++k) \
        acc[ai][bj][m][n] = __builtin_amdgcn_mfma_f32_16x16x32_bf16(Bt[n][k], At[m][k], acc[ai][bj][m][n], 0, 0, 0); __builtin_amdgcn_s_setprio(0); } while (0)
#define PG8_WAIT_V(n) asm volatile("s_waitcnt vmcnt(" #n ")" ::: "memory")
#define PG8_WAIT_L(n) asm volatile("s_waitcnt lgkmcnt(" #n ")" ::: "memory")
#define PG8_BAR __builtin_amdgcn_s_barrier()
#define PG8_SCHED __builtin_amdgcn_sched_barrier(0)
    Unit cur, nxt; int ui = 0;
    if (!S.next(0, cur)) return;
    f32x4 acc[2][2][4][2];
#pragma unroll
    for (int a = 0; a < 2; ++a)
#pragma unroll
        for (int b = 0; b < 2; ++b)
#pragma unroll
            for (int m = 0; m < 4; ++m)
#pragma unroll
                for (int n = 0; n < 2; ++n) acc[a][b][m][n] = (f32x4){0.f, 0.f, 0.f, 0.f};
    bf16x8 At[4][2], B0[2][2], B1[2][2];
    const char* cA = cur.a; const char* cB = cur.b;
    PG8_STAGE(PG8_SB(0, 0), cB, voffB); PG8_STAGE(PG8_SB(0, 1), cB + hstepB, voffB); PG8_STAGE(PG8_SA(0, 0), cA, voffA); PG8_STAGE(PG8_SA(0, 1), cA + hstepA, voffA);
    if (wr == 1) PG8_BAR;
    PG8_WAIT_V(2); PG8_BAR;
    PG8_STAGE(PG8_SB(1, 0), cB + kstep, voffB); PG8_STAGE(PG8_SA(1, 0), cA + kstep, voffA); PG8_STAGE(PG8_SB(1, 1), cB + hstepB + kstep, voffB);
    PG8_WAIT_V(6); PG8_BAR;
    for (;;) {
        const bool has_next = S.next(ui + 1, nxt);
        const char* nA = has_next ? nxt.a : cA; const char* nB = has_next ? nxt.b : cB;
        for (int t = 0; t < nt; t += 2) {
            const bool last = (t == nt - 2);
            const char* a1 = cA + (size_t)(t + 1) * kstep;
            const char* a2 = last ? nA : cA + (size_t)(t + 2) * kstep; const char* b2 = last ? nB : cB + (size_t)(t + 2) * kstep;
            const char* a3 = a2 + kstep; const char* b3 = b2 + kstep;
            PG8_LDB(B0, 0, 0); PG8_LDB(B1, 0, 1); PG8_SCHED; PG8_LDA(At, 0, 0); PG8_STAGE(PG8_SA(1, 1), a1 + hstepA, voffA);
            PG8_WAIT_V(8); PG8_WAIT_L(0); PG8_BAR; PG8_MMA(0, 0, At, B0); PG8_MMA(0, 1, At, B1); PG8_BAR; PG8_SCHED;
            PG8_LDA(At, 0, 1); PG8_STAGE(PG8_SB(0, 0), b2, voffB); PG8_STAGE(PG8_SB(0, 1), b2 + hstepB, voffB); PG8_STAGE(PG8_SA(0, 0), a2, voffA);
            PG8_WAIT_V(8); PG8_WAIT_L(0); PG8_BAR; PG8_MMA(1, 0, At, B0); PG8_MMA(1, 1, At, B1); PG8_BAR; PG8_SCHED;
            PG8_LDB(B0, 1, 0); PG8_LDB(B1, 1, 1); PG8_SCHED; PG8_LDA(At, 1, 0); PG8_STAGE(PG8_SA(0, 1), a2 + hstepA, voffA);
            PG8_WAIT_V(8); PG8_WAIT_L(0); PG8_BAR; PG8_MMA(0, 0, At, B0); PG8_MMA(0, 1, At, B1); PG8_BAR; PG8_SCHED;
            PG8_LDA(At, 1, 1); PG8_STAGE(PG8_SB(1, 0), b3, voffB); PG8_STAGE(PG8_SB(1, 1), b3 + hstepB, voffB); PG8_STAGE(PG8_SA(1, 0), a3, voffA);
            PG8_WAIT_V(8); PG8_WAIT_L(0); PG8_BAR; PG8_MMA(1, 0, At, B0); PG8_MMA(1, 1, At, B1); PG8_BAR; PG8_SCHED;
        }
        if constexpr (ALIGN_EPI) { if (wr == 0) PG8_BAR; }
        E(acc, cur, wr, wc, fr, fq);
        if (!has_next) break;
#pragma unroll
        for (int a = 0; a < 2; ++a)
#pragma unroll
            for (int b = 0; b < 2; ++b)
#pragma unroll
                for (int m = 0; m < 4; ++m)
#pragma unroll
                    for (int n = 0; n < 2; ++n) acc[a][b][m][n] = (f32x4){0.f, 0.f, 0.f, 0.f};
        cur = nxt; cA = nA; cB = nB; ++ui;
        if constexpr (ALIGN_EPI) { if (wr == 1) PG8_BAR; }
    }
    PG8_WAIT_V(0);
    if constexpr (!ALIGN_EPI) { if (wr == 0) PG8_BAR; }
    PG8_BAR;
#undef PG8_SA
#undef PG8_SB
#undef PG8_STAGE
#undef PG8_LDA
#undef PG8_LDB
#undef PG8_MMA
#undef PG8_WAIT_V
#undef PG8_WAIT_L
#undef PG8_BAR
#undef PG8_SCHED
}
}
struct SelP1 { OpStoreBf16 o1, o2; __device__ __forceinline__ void operator()(int kind, int r, int c, f32x4 v0, f32x4 v1) const { if (kind == 0) { o1(r, c, v0); o1(r, c + 4, v1); } else { o2(r, c, v0); o2(r, c + 4, v1); } } };
struct SelP5 { OpZGate oz; OpSig os; __device__ __forceinline__ void operator()(int kind, int r, int c, f32x4 v0, f32x4 v1) const { if (kind == 0) { oz(r, c, v0); oz(r, c + 4, v1); } else { os(r, c, v0); os(r, c + 4, v1); } } };
struct SelP6 { OpMerge<0> m0; OpMerge<1> m1; OpMerge<2> m2; __device__ __forceinline__ void operator()(int kind, int r, int c, f32x4 v0, f32x4 v1) const {
    if (kind == 0) { m0(r, c, v0); m0(r, c + 4, v1); } else if (kind == 1) { m1(r, c, v0); m1(r, c + 4, v1); } else { m2(r, c, v0); m2(r, c + 4, v1); } } };
struct SelP7 { OpOutF32 oo; __device__ __forceinline__ void operator()(int kind, int r, int c, f32x4 v0, f32x4 v1) const { oo(r, c, v0); oo(r, c + 4, v1); } };

__device__ void phase_gla_rec(const Params& p, float* oraw, int bid, int nb, unsigned char* lds) {
    constexpr int CH = 32, RS = 136;
    float* As = (float*)lds; float* Ks = As + CH * RS; float* Qs = Ks + CH * RS; float* Vs = Qs + CH * RS;
    const bf16_t* U = Uptr(p);
    const int tid = threadIdx.x, cl = tid >> 3, ds = tid & 7;
    for (int it = bid; it < 64; it += nb) {
        const int b = it >> 4, h = (it >> 2) & 3, q4 = it & 3;
        float s[16];
#pragma unroll
        for (int i = 0; i < 16; ++i) s[i] = 0.f;
        for (int t0 = 0; t0 < SEQ; t0 += CH) {
            __syncthreads();
            for (int e = tid; e < CH * 128; e += NTHREADS) {
                const int i = e >> 7, d = e & 127; const size_t m = (size_t)b * SEQ + t0 + i; const bf16_t* ur = U + m * LDU;
                float x = p.b_a[h * 128 + d];
#pragma unroll
                for (int r = 0; r < 16; ++r) x += bf2f(ur[C_GA + r]) * p.w_a_up[r * 512 + h * 128 + d];
                const float ls = fminf(x, 0.f) - log1pf(__expf(-fabsf(x)));
                const int o = i * RS + (d >> 4) * 17 + (d & 15);
                As[o] = __expf(ls * (1.f / 16.f));
                Ks[o] = bf2f(ur[C_GK + h * 128 + d]);
                Qs[o] = bf2f(ur[C_GQ + h * 128 + d]) * 0.08838834764831845f;
            }
            for (int e = tid; e < CH * 64; e += NTHREADS) { const int i = e >> 6, c = e & 63; Vs[e] = bf2f(U[((size_t)b * SEQ + t0 + i) * LDU + C_GV + h * 256 + q4 * 64 + c]); }
            __syncthreads();
            for (int i = 0; i < CH; ++i) {
                const float v = Vs[i * 64 + cl]; const float* a = As + i * RS + ds * 17; const float* k = Ks + i * RS + ds * 17; const float* q = Qs + i * RS + ds * 17;
                float o = 0.f;
#pragma unroll
                for (int dd = 0; dd < 16; ++dd) { s[dd] = a[dd] * s[dd] + k[dd] * v; o += q[dd] * s[dd]; }
                o += __shfl_xor(o, 1); o += __shfl_xor(o, 2); o += __shfl_xor(o, 4);
                if (ds == 0) oraw[((size_t)b * SEQ + t0 + i) * DM + h * 256 + q4 * 64 + cl] = o;
            }
        }
    }
}
__device__ void phase_gla_norm(const Params& p, const float* oraw, int bid, int nb) {
    bf16_t* U = Uptr(p);
    const int lane = threadIdx.x & 63, wave = threadIdx.x >> 6;
    for (int it = bid * NWAVES + wave; it < MTOK * 4; it += nb * NWAVES) {
        const int m = it >> 2, h = it & 3;
        const f32x4 v = *(const f32x4*)(oraw + (size_t)m * DM + h * 256 + lane * 4);
        const float ss = wave_sum((v[0] * v[0] + v[1] * v[1]) + (v[2] * v[2] + v[3] * v[3]));
        const float rstd = 1.f / sqrtf(ss * (1.f / 256.f) + EPS);
        const f32x4 g = *(const f32x4*)(p.g_gla + lane * 4);
        st4bf(U + (size_t)m * LDU + C_GV + h * 256 + lane * 4, v * g * rstd);
    }
}

__device__ __forceinline__ unsigned fkey(float f) { const unsigned u = __float_as_uint(f); return (u & 0x80000000u) ? ~u : (u | 0x80000000u); }
__device__ void phase_dsa_ref(const Params& p, int bid, int nb, unsigned char* lds) {
    float* sc = (float*)lds;
    float* iqs = sc + 4096;
    float* qs = iqs + 512;
    float* lg = qs + 1024;
    int* sel = (int*)(lg + 2048);
    unsigned* hist = (unsigned*)(sel + 256);
    unsigned* cnt = hist + 256;
    int* misc = (int*)(cnt + 512);
    float* ws8 = (float*)(misc + 8);
    bf16_t* U = Uptr(p);
    const int tid = threadIdx.x, lane = tid & 63, wave = tid >> 6;
    for (int it = bid; it < MTOK; it += nb) {
        const int b = it / SEQ, t = it % SEQ; const size_t m = (size_t)it; const bf16_t* ur = U + m * LDU; const bf16_t* ub = U + (size_t)b * SEQ * LDU;
        __syncthreads();
        iqs[tid] = bf2f(ur[C_IQ + tid]);
        qs[tid] = bf2f(ur[C_DQ + tid]) * 0.08838834764831845f; qs[tid + 512] = bf2f(ur[C_DQ + 512 + tid]) * 0.08838834764831845f;
        if (tid < 8) ws8[tid] = bf2f(ur[C_IW + tid]);
        if (tid == 0) misc[0] = 0;
        __syncthreads();
        const int n = t + 1, ksel = n < 256 ? n : 256;
#pragma unroll 1
        for (int j = 0; j < 8; ++j) {
            const int s = tid * 8 + j;
            if (s < n) {
                const bf16_t* kr = ub + (size_t)s * LDU + C_IK;
                float acc[8];
#pragma unroll
                for (int h = 0; h < 8; ++h) acc[h] = 0.f;
#pragma unroll 1
                for (int d0 = 0; d0 < 64; d0 += 8) {
                    const bf16x8 kv = *(const bf16x8*)(kr + d0);
#pragma unroll
                    for (int dd = 0; dd < 8; ++dd) { const float kd = bf2f((bf16_t)kv[dd]);
#pragma unroll
                        for (int h = 0; h < 8; ++h) acc[h] += iqs[h * 64 + d0 + dd] * kd; }
                }
                float score = 0.f;
#pragma unroll
                for (int h = 0; h < 8; ++h) score += ws8[h] * fmaxf(acc[h], 0.f);
                sc[s] = score;
            }
        }
        __syncthreads();
        if (n <= 256) { if (tid < n) sel[tid] = tid; }
        else {
            unsigned prefix = 0u, mask = 0u; int need = ksel;
            for (int pass = 3; pass >= 0; --pass) {
                const int shift = 8 * pass;
                if (tid < 256) hist[tid] = 0u;
                __syncthreads();
#pragma unroll 1
                for (int j = 0; j < 8; ++j) { const int s = tid * 8 + j; if (s < n) { const unsigned u = fkey(sc[s]); if ((u & mask) == prefix) atomicAdd(&hist[(u >> shift) & 255u], 1u); } }
                __syncthreads();
                if (tid == 0) { int cum = 0, d = 255; for (; d > 0; --d) { const int c = (int)hist[d]; if (cum + c >= need) break; cum += c; } misc[1] = d; misc[2] = need - cum; }
                __syncthreads();
                prefix |= (unsigned)misc[1] << shift; mask |= 0xFFu << shift; need = misc[2];
                __syncthreads();
            }
            unsigned myeq = 0u;
#pragma unroll 1
            for (int j = 0; j < 8; ++j) { const int s = tid * 8 + j; if (s < n && fkey(sc[s]) == prefix) ++myeq; }
            cnt[tid] = myeq;
            __syncthreads();
            int rank = 0; for (int i = 0; i < tid; ++i) rank += (int)cnt[i];
#pragma unroll 1
            for (int j = 0; j < 8; ++j) { const int s = tid * 8 + j; if (s < n) { const unsigned u = fkey(sc[s]);
                bool take = u > prefix; if (u == prefix) { take = rank < need; ++rank; }
                if (take) { const int pos = atomicAdd(&misc[0], 1); if (pos < 256) sel[pos] = s; } } }
        }
        __syncthreads();
        { const int j = tid & 255, c = tid >> 8;
          float l4[4];
          if (j < ksel) { const int s = sel[j]; const bf16_t* kr = ub + (size_t)s * LDU + C_DK + c * 128;
              float a0 = 0.f, a1 = 0.f, a2 = 0.f, a3 = 0.f;
#pragma unroll 1
              for (int d0 = 0; d0 < 128; d0 += 8) { const bf16x8 kv = *(const bf16x8*)(kr + d0);
#pragma unroll
                  for (int dd = 0; dd < 8; ++dd) { const float kd = bf2f((bf16_t)kv[dd]); const float* qq = qs + c * 512 + d0 + dd; a0 += qq[0] * kd; a1 += qq[128] * kd; a2 += qq[256] * kd; a3 += qq[384] * kd; } }
              int dist = t - s; if (dist < 0) dist = 0; const int bk = dist < 128 ? (int)T5B[dist] : 31; const float* rb = p.rel_bias + bk * 8 + c * 4;
              l4[0] = a0 + rb[0]; l4[1] = a1 + rb[1]; l4[2] = a2 + rb[2]; l4[3] = a3 + rb[3];
          } else { l4[0] = l4[1] = l4[2] = l4[3] = -1e30f; }
#pragma unroll
          for (int g = 0; g < 4; ++g) lg[(c * 4 + g) * 256 + j] = l4[g]; }
        __syncthreads();
        { float v[4]; float mx = -3e38f;
#pragma unroll
          for (int i = 0; i < 4; ++i) { v[i] = lg[wave * 256 + lane + 64 * i]; mx = fmaxf(mx, v[i]); }
          mx = wave_max(mx); float sm = 0.f;
#pragma unroll
          for (int i = 0; i < 4; ++i) { v[i] = __expf(v[i] - mx); sm += v[i]; }
          sm = wave_sum(sm); const float inv = 1.f / sm;
#pragma unroll
          for (int i = 0; i < 4; ++i) lg[wave * 256 + lane + 64 * i] = v[i] * inv; }
        __syncthreads();
        { const int h = wave, c = h >> 2; float o0 = 0.f, o1 = 0.f;
#pragma unroll 4
          for (int j = 0; j < ksel; ++j) { const float pj = lg[h * 256 + j]; const unsigned w = *(const unsigned*)(ub + (size_t)sel[j] * LDU + C_DV + c * 128 + lane * 2);
              o0 += pj * __uint_as_float(w << 16); o1 += pj * __uint_as_float(w & 0xffff0000u); }
          *(unsigned*)(U + m * LDU + C_DQ + h * 128 + lane * 2) = pk2(o0, o1); }
    }
}


typedef float f32x16 __attribute__((ext_vector_type(16)));
typedef short s16x4 __attribute__((ext_vector_type(4)));
#define LAS __attribute__((address_space(3)))
#define MFMA32(a, b, c) __builtin_amdgcn_mfma_f32_32x32x16_bf16((a), (b), (c), 0, 0, 0)
__device__ __forceinline__ int crow(int r, int h) { return (r & 3) + 8 * (r >> 2) + 4 * h; }
constexpr int TRI = 8256;
__device__ __forceinline__ size_t mask_index(int b, int j, int kt, int lane) { return ((size_t)(b * TRI + j * (j + 1) / 2 + kt)) * 64 + lane; }

__device__ __forceinline__ void idx_tile(f32x16& sc, const bf16x8 (&aik)[4], LAS const bf16x8* biq  , const float (&wq)[8]) {
#pragma unroll
    for (int r = 0; r < 16; ++r) sc[r] = 0.f;
#pragma unroll
    for (int h = 0; h < 8; ++h) {
        f32x16 d;
#pragma unroll
        for (int r = 0; r < 16; ++r) d[r] = 0.f;
#pragma unroll
        for (int kk = 0; kk < 4; ++kk) d = MFMA32(aik[kk], biq[(h * 4 + kk) * 64], d);
#pragma unroll
        for (int r = 0; r < 16; ++r) sc[r] = __builtin_fmaf(wq[h], __builtin_fmaxf(d[r], 0.f), sc[r]);
    }
}

__device__ __forceinline__ void dsa_select_item(const Params& p, int idx, unsigned char* lds) {
    unsigned* hist = (unsigned*)lds;
    unsigned* qpref = hist + 32 * 256;
    int* qneed = (int*)(qpref + 32);
    int* qcut = qneed + 32;
    int* qflag = qcut + 32;
    int* anyflag = qflag + 32;
    unsigned* tb = (unsigned*)(anyflag + 8);
    LAS bf16x8* iqf = (LAS bf16x8*)((LAS unsigned char*)lds + 65536);
    const bf16_t* U = Uptr(p); unsigned short* maskbuf = (unsigned short*)(p.ws + WS_MASK);
    const int tid = opaque_tid(), lane = tid & 63, wave = __builtin_amdgcn_readfirstlane(tid >> 6), q = lane & 31, half = lane >> 5;
    const int b = idx & 3, j = idx >> 2, t0 = 32 * j; const size_t mb = (size_t)b * SEQ;
    __syncthreads();
    for (int e = tid; e < 32 * 256; e += NTHREADS) hist[e] = 0u;
    if (tid < 32) { qpref[tid] = 0u; qneed[tid] = 256; qcut[tid] = 0x7fffffff; qflag[tid] = 0; }
    if (tid < 8) anyflag[tid] = 0;
    float wq[8];
    { const bf16_t* ur = U + (mb + t0 + q) * LDU;
#pragma unroll
      for (int i = 0; i < 4; ++i) { const int f = wave + 8 * i; iqf[f * 64 + lane] = *(const bf16x8*)(ur + C_IQ + f * 16 + 8 * half); }
#pragma unroll
      for (int h = 0; h < 8; ++h) wq[h] = bf2f(ur[C_IW + h]); }
    LAS const bf16x8* biq = iqf + lane;
    __syncthreads();
#pragma unroll 1
    for (int ps = 0; ps < 6; ++ps) {
        if (ps == 4) { if (anyflag[0] == 0) continue; }
        const unsigned myT = qpref[q]; const int mycut = qcut[q];
        const int shift = 24 - 8 * ps; const unsigned mhi = (ps == 0 || ps > 3) ? 0u : (0xFFFFFFFFu << (32 - 8 * ps));
#pragma unroll 1
        for (int kt = wave; kt <= j; kt += NWAVES) {
            bf16x8 aik[4];
            { const bf16_t* kr = U + (mb + 32 * kt + q) * LDU + C_IK + 8 * half;
#pragma unroll
              for (int kk = 0; kk < 4; ++kk) aik[kk] = *(const bf16x8*)(kr + kk * 16); }
            f32x16 sc; idx_tile(sc, aik, biq, wq);
            unsigned word = 0u;
#pragma unroll
            for (int r = 0; r < 16; ++r) {
                const int kin = crow(r, half); const bool valid = (kt < j) || (kin <= q);
                const unsigned key = fkey(sc[r]);
                if (ps < 4) { if (valid && (key & mhi) == myT) atomicAdd(&hist[q * 256 + ((key >> shift) & 255u)], 1u); }
                else if (ps == 4) { if (valid && key == myT) word |= 1u << kin; }
                else { const bool sel = valid && (key > myT || (key == myT && (32 * kt + kin) <= mycut)); word |= sel ? (1u << r) : 0u; }
            }
            if (ps == 4) { if (word) atomicOr(&tb[kt * 32 + q], word); }
            if (ps == 5) maskbuf[mask_index(b, j, kt, lane)] = (unsigned short)word;
        }
        __syncthreads();
        if (ps < 4) {
            for (int qi = 0; qi < 4; ++qi) {
                const int qq = 4 * wave + qi; const int need = qneed[qq];
                u32x4 c = *(u32x4*)&hist[qq * 256 + 4 * lane];
                const int tot = (int)(c.x + c.y + c.z + c.w);
                int suf = tot;
#pragma unroll
                for (int o = 1; o < 64; o <<= 1) { const int tv = __shfl_down(suf, o); if (lane + o < 64) suf += tv; }
                const int above = suf - tot;
                if (above < need && need <= suf) {
                    int cum = above, digit, eq;
                    if (cum + (int)c.w >= need) { digit = 3; eq = (int)c.w; }
                    else { cum += (int)c.w; if (cum + (int)c.z >= need) { digit = 2; eq = (int)c.z; }
                        else { cum += (int)c.z; if (cum + (int)c.y >= need) { digit = 1; eq = (int)c.y; } else { cum += (int)c.y; digit = 0; eq = (int)c.x; } } }
                    qpref[qq] |= (unsigned)(4 * lane + digit) << shift; qneed[qq] = need - cum;
                    if (ps == 3 && eq > need - cum) { qflag[qq] = 1; anyflag[0] = 1; }
                }
                *(u32x4*)&hist[qq * 256 + 4 * lane] = (u32x4){0u, 0u, 0u, 0u};
            }
            if (ps == 3) { for (int e = tid; e < (j + 1) * 32; e += NTHREADS) tb[e] = 0u; }
        }
        if (ps == 4) {
            if (tid < 32 && qflag[tid]) { const int need = qneed[tid]; int cnt = 0, cut = 0x7fffffff;
                for (int kt = 0; kt <= j; ++kt) { unsigned w = tb[kt * 32 + tid]; const int pc = __popc(w);
                    if (cnt + pc >= need) { int left = need - cnt, pos = 0; for (;;) { pos = __ffs(w) - 1; if (--left == 0) break; w &= w - 1; } cut = 32 * kt + pos; break; }
                    cnt += pc; }
                qcut[tid] = cut; }
        }
        __syncthreads();
    }
}
__device__ void phase_dsa_select(const Params& p, int bid, int nb, unsigned char* lds) {
    for (int k2 = 2 * bid; k2 < 512; k2 += (k2 & 1) ? 2 * nb - 1 : 1) { const int k = k2 >> 1; dsa_select_item(p, (k2 & 1) ? 511 - k : k, lds); }
}


typedef float f32x4_ __attribute__((ext_vector_type(4)));
#define MFMA16(a, b, c) __builtin_amdgcn_mfma_f32_16x16x32_bf16((a), (b), (c), 0, 0, 0)
constexpr int S2_PITCH = 8192 + 16;
constexpr int S2_KEYS = 0, S2_HIST = 16 * S2_PITCH, S2_MISC = S2_HIST + 16 * 128 * 4;
__device__ __forceinline__ unsigned key16x2(float a, float b) {
    const unsigned x = __builtin_bit_cast(unsigned, __builtin_amdgcn_cvt_pkrtz(a, b));
    const unsigned neg = (x >> 15) & 0x00010001u;
    return x ^ ((neg * 0xFFFFu) | 0x80008000u);
}
__device__ __forceinline__ void dsa_select16_item(const Params& p, int idx, int a, unsigned char* lds_) {
    LAS char* lds = (LAS char*)lds_;
    LAS unsigned* hist = (LAS unsigned*)(lds + S2_HIST);
    LAS unsigned* qT = (LAS unsigned*)(lds + S2_MISC);
    LAS int* qneed = (LAS int*)(qT + 16);
    LAS int* qcut = qneed + 16;
    LAS int* qflag = qcut + 16;
    const bf16_t* U = Uptr(p); unsigned short* maskbuf = (unsigned short*)(p.ws + WS_MASK);
    const int tid = opaque_tid(), lane = tid & 63, wave = __builtin_amdgcn_readfirstlane(tid >> 6), qn = lane & 15, quad = lane >> 4;
    const int b = idx & 3, j = idx >> 2, t0 = 32 * j + 16 * a; const size_t mb = (size_t)b * SEQ;
    const int ntile16 = 2 * j + a + 1;
    __syncthreads();
    for (int e = tid; e < 16 * 128; e += NTHREADS) hist[e] = 0u;
    if (tid < 16) { qT[tid] = 0u; qneed[tid] = 256; qcut[tid] = 0x7fffffff; qflag[tid] = 0; }
    {
        bf16x8 biq[8][2]; float wq[8];
        const bf16_t* ur = U + (mb + t0 + qn) * LDU;
#pragma unroll
        for (int h = 0; h < 8; ++h) { biq[h][0] = *(const bf16x8*)(ur + C_IQ + h * 64 + 8 * quad); biq[h][1] = *(const bf16x8*)(ur + C_IQ + h * 64 + 32 + 8 * quad); wq[h] = bf2f(ur[C_IW + h]); }
        const bf16_t* kb = U + (mb + qn) * LDU + C_IK + 8 * quad;
        bf16x8 a00, a01, a10, a11;
        { const bool two = wave + NWAVES < ntile16; const bf16_t* k0 = kb + (size_t)16 * wave * LDU; const bf16_t* k1 = kb + (size_t)16 * (two ? wave + NWAVES : wave) * LDU;
          if (wave < ntile16) { a00 = *(const bf16x8*)k0; a01 = *(const bf16x8*)(k0 + 32); a10 = *(const bf16x8*)k1; a11 = *(const bf16x8*)(k1 + 32); } }
#pragma unroll 1
        for (int tile = wave; tile < ntile16; tile += 2 * NWAVES) {
            const bool two = tile + NWAVES < ntile16;
            const int nt = tile + 2 * NWAVES; const bool hn = nt < ntile16, hn2 = nt + NWAVES < ntile16;
            bf16x8 n00 = a00, n01 = a01, n10 = a10, n11 = a11;
            if (hn) { const bf16_t* k0 = kb + (size_t)16 * nt * LDU; const bf16_t* k1 = kb + (size_t)16 * (hn2 ? nt + NWAVES : nt) * LDU;
                n00 = *(const bf16x8*)k0; n01 = *(const bf16x8*)(k0 + 32); n10 = *(const bf16x8*)k1; n11 = *(const bf16x8*)(k1 + 32); }
            f32x4_ s0 = (f32x4_){0.f, 0.f, 0.f, 0.f}, s1 = s0;
#pragma unroll
            for (int h = 0; h < 8; ++h) {
                f32x4_ d0 = (f32x4_){0.f, 0.f, 0.f, 0.f}, d1 = d0;
                d0 = MFMA16(a00, biq[h][0], d0); d1 = MFMA16(a10, biq[h][0], d1);
                d0 = MFMA16(a01, biq[h][1], d0); d1 = MFMA16(a11, biq[h][1], d1);
#pragma unroll
                for (int r = 0; r < 4; ++r) { s0[r] = __builtin_fmaf(wq[h], __builtin_fmaxf(d0[r], 0.f), s0[r]); s1[r] = __builtin_fmaf(wq[h], __builtin_fmaxf(d1[r], 0.f), s1[r]); }
            }
            u32x2 w0; w0.x = key16x2(s0[0], s0[1]); w0.y = key16x2(s0[2], s0[3]);
            *(LAS u32x2*)(lds + S2_KEYS + qn * S2_PITCH + (16 * tile + 4 * quad) * 2) = w0;
            if (two) { u32x2 w1; w1.x = key16x2(s1[0], s1[1]); w1.y = key16x2(s1[2], s1[3]);
                *(LAS u32x2*)(lds + S2_KEYS + qn * S2_PITCH + (16 * (tile + NWAVES) + 4 * quad) * 2) = w1; }
            a00 = n00; a01 = n01; a10 = n10; a11 = n11;
        }
    }
    __syncthreads();
    const int rq = tid & 15, part = tid >> 4, nq = t0 + rq + 1;
#pragma unroll 1
    for (int ps = 0; ps < 2; ++ps) {
        const unsigned hiT = qT[rq] >> 8;
        LAS const char* krow = lds + S2_KEYS + rq * S2_PITCH;
        for (int base = part * 8; base < nq; base += 256) {
            const u32x4 kv = *(LAS const u32x4*)(krow + base * 2);
#pragma unroll
            for (int e = 0; e < 8; ++e) { const unsigned w = e < 2 ? kv.x : e < 4 ? kv.y : e < 6 ? kv.z : kv.w; const unsigned key = (e & 1) ? (w >> 16) : (w & 0xffffu);
                const bool ok = (base + e < nq) && (ps == 0 || (key >> 8) == hiT);
                const unsigned bin = ps == 0 ? (key >> 8) : (key & 255u);
                if (ok) __hip_atomic_fetch_add(hist + rq * 128 + (bin >> 1), 1u << (16 * (bin & 1u)), __ATOMIC_RELAXED, __HIP_MEMORY_SCOPE_WORKGROUP); }
        }
        __syncthreads();
#pragma unroll
        for (int qi = 0; qi < 2; ++qi) {
            const int qq = 2 * wave + qi; const int need = qneed[qq];
            const u32x2 hw = *(LAS u32x2*)(hist + qq * 128 + 2 * lane);
            const int c0 = (int)(hw.x & 0xffffu), c1 = (int)(hw.x >> 16), c2 = (int)(hw.y & 0xffffu), c3 = (int)(hw.y >> 16);
            const int tot = c0 + c1 + c2 + c3;
            int suf = tot;
#pragma unroll
            for (int o = 1; o < 64; o <<= 1) { const int tv = __shfl_down(suf, o); if (lane + o < 64) suf += tv; }
            const int above = suf - tot;
            if (above < need && need <= suf) {
                int cum = above, digit, eq;
                if (cum + c3 >= need) { digit = 3; eq = c3; }
                else { cum += c3; if (cum + c2 >= need) { digit = 2; eq = c2; }
                    else { cum += c2; if (cum + c1 >= need) { digit = 1; eq = c1; } else { cum += c1; digit = 0; eq = c0; } } }
                qT[qq] |= (unsigned)(4 * lane + digit) << (ps == 0 ? 8 : 0); qneed[qq] = need - cum;
                if (ps == 1 && eq > need - cum) qflag[qq] = 1;
            }
            *(LAS u32x2*)(hist + qq * 128 + 2 * lane) = (u32x2){0u, 0u};
        }
        __syncthreads();
    }
#pragma unroll 1
    for (int qi = 0; qi < 2; ++qi) {
        const int qq = 2 * wave + qi;
        if (qflag[qq]) { const int nqq = t0 + qq + 1, need = qneed[qq]; const unsigned T = qT[qq]; int acc = 0, cut = 0x7fffffff;
            for (int base = 0; base < nqq; base += 64) { const int s = base + lane;
                const unsigned key = *(LAS const unsigned short*)(lds + S2_KEYS + qq * S2_PITCH + s * 2);
                unsigned long long em = __ballot(s < nqq && key == T); const int pc = __popcll(em);
                if (acc + pc >= need) { int left = need - acc; while (--left > 0) em &= em - 1; cut = base + (int)__ffsll((long long)em) - 1; break; }
                acc += pc; }
            if (lane == 0) qcut[qq] = cut; }
    }
    __syncthreads();
    for (int pi = tid; pi < 16 * (j + 1); pi += NTHREADS) {
        const int eq_ = pi & 15, kt = pi >> 4; const int nqq = t0 + eq_ + 1, cut = qcut[eq_]; const unsigned T = (nqq <= 256) ? 0u : qT[eq_];
        LAS const char* kp = lds + S2_KEYS + eq_ * S2_PITCH + kt * 64;
        unsigned w32 = 0u;
#pragma unroll
        for (int v4 = 0; v4 < 4; ++v4) { const u32x4 kv = *(LAS const u32x4*)(kp + v4 * 16);
#pragma unroll
            for (int e = 0; e < 8; ++e) { const unsigned w = e < 2 ? kv.x : e < 4 ? kv.y : e < 6 ? kv.z : kv.w; const unsigned key = (e & 1) ? (w >> 16) : (w & 0xffffu);
                const int s = 32 * kt + 8 * v4 + e; const bool sel = (s < nqq) && (key > T || (key == T && s <= cut)); w32 |= sel ? (1u << (8 * v4 + e)) : 0u; } }
#pragma unroll
        for (int hf = 0; hf < 2; ++hf) { const unsigned x = w32 >> (4 * hf); const unsigned wd = (x & 0xFu) | ((x >> 4) & 0xF0u) | ((x >> 8) & 0xF00u) | ((x >> 12) & 0xF000u);
            maskbuf[mask_index(b, j, kt, 16 * a + eq_ + 32 * hf)] = (unsigned short)wd; }
    }
}
__device__ void phase_dsa_select2(const Params& p, int bid, int nb, unsigned char* lds) {
    for (int k4 = 4 * bid; k4 < 1024; k4 += ((k4 & 3) == 3) ? 4 * nb - 3 : 1) { const int k = k4 >> 2, r = k4 & 3; dsa_select16_item(p, (r & 2) ? (((127 - (k >> 2)) << 2) | (k & 3)) : k, r & 1, lds); }
}

constexpr int DA_K = 0, DA_V = 32768, DA_BUF = 65536  , DA_TB = 131072, DA_WS = DA_TB + 8 * 132 * 4, DA_END = DA_WS + 8 * 64 * 4;
__device__ __forceinline__ s16x4 ds_tr(LAS const char* pp) { typedef short v4i16_t __attribute__((ext_vector_type(4))); return __builtin_bit_cast(s16x4, __builtin_amdgcn_ds_read_tr16_b64_v4i16((LAS v4i16_t*)pp)); }
template <int MODE>
__device__ __forceinline__ void attend_item(const Params& p, int idx, unsigned char* lds_, bool dry) {
    LAS char* lds = (LAS char*)lds_;
    bf16_t* U = Uptr(p); const unsigned short* maskbuf = (const unsigned short*)(p.ws + WS_MASK);
    const int tid = opaque_tid(), lane = tid & 63, wv = __builtin_amdgcn_readfirstlane(tid >> 6), q = lane & 31, half = lane >> 5;
    constexpr int NKK = MODE == 0 ? 8 : 16;
    const int h = MODE == 0 ? wv : (idx & 3); const int c = wv >> 2;
    const int b = MODE == 0 ? (idx & 3) : ((idx >> 2) >> 5); const int j = idx >> 2;
    const size_t mb = (size_t)b * SEQ;
    const size_t mq = MODE == 0 ? mb + 32 * j : (size_t)128 * j + 32 * (wv & 3);
    const int t0 = 32 * j;
    LAS const float* tbh = (LAS const float*)(lds + DA_TB) + h * 132; LAS float* wsc = (LAS float*)(lds + DA_WS) + wv * 64;
    constexpr float C1 = (MODE == 0 ? 0.08838834764831845f : 0.0625f) * 1.4426950408889634f;
    const float b31 = MODE == 0 ? tbh[128] : 0.f, bmaxh = MODE == 0 ? tbh[129] : 0.f;
    const int nsteps = MODE == 0 ? (j >> 1) + 1 : 4;
    const int srow = 2 * wv + half, spc = lane & 31;
    const bf16_t* gk; const bf16_t* gv; size_t gpitch;
    if (MODE == 0) { gk = U + (mb + srow) * LDU + C_DK + ((spc ^ (srow & 15)) << 3); gv = U + (mb + srow) * LDU + C_DV + ((spc ^ ((srow & 3) << 2)) << 3); gpitch = LDU; }
    else { const bf16_t* MKV = (const bf16_t*)(p.ws + WS_MKV) + ((size_t)b * NMEM + srow) * 2048 + h * 256; gk = MKV + ((spc ^ (srow & 15)) << 3); gv = MKV + 1024 + ((spc ^ ((srow & 3) << 2)) << 3); gpitch = 2048; }
#define DA_STAGE(st_, bufoff_) do { const size_t go_ = (size_t)(64 * (st_)) * gpitch; _Pragma("unroll") for (int i_ = 0; i_ < 4; ++i_) { \
        __builtin_amdgcn_global_load_lds((const unsigned*)(gk + go_ + (size_t)16 * i_ * gpitch), (LAS unsigned*)(lds + (bufoff_) + DA_K + (wv + 8 * i_) * 1024), 16, 0, 0); \
        __builtin_amdgcn_global_load_lds((const unsigned*)(gv + go_ + (size_t)16 * i_ * gpitch), (LAS unsigned*)(lds + (bufoff_) + DA_V + (wv + 8 * i_) * 1024), 16, 0, 0); } } while (0)
    __syncthreads();
    DA_STAGE(0, 0);
    bf16x8 qf[NKK];
    { const bf16_t* ur = U + (mq + q) * LDU + (MODE == 0 ? C_DQ + h * 128 : C_XQ + h * 256) + 8 * half;
#pragma unroll
      for (int kk = 0; kk < NKK; ++kk) qf[kk] = *(const bf16x8*)(ur + kk * 16); }
    f32x16 o[4];
#pragma unroll
    for (int dt = 0; dt < 4; ++dt)
#pragma unroll
        for (int r = 0; r < 16; ++r) o[dt][r] = 0.f;
    float m = -1e20f, l = 0.f;
    unsigned kA0, vA0;
    { const int q4 = (lane & 15) >> 2, p4 = lane & 3, g1 = (lane >> 4) & 1;
      kA0 = DA_K + q * 512 + ((((MODE == 0 ? c * 16 : 0) + half) ^ (q & 15)) << 4);
      vA0 = DA_V + (4 * half + q4) * 512 + (((c * 16 + 2 * g1 + (p4 >> 1)) ^ (q4 << 2)) << 4) + (p4 & 1) * 8; }
    unsigned mw0 = 0xffffu, mw1 = 0xffffu;
    if (MODE == 0) { mw0 = maskbuf[mask_index(b, j, 0, lane)]; mw1 = (1 <= j) ? maskbuf[mask_index(b, j, 1, lane)] : 0u; }
#pragma unroll 1
    for (int st = 0; st < nsteps; ++st) {
        const int kbase = 64 * st;
        asm volatile("s_waitcnt vmcnt(0)" ::: "memory");
        __syncthreads();
        const unsigned cw0 = mw0, cw1 = mw1;
        if (st + 1 < nsteps && !(dry && PROF_STOP == 21)) { DA_STAGE(st + 1, ((st + 1) & 1) * DA_BUF);
            if (MODE == 0) { const int kt = 2 * st + 2; mw0 = maskbuf[mask_index(b, j, kt, lane)]; mw1 = (kt + 1 <= j) ? maskbuf[mask_index(b, j, kt + 1, lane)] : 0u; } }
        f32x16 s0, s1;
#pragma unroll
        for (int r = 0; r < 16; ++r) { s0[r] = 0.f; s1[r] = 0.f; }
#pragma unroll
        for (int kk = 0; kk < NKK; ++kk) {
            const bf16x8 a0 = *(LAS const bf16x8*)(lds + (kA0 ^ (unsigned)(kk << 5)));
            const bf16x8 a1 = *(LAS const bf16x8*)(lds + (kA0 ^ (unsigned)(kk << 5)) + 32 * 512);
            s0 = MFMA32(a0, qf[kk], s0); s1 = MFMA32(a1, qf[kk], s1); }
        const bool far_ = MODE == 0 && (t0 - (kbase + 63)) >= 128;
        float sm = fmaxf(s0[0], s1[0]);
#pragma unroll
        for (int r = 1; r < 16; ++r) sm = fmaxf(sm, fmaxf(s0[r], s1[r]));
        sm = fmaxf(sm, __shfl_xor(sm, 32));
        const float mc = __builtin_fmaf(sm, C1, MODE == 0 ? (far_ ? b31 : bmaxh) : 0.f);
        if (__any(mc > m + 8.f)) {
            const float mnew = fmaxf(m, mc);
            const float alpha = __builtin_amdgcn_exp2f(m - mnew); l *= alpha;
            if (half == 0) wsc[q] = alpha;
            asm volatile("s_waitcnt lgkmcnt(0)" ::: "memory");
#pragma unroll
            for (int r = 0; r < 16; ++r) { const float a = wsc[crow(r, half)];
#pragma unroll
                for (int dt = 0; dt < 4; ++dt) o[dt][r] *= a; }
            m = mnew;
        }
        float ls = 0.f;
        if (MODE == 1) {
            const float nm = -m;
#pragma unroll
            for (int r = 0; r < 16; ++r) { s0[r] = __builtin_amdgcn_exp2f(__builtin_fmaf(s0[r], C1, nm)); s1[r] = __builtin_amdgcn_exp2f(__builtin_fmaf(s1[r], C1, nm)); ls += s0[r] + s1[r]; }
        } else if (far_) {
            const int bm = __float_as_int(b31 - m), NEGI = __float_as_int(-1e30f);
#pragma unroll
            for (int r = 0; r < 16; ++r) {
                const int k0 = __builtin_amdgcn_sbfe((int)cw0, r, 1), k1 = __builtin_amdgcn_sbfe((int)cw1, r, 1);
                const float a0 = __int_as_float((k0 & bm) | (~k0 & NEGI)), a1 = __int_as_float((k1 & bm) | (~k1 & NEGI));
                s0[r] = __builtin_amdgcn_exp2f(__builtin_fmaf(s0[r], C1, a0)); s1[r] = __builtin_amdgcn_exp2f(__builtin_fmaf(s1[r], C1, a1)); ls += s0[r] + s1[r]; }
        } else {
            const int NEGI = __float_as_int(-1e30f);
#pragma unroll
            for (int r = 0; r < 16; ++r) {
                int d0 = t0 + q - (kbase + crow(r, half)); int d1 = d0 - 32; d0 = d0 < 0 ? 0 : (d0 > 128 ? 128 : d0); d1 = d1 < 0 ? 0 : (d1 > 128 ? 128 : d1);
                const int b0 = __float_as_int(tbh[d0] - m), b1 = __float_as_int(tbh[d1] - m);
                const int k0 = __builtin_amdgcn_sbfe((int)cw0, r, 1), k1 = __builtin_amdgcn_sbfe((int)cw1, r, 1);
                const float a0 = __int_as_float((k0 & b0) | (~k0 & NEGI)), a1 = __int_as_float((k1 & b1) | (~k1 & NEGI));
                s0[r] = __builtin_amdgcn_exp2f(__builtin_fmaf(s0[r], C1, a0)); s1[r] = __builtin_amdgcn_exp2f(__builtin_fmaf(s1[r], C1, a1)); ls += s0[r] + s1[r]; }
        }
        l += ls;
#pragma unroll
        for (int u = 0; u < 2; ++u) {
#pragma unroll
            for (int ss = 0; ss < 2; ++ss) {
                u32x4 pw;
                if (u == 0) { pw.x = pk2(s0[8 * ss], s0[8 * ss + 1]); pw.y = pk2(s0[8 * ss + 2], s0[8 * ss + 3]); pw.z = pk2(s0[8 * ss + 4], s0[8 * ss + 5]); pw.w = pk2(s0[8 * ss + 6], s0[8 * ss + 7]); }
                else { pw.x = pk2(s1[8 * ss], s1[8 * ss + 1]); pw.y = pk2(s1[8 * ss + 2], s1[8 * ss + 3]); pw.z = pk2(s1[8 * ss + 4], s1[8 * ss + 5]); pw.w = pk2(s1[8 * ss + 6], s1[8 * ss + 7]); }
                const bf16x8 pa = __builtin_bit_cast(bf16x8, pw);
#pragma unroll
                for (int dt = 0; dt < 4; ++dt) {
                    const s16x4 lo = ds_tr(lds + (vA0 ^ (unsigned)(dt << 6)) + (32 * u + 16 * ss) * 512);
                    const s16x4 hi = ds_tr(lds + (vA0 ^ (unsigned)(dt << 6)) + (32 * u + 16 * ss + 8) * 512);
                    const bf16x8 vb = (bf16x8){lo[0], lo[1], lo[2], lo[3], hi[0], hi[1], hi[2], hi[3]};
                    o[dt] = MFMA32(pa, vb, o[dt]);
                }
            }
        }
        kA0 ^= DA_BUF; vA0 ^= DA_BUF;
    }
#undef DA_STAGE
    l += __shfl_xor(l, 32);
    if (half == 0) wsc[q] = 1.f / l;
    asm volatile("s_waitcnt lgkmcnt(0)" ::: "memory");
#pragma unroll
    for (int r = 0; r < 16; ++r) { const int qq = crow(r, half); const float a = wsc[qq];
        bf16_t* orow = U + (mq + qq) * LDU + (MODE == 0 ? C_DQ + h * 128 : C_XQ + h * 256 + c * 128) + q;
#pragma unroll
        for (int dt = 0; dt < 4; ++dt) { const bf16_t ov = (bf16_t)f2bf(o[dt][r] * a); if (!dry) orow[dt * 32] = ov; } }
}

constexpr int D4_GRP = 65536, D4_K = 0, D4_V = 16384, D4_BUF = 32768, D4_CNT = DA_END;
__device__ __forceinline__ void group_barrier(LAS unsigned* cnt, int lane) {
    asm volatile("s_waitcnt vmcnt(0) lgkmcnt(0)" ::: "memory");
    if (lane == 0) { const unsigned old = __hip_atomic_fetch_add(cnt, 1u, __ATOMIC_RELAXED, __HIP_MEMORY_SCOPE_WORKGROUP); const unsigned target = (old & ~3u) + 4u;
        while (__hip_atomic_load(cnt, __ATOMIC_RELAXED, __HIP_MEMORY_SCOPE_WORKGROUP) < target) __builtin_amdgcn_s_sleep(1); }
    asm volatile("" ::: "memory");
}
__device__ __forceinline__ float max3f_(float a, float b, float c) { float r; asm("v_max3_f32 %0, %1, %2, %3" : "=v"(r) : "v"(a), "v"(b), "v"(c)); return r; }
__device__ __forceinline__ void dsa_attend4_item(const Params& p, int idx, unsigned char* lds_, bool dry) {
    LAS char* lds = (LAS char*)lds_;
    bf16_t* U = Uptr(p); const unsigned short* maskbuf = (const unsigned short*)(p.ws + WS_MASK);
    const int tid = opaque_tid(), lane = tid & 63, wv = __builtin_amdgcn_readfirstlane(tid >> 6), q = lane & 31, half = lane >> 5;
    const int grp = wv >> 2, w4 = wv & 3, h = wv;
    const int b = idx & 3, j = idx >> 2, t0 = 32 * j; const size_t mb = (size_t)b * SEQ;
    LAS const float* tbh = (LAS const float*)(lds + DA_TB) + h * 132; LAS float* wsc = (LAS float*)(lds + DA_WS) + wv * 64;
    LAS unsigned* gcnt = (LAS unsigned*)(lds + D4_CNT) + grp * 16;
    constexpr float C1 = 0.08838834764831845f * 1.4426950408889634f;
    const float b31 = tbh[128], bmaxh = tbh[129];
    const int nsteps = (j >> 1) + 1;
    const unsigned gb = grp * D4_GRP;
    const int sr = 4 * w4 + (lane >> 4), spc = lane & 15;
    const bf16_t* gk = U + (mb + sr) * LDU + C_DK + grp * 128 + ((spc ^ (sr & 15)) << 3);
    const bf16_t* gv = U + (mb + sr) * LDU + C_DV + grp * 128 + ((spc ^ ((sr & 3) << 2)) << 3);
#define D4_STAGE(st_, bufoff_) do { const size_t go_ = (size_t)(64 * (st_)) * LDU; _Pragma("unroll") for (int i_ = 0; i_ < 4; ++i_) { \
        __builtin_amdgcn_global_load_lds((const unsigned*)(gk + go_ + (size_t)16 * i_ * LDU), (LAS unsigned*)(lds + gb + (bufoff_) + D4_K + (w4 + 4 * i_) * 1024), 16, 0, 0); \
        __builtin_amdgcn_global_load_lds((const unsigned*)(gv + go_ + (size_t)16 * i_ * LDU), (LAS unsigned*)(lds + gb + (bufoff_) + D4_V + (w4 + 4 * i_) * 1024), 16, 0, 0); } } while (0)
    group_barrier(gcnt, lane);
    D4_STAGE(0, 0);
    bf16x8 qf[8];
    { const bf16_t* ur = U + (mb + t0 + q) * LDU + C_DQ + h * 128 + 8 * half;
#pragma unroll
      for (int kk = 0; kk < 8; ++kk) qf[kk] = *(const bf16x8*)(ur + kk * 16); }
    f32x16 o[4];
#pragma unroll
    for (int dt = 0; dt < 4; ++dt)
#pragma unroll
        for (int r = 0; r < 16; ++r) o[dt][r] = 0.f;
    float m = -1e20f, l = 0.f;
    unsigned kA0, vA0;
    { const int q4 = (lane & 15) >> 2, p4 = lane & 3, g1 = (lane >> 4) & 1;
      kA0 = gb + D4_K + q * 256 + ((half ^ (q & 15)) << 4);
      vA0 = gb + D4_V + (4 * half + q4) * 256 + (((2 * g1 + (p4 >> 1)) ^ (q4 << 2)) << 4) + (p4 & 1) * 8; }
    unsigned mw0 = maskbuf[mask_index(b, j, 0, lane)], mw1 = (1 <= j) ? maskbuf[mask_index(b, j, 1, lane)] : 0u;
#pragma unroll 1
    for (int st = 0; st < nsteps; ++st) {
        const int kbase = 64 * st;
        group_barrier(gcnt, lane);
        const unsigned cw0 = mw0, cw1 = mw1;
        if (st + 1 < nsteps) { D4_STAGE(st + 1, ((st + 1) & 1) * D4_BUF);
            const int kt = 2 * st + 2; mw0 = maskbuf[mask_index(b, j, kt, lane)]; mw1 = (kt + 1 <= j) ? maskbuf[mask_index(b, j, kt + 1, lane)] : 0u; }
        f32x16 s0, s1;
#pragma unroll
        for (int r = 0; r < 16; ++r) { s0[r] = 0.f; s1[r] = 0.f; }
#pragma unroll
        for (int kk = 0; kk < 8; ++kk) {
            const bf16x8 a0 = *(LAS const bf16x8*)(lds + (kA0 ^ (unsigned)(kk << 5)));
            const bf16x8 a1 = *(LAS const bf16x8*)(lds + (kA0 ^ (unsigned)(kk << 5)) + 32 * 256);
            s0 = MFMA32(a0, qf[kk], s0); s1 = MFMA32(a1, qf[kk], s1); }
        const bool far_ = (t0 - (kbase + 63)) >= 128;
        float sm = max3f_(s0[0], s1[0], s0[1]);
#pragma unroll
        for (int r = 1; r < 16; ++r) sm = (r < 15) ? max3f_(sm, s1[r], s0[r + 1]) : fmaxf(sm, s1[r]);
        sm = fmaxf(sm, __shfl_xor(sm, 32));
        const float mc = __builtin_fmaf(sm, C1, far_ ? b31 : bmaxh);
        if (__any(mc > m + 8.f)) {
            const float mnew = fmaxf(m, mc);
            const float alpha = __builtin_amdgcn_exp2f(m - mnew); l *= alpha;
            if (half == 0) wsc[q] = alpha;
            asm volatile("s_waitcnt lgkmcnt(0)" ::: "memory");
#pragma unroll
            for (int r = 0; r < 16; ++r) { const float a = wsc[crow(r, half)];
#pragma unroll
                for (int dt = 0; dt < 4; ++dt) o[dt][r] *= a; }
            m = mnew;
        }
        float ls = 0.f;
        if (far_) {
            const int bm = __float_as_int(b31 - m), NEGI = __float_as_int(-1e30f);
#pragma unroll
            for (int r = 0; r < 16; ++r) {
                const int k0 = __builtin_amdgcn_sbfe((int)cw0, r, 1), k1 = __builtin_amdgcn_sbfe((int)cw1, r, 1);
                const float a0 = __int_as_float((k0 & bm) | (~k0 & NEGI)), a1 = __int_as_float((k1 & bm) | (~k1 & NEGI));
                s0[r] = __builtin_amdgcn_exp2f(__builtin_fmaf(s0[r], C1, a0)); s1[r] = __builtin_amdgcn_exp2f(__builtin_fmaf(s1[r], C1, a1)); ls += s0[r] + s1[r]; }
        } else {
            const int NEGI = __float_as_int(-1e30f);
#pragma unroll
            for (int r = 0; r < 16; ++r) {
                int d0 = t0 + q - (kbase + crow(r, half)); int d1 = d0 - 32; d0 = d0 < 0 ? 0 : (d0 > 128 ? 128 : d0); d1 = d1 < 0 ? 0 : (d1 > 128 ? 128 : d1);
                const int b0 = __float_as_int(tbh[d0] - m), b1 = __float_as_int(tbh[d1] - m);
                const int k0 = __builtin_amdgcn_sbfe((int)cw0, r, 1), k1 = __builtin_amdgcn_sbfe((int)cw1, r, 1);
                const float a0 = __int_as_float((k0 & b0) | (~k0 & NEGI)), a1 = __int_as_float((k1 & b1) | (~k1 & NEGI));
                s0[r] = __builtin_amdgcn_exp2f(__builtin_fmaf(s0[r], C1, a0)); s1[r] = __builtin_amdgcn_exp2f(__builtin_fmaf(s1[r], C1, a1)); ls += s0[r] + s1[r]; }
        }
        l += ls;
#pragma unroll
        for (int u = 0; u < 2; ++u) {
#pragma unroll
            for (int ss = 0; ss < 2; ++ss) {
                u32x4 pw;
                if (u == 0) { pw.x = pk2(s0[8 * ss], s0[8 * ss + 1]); pw.y = pk2(s0[8 * ss + 2], s0[8 * ss + 3]); pw.z = pk2(s0[8 * ss + 4], s0[8 * ss + 5]); pw.w = pk2(s0[8 * ss + 6], s0[8 * ss + 7]); }
                else { pw.x = pk2(s1[8 * ss], s1[8 * ss + 1]); pw.y = pk2(s1[8 * ss + 2], s1[8 * ss + 3]); pw.z = pk2(s1[8 * ss + 4], s1[8 * ss + 5]); pw.w = pk2(s1[8 * ss + 6], s1[8 * ss + 7]); }
                const bf16x8 pa = __builtin_bit_cast(bf16x8, pw);
#pragma unroll
                for (int dt = 0; dt < 4; ++dt) {
                    const s16x4 lo = ds_tr(lds + (vA0 ^ (unsigned)(dt << 6)) + (32 * u + 16 * ss) * 256);
                    const s16x4 hi = ds_tr(lds + (vA0 ^ (unsigned)(dt << 6)) + (32 * u + 16 * ss + 8) * 256);
                    const bf16x8 vb = (bf16x8){lo[0], lo[1], lo[2], lo[3], hi[0], hi[1], hi[2], hi[3]};
                    o[dt] = MFMA32(pa, vb, o[dt]);
                }
            }
        }
        kA0 ^= D4_BUF; vA0 ^= D4_BUF;
    }
#undef D4_STAGE
    l += __shfl_xor(l, 32);
    if (half == 0) wsc[q] = 1.f / l;
    asm volatile("s_waitcnt lgkmcnt(0)" ::: "memory");
#pragma unroll
    for (int r = 0; r < 16; ++r) { const int qq = crow(r, half); const float a = wsc[qq];
        bf16_t* orow = U + (mb + t0 + qq) * LDU + C_DQ + h * 128 + q;
#pragma unroll
        for (int dt = 0; dt < 4; ++dt) { const bf16_t ov = (bf16_t)f2bf(o[dt][r] * a); if (!dry) orow[dt * 32] = ov; } }
}
__device__ void phase_dsa_attend4(const Params& p, int bid, int nb, unsigned char* lds, bool dry) {
    { float* tb = (float*)(lds + DA_TB);
      for (int e = threadIdx.x; e < 8 * 129; e += NTHREADS) { const int hh = e / 129, d = e % 129; tb[hh * 132 + d] = p.rel_bias[(d < 128 ? (int)T5B[d] : 31) * 8 + hh] * 1.4426950408889634f; }
      if (threadIdx.x < 8) { float mx = -1e30f; for (int bk = 0; bk < 32; ++bk) mx = fmaxf(mx, p.rel_bias[bk * 8 + threadIdx.x]); tb[threadIdx.x * 132 + 129] = mx * 1.4426950408889634f; }
      if (threadIdx.x < 32) ((unsigned*)(lds + D4_CNT))[threadIdx.x] = 0u; }
    __syncthreads();
    const int grp = __builtin_amdgcn_readfirstlane(threadIdx.x >> 8);
    for (int k = bid; k < 256; k += nb) {
        const int ia = k, ib = ((127 - (k >> 2)) << 2) | (k & 3);
#pragma unroll 1
        for (int r = 0; r < 2; ++r) dsa_attend4_item(p, (r ^ grp) ? ib : ia, lds, dry);
    }
    __syncthreads();
}

__device__ void phase_cross_attend(const Params& p, int bid, int nb, unsigned char* lds, bool dry) {
    for (int k = bid; k < 512; k += nb) attend_item<1>(p, k, lds, dry);
}
__device__ void phase_dsa_attend(const Params& p, int bid, int nb, unsigned char* lds, bool dry) {
    { float* tb = (float*)(lds + DA_TB);
      for (int e = threadIdx.x; e < 8 * 129; e += NTHREADS) { const int hh = e / 129, d = e % 129; tb[hh * 132 + d] = p.rel_bias[(d < 128 ? (int)T5B[d] : 31) * 8 + hh] * 1.4426950408889634f; }
      if (threadIdx.x < 8) { float mx = -1e30f; for (int bk = 0; bk < 32; ++bk) mx = fmaxf(mx, p.rel_bias[bk * 8 + threadIdx.x]); tb[threadIdx.x * 132 + 129] = mx * 1.4426950408889634f; } }
    __syncthreads();
    for (int k2 = 2 * bid; k2 < 512; k2 += (k2 & 1) ? 2 * nb - 1 : 1) { const int k = k2 >> 1; attend_item<0>(p, (k2 & 1) ? (((127 - (k >> 2)) << 2) | (k & 3)) : k, lds, dry); }
}


constexpr size_t WS_GD = 44 * MiB;
static_assert(WS_MASK + (size_t)4 * TRI * 128 <= WS_GD && WS_GD + 1024 * 128 * 4 <= WS_U, "ws map (mask, gla decay)");
__device__ __forceinline__ void gla_stage_v(LAS char* vdst, const bf16_t* Uc, int h, int tid) {
    const int lane = tid & 63, wv = __builtin_amdgcn_readfirstlane(tid >> 6), half = lane >> 5, srow = 2 * wv + half, spc = lane & 31;
    const bf16_t* gv = Uc + (size_t)srow * LDU + C_GV + h * 256 + ((spc ^ ((srow & 3) << 2)) << 3);
#pragma unroll
    for (int i = 0; i < 4; ++i) __builtin_amdgcn_global_load_lds((const unsigned*)(gv + (size_t)16 * i * LDU), (LAS unsigned*)(vdst + (wv + 8 * i) * 1024), 16, 0, 0);
}
constexpr int G1_KT = 0, G1_V = 16384, G1_B = 49152, G1_GA = 81920, G1_SEG = 83968, G1_BT = 86016;
__device__ __forceinline__ void gla_g1_item(const Params& p, int item, unsigned char* lds_, bool dry) {
    LAS char* lds = (LAS char*)lds_;
    bf16_t* U = Uptr(p); bf16_t* GS = (bf16_t*)p.out; float* GD = (float*)(p.ws + WS_GD);
    const int tid = opaque_tid(), lane = tid & 63, wv = __builtin_amdgcn_readfirstlane(tid >> 6), half = lane >> 5;
    const int bh = item >> 6, n = item & 63, b = bh >> 2, h = bh & 3;
    bf16_t* Uc = U + ((size_t)b * SEQ + 64 * n) * LDU;
    const int d8 = tid & 15, tg = tid >> 4;
    const u32x4 qa = *(const u32x4*)(Uc + (size_t)(2 * tg) * LDU + C_GQ + h * 128 + 8 * d8), qb = *(const u32x4*)(Uc + (size_t)(2 * tg + 1) * LDU + C_GQ + h * 128 + 8 * d8);
    const u32x4 ka = *(const u32x4*)(Uc + (size_t)(2 * tg) * LDU + C_GK + h * 128 + 8 * d8), kb = *(const u32x4*)(Uc + (size_t)(2 * tg + 1) * LDU + C_GK + h * 128 + 8 * d8);
    u32x4 gav = (u32x4){0u, 0u, 0u, 0u}; if (tid < 128) gav = *(const u32x4*)(Uc + (size_t)(tid >> 1) * LDU + C_GA + 8 * (tid & 1));
    __syncthreads();
    if (tid < 128) *(LAS u32x4*)(lds + G1_GA + tid * 16) = gav;
    gla_stage_v(lds + G1_V, Uc, h, tid);
    __syncthreads();
    { const int d = tid & 127, seg = tid >> 7;
      float w[16];
#pragma unroll
      for (int r = 0; r < 16; ++r) w[r] = p.w_a_up[r * 512 + h * 128 + d];
      const float ba = p.b_a[h * 128 + d];
      float bl[16]; float cum = 0.f;
#pragma unroll
      for (int i = 0; i < 16; ++i) {
          const u32x4 g0 = *(LAS const u32x4*)(lds + G1_GA + (16 * seg + i) * 32), g1 = *(LAS const u32x4*)(lds + G1_GA + (16 * seg + i) * 32 + 16);
          float x = ba;
          x += __uint_as_float(g0.x << 16) * w[0] + __uint_as_float(g0.x & 0xffff0000u) * w[1] + __uint_as_float(g0.y << 16) * w[2] + __uint_as_float(g0.y & 0xffff0000u) * w[3];
          x += __uint_as_float(g0.z << 16) * w[4] + __uint_as_float(g0.z & 0xffff0000u) * w[5] + __uint_as_float(g0.w << 16) * w[6] + __uint_as_float(g0.w & 0xffff0000u) * w[7];
          x += __uint_as_float(g1.x << 16) * w[8] + __uint_as_float(g1.x & 0xffff0000u) * w[9] + __uint_as_float(g1.y << 16) * w[10] + __uint_as_float(g1.y & 0xffff0000u) * w[11];
          x += __uint_as_float(g1.z << 16) * w[12] + __uint_as_float(g1.z & 0xffff0000u) * w[13] + __uint_as_float(g1.w << 16) * w[14] + __uint_as_float(g1.w & 0xffff0000u) * w[15];
          const float sp = __builtin_amdgcn_logf(1.f + __builtin_amdgcn_exp2f(-1.4426950408889634f * fmaxf(x, -80.f)));
          cum += -0.04332169878499658f * sp; bl[i] = cum;
      }
      LAS float* segsum = (LAS float*)(lds + G1_SEG);
      segsum[seg * 128 + d] = cum;
      __syncthreads();
      float off = 0.f, tot = 0.f;
#pragma unroll
      for (int s2 = 0; s2 < 4; ++s2) { const float v = segsum[s2 * 128 + d]; tot += v; if (s2 < seg) off += v; }
#pragma unroll
      for (int i = 0; i < 16; ++i) *(LAS float*)(lds + G1_B + ((16 * seg + i) * 128 + d) * 4) = bl[i] + off;
      if (seg == 0) { *(LAS float*)(lds + G1_BT + d * 4) = tot; GD[(size_t)item * 128 + d] = __builtin_amdgcn_exp2f(1.4426950408889634f * tot); } }
    __syncthreads();
    { unsigned qo[2][4], ko[2][4]; float kt_[2][8];
#pragma unroll
      for (int tt = 0; tt < 2; ++tt) { const int t = 2 * tg + tt; const u32x4 qv = tt ? qb : qa, kv = tt ? kb : ka;
          const f32x4 b0 = *(LAS const f32x4*)(lds + G1_B + (t * 128 + 8 * d8) * 4), b1 = *(LAS const f32x4*)(lds + G1_B + (t * 128 + 8 * d8 + 4) * 4);
          const f32x4 t0 = *(LAS const f32x4*)(lds + G1_BT + (8 * d8) * 4), t1 = *(LAS const f32x4*)(lds + G1_BT + (8 * d8 + 4) * 4);
          float qd[8], kd[8];
#pragma unroll
          for (int e = 0; e < 8; ++e) { const unsigned qw = e < 2 ? qv.x : e < 4 ? qv.y : e < 6 ? qv.z : qv.w, kw = e < 2 ? kv.x : e < 4 ? kv.y : e < 6 ? kv.z : kv.w;
              const float qf = (e & 1) ? __uint_as_float(qw & 0xffff0000u) : __uint_as_float(qw << 16), kf = (e & 1) ? __uint_as_float(kw & 0xffff0000u) : __uint_as_float(kw << 16);
              const float bb = e < 4 ? b0[e & 3] : b1[e & 3], bt = e < 4 ? t0[e & 3] : t1[e & 3];
              const float ep = __builtin_amdgcn_exp2f(1.4426950408889634f * bb), em = __builtin_amdgcn_exp2f(-1.4426950408889634f * bb);
              qd[e] = qf * 0.08838834764831845f * ep; kd[e] = kf * em; kt_[tt][e] = kf * __builtin_amdgcn_exp2f(1.4426950408889634f * (bt - bb)); }
#pragma unroll
          for (int e = 0; e < 4; ++e) { qo[tt][e] = pk2(qd[2 * e], qd[2 * e + 1]); ko[tt][e] = pk2(kd[2 * e], kd[2 * e + 1]); } }
      if (!dry) {
      if (!dry) {
      *(u32x4*)(Uc + (size_t)(2 * tg) * LDU + C_GQ + h * 128 + 8 * d8) = (u32x4){qo[0][0], qo[0][1], qo[0][2], qo[0][3]};
      *(u32x4*)(Uc + (size_t)(2 * tg + 1) * LDU + C_GQ + h * 128 + 8 * d8) = (u32x4){qo[1][0], qo[1][1], qo[1][2], qo[1][3]};
      *(u32x4*)(Uc + (size_t)(2 * tg) * LDU + C_GK + h * 128 + 8 * d8) = (u32x4){ko[0][0], ko[0][1], ko[0][2], ko[0][3]};
      *(u32x4*)(Uc + (size_t)(2 * tg + 1) * LDU + C_GK + h * 128 + 8 * d8) = (u32x4){ko[1][0], ko[1][1], ko[1][2], ko[1][3]}; } }
#pragma unroll
      for (int e = 0; e < 8; ++e) { const int d = 8 * d8 + e; const int ch = (tg >> 2) ^ ((d >> 1) & 7);
          *(LAS unsigned*)(lds + G1_KT + d * 128 + (ch << 4) + (tg & 3) * 4) = pk2(kt_[0][e], kt_[1][e]); } }
    asm volatile("s_waitcnt vmcnt(0)" ::: "memory");
    __syncthreads();
    f32x16 acc[4];
#pragma unroll
    for (int i = 0; i < 4; ++i)
#pragma unroll
        for (int r = 0; r < 16; ++r) acc[i][r] = 0.f;
    const int dk = 32 * (wv & 3) + (lane & 31), q4 = (lane & 15) >> 2, p4 = lane & 3, g1 = (lane >> 4) & 1;
#pragma unroll
    for (int s_ = 0; s_ < 4; ++s_) {
        const bf16x8 a = *(LAS const bf16x8*)(lds + G1_KT + dk * 128 + (((2 * s_ + half) ^ ((dk >> 1) & 7)) << 4));
#pragma unroll
        for (int i = 0; i < 4; ++i) { const int dtile = 4 * (wv >> 2) + i; const int ch = (dtile * 4 + 2 * g1 + (p4 >> 1)) ^ (q4 << 2);
            const s16x4 lo = ds_tr(lds + G1_V + (16 * s_ + 8 * half + q4) * 512 + (ch << 4) + (p4 & 1) * 8);
            const s16x4 hi = ds_tr(lds + G1_V + (16 * s_ + 8 * half + 4 + q4) * 512 + (ch << 4) + (p4 & 1) * 8);
            const bf16x8 vb = (bf16x8){lo[0], lo[1], lo[2], lo[3], hi[0], hi[1], hi[2], hi[3]};
            acc[i] = MFMA32(a, vb, acc[i]); }
    }
    bf16_t* gs = GS + (size_t)item * 32768;
#pragma unroll
    for (int i = 0; i < 4; ++i) { const int dv = 32 * (4 * (wv >> 2) + i) + (lane & 31);
#pragma unroll
        for (int r4 = 0; r4 < 4; ++r4) { u32x2 w2; w2.x = pk2(acc[i][4 * r4], acc[i][4 * r4 + 1]); w2.y = pk2(acc[i][4 * r4 + 2], acc[i][4 * r4 + 3]);
            *(u32x2*)(gs + (size_t)dv * 128 + 32 * (wv & 3) + 8 * r4 + 4 * half) = w2; } }
}
__device__ void phase_gla_g1(const Params& p, int bid, int nb, unsigned char* lds, bool dry) { for (int it = bid; it < 1024; it += nb) gla_g1_item(p, it, lds, dry); }
__device__ void phase_gla_g2(const Params& p, int bid, int nb, bool dry) {
    bf16_t* GS = (bf16_t*)p.out; const float* GD = (const float*)(p.ws + WS_GD);
    for (int e = bid * NTHREADS + threadIdx.x; e < 16 * 8192; e += nb * NTHREADS) {
        const int bh = e >> 13, w = e & 8191, dk4 = (w & 31) * 4;
        bf16_t* gp = GS + (size_t)bh * 64 * 32768 + (size_t)w * 4; const float* dp = GD + (size_t)bh * 64 * 128 + dk4;
        f32x4 S = (f32x4){0.f, 0.f, 0.f, 0.f};
#pragma unroll 8
        for (int n = 0; n < 64; ++n) {
            const u32x2 t2 = *(const u32x2*)(gp + (size_t)n * 32768); const f32x4 dc = *(const f32x4*)(dp + n * 128);
            u32x2 o2; o2.x = pk2(S[0], S[1]); o2.y = pk2(S[2], S[3]); if (!dry) *(u32x2*)(gp + (size_t)n * 32768) = o2;
            S[0] = dc[0] * S[0] + __uint_as_float(t2.x << 16); S[1] = dc[1] * S[1] + __uint_as_float(t2.x & 0xffff0000u);
            S[2] = dc[2] * S[2] + __uint_as_float(t2.y << 16); S[3] = dc[3] * S[3] + __uint_as_float(t2.y & 0xffff0000u);
        }
    }
}
constexpr int G3_QD = 0, G3_KD = 16384, G3_V = 32768, G3_SSQ = 65536;
__device__ __forceinline__ void gla_g3_item(const Params& p, int item, unsigned char* lds_, bool dry) {
    LAS char* lds = (LAS char*)lds_;
    bf16_t* U = Uptr(p); const bf16_t* GS = (const bf16_t*)p.out;
    const int tid = opaque_tid(), lane = tid & 63, wv = __builtin_amdgcn_readfirstlane(tid >> 6), half = lane >> 5, q = lane & 31;
    const int bh = item >> 6, n = item & 63, b = bh >> 2, h = bh & 3;
    bf16_t* Uc = U + ((size_t)b * SEQ + 64 * n) * LDU;
    LAS float* ssq = (LAS float*)(lds + G3_SSQ);
    __syncthreads();
    { const int r4 = lane >> 4, pc = lane & 15;
#pragma unroll
      for (int i = 0; i < 2; ++i) { const int row = 4 * (wv + 8 * i) + r4; const bf16_t* src = Uc + (size_t)row * LDU + h * 128 + ((pc ^ (row & 15)) << 3);
          __builtin_amdgcn_global_load_lds((const unsigned*)(src + C_GQ), (LAS unsigned*)(lds + G3_QD + (wv + 8 * i) * 1024), 16, 0, 0);
          __builtin_amdgcn_global_load_lds((const unsigned*)(src + C_GK), (LAS unsigned*)(lds + G3_KD + (wv + 8 * i) * 1024), 16, 0, 0); } }
    gla_stage_v(lds + G3_V, Uc, h, tid);
    if (tid < 64) ssq[tid] = 0.f;
    bf16x8 sf[8];
    { const bf16_t* sp = GS + (size_t)item * 32768 + (size_t)(32 * wv + q) * 128 + 8 * half;
#pragma unroll
      for (int kk = 0; kk < 8; ++kk) sf[kk] = *(const bf16x8*)(sp + kk * 16); }
    asm volatile("s_waitcnt vmcnt(0)" ::: "memory");
    __syncthreads();
    f32x16 o[2];
#pragma unroll
    for (int tt = 0; tt < 2; ++tt)
#pragma unroll
        for (int r = 0; r < 16; ++r) o[tt][r] = 0.f;
    const int q4 = (lane & 15) >> 2, p4 = lane & 3, g1 = (lane >> 4) & 1;
    const unsigned vA = G3_V + (4 * half + q4) * 512 + ((((wv * 4 + 2 * g1 + (p4 >> 1))) ^ (q4 << 2)) << 4) + (p4 & 1) * 8;
#pragma unroll
    for (int tt = 0; tt < 2; ++tt) {
#pragma unroll
        for (int kk = 0; kk < 8; ++kk) { const int t = 32 * tt + q;
            const bf16x8 a = *(LAS const bf16x8*)(lds + G3_QD + t * 256 + (((2 * kk + half) ^ (t & 15)) << 4));
            o[tt] = MFMA32(a, sf[kk], o[tt]); }
#pragma unroll
        for (int st = 0; st <= tt; ++st) {
            f32x16 x;
#pragma unroll
            for (int r = 0; r < 16; ++r) x[r] = 0.f;
#pragma unroll
            for (int kk = 0; kk < 8; ++kk) { const int srow = 32 * st + q, trow = 32 * tt + q;
                const bf16x8 a = *(LAS const bf16x8*)(lds + G3_KD + srow * 256 + (((2 * kk + half) ^ (srow & 15)) << 4));
                const bf16x8 bq = *(LAS const bf16x8*)(lds + G3_QD + trow * 256 + (((2 * kk + half) ^ (trow & 15)) << 4));
                x = MFMA32(a, bq, x); }
            if (st == tt) {
#pragma unroll
                for (int r = 0; r < 16; ++r) x[r] = (crow(r, half) <= q) ? x[r] : 0.f;
            }
#pragma unroll
            for (int ss = 0; ss < 2; ++ss) {
                u32x4 pw; pw.x = pk2(x[8 * ss], x[8 * ss + 1]); pw.y = pk2(x[8 * ss + 2], x[8 * ss + 3]); pw.z = pk2(x[8 * ss + 4], x[8 * ss + 5]); pw.w = pk2(x[8 * ss + 6], x[8 * ss + 7]);
                const bf16x8 pa = __builtin_bit_cast(bf16x8, pw);
                const s16x4 lo = ds_tr(lds + vA + (32 * st + 16 * ss) * 512);
                const s16x4 hi = ds_tr(lds + vA + (32 * st + 16 * ss + 8) * 512);
                const bf16x8 vb = (bf16x8){lo[0], lo[1], lo[2], lo[3], hi[0], hi[1], hi[2], hi[3]};
                o[tt] = MFMA32(pa, vb, o[tt]);
            }
        }
    }
#pragma unroll
    for (int tt = 0; tt < 2; ++tt)
#pragma unroll
        for (int r = 0; r < 16; ++r) { float v = o[tt][r] * o[tt][r];
            v += __shfl_xor(v, 1); v += __shfl_xor(v, 2); v += __shfl_xor(v, 4); v += __shfl_xor(v, 8); v += __shfl_xor(v, 16);
            if (q == 0) __hip_atomic_fetch_add(ssq + 32 * tt + crow(r, half), v, __ATOMIC_RELAXED, __HIP_MEMORY_SCOPE_WORKGROUP); }
    __syncthreads();
    const float gg = p.g_gla[32 * wv + q];
#pragma unroll
    for (int tt = 0; tt < 2; ++tt)
#pragma unroll
        for (int r = 0; r < 16; ++r) { const int t = 32 * tt + crow(r, half); const float rstd = 1.f / sqrtf(ssq[t] * (1.f / 256.f) + EPS);
            const bf16_t ov = (bf16_t)f2bf(o[tt][r] * rstd * gg); if (!dry) Uc[(size_t)t * LDU + C_GV + h * 256 + 32 * wv + q] = ov; }
}
__device__ void phase_gla_g3(const Params& p, int bid, int nb, unsigned char* lds, bool dry) { for (int it = bid; it < 1024; it += nb) gla_g3_item(p, it, lds, dry); }

__device__ void phase_cross_ref(const Params& p, int bid, int nb, unsigned char* lds) {
    float* qs = (float*)lds;
    float* lg = qs + 1024;
    bf16_t* U = Uptr(p); const bf16_t* MKV = (const bf16_t*)(p.ws + WS_MKV);
    const int tid = threadIdx.x, lane = tid & 63, wave = tid >> 6;
    for (int it = bid; it < MTOK; it += nb) {
        const int b = it / SEQ; const size_t m = (size_t)it; const bf16_t* mb = MKV + (size_t)b * NMEM * 2048;
        __syncthreads();
        qs[tid] = bf2f(U[m * LDU + C_XQ + tid]) * 0.0625f; qs[tid + 512] = bf2f(U[m * LDU + C_XQ + 512 + tid]) * 0.0625f;
        __syncthreads();
        { const int j = tid & 255, hp = tid >> 8;
          const bf16_t* kr = mb + (size_t)j * 2048 + hp * 512; float a0 = 0.f, a1 = 0.f;
          for (int d0 = 0; d0 < 256; d0 += 8) { const bf16x8 k0 = *(const bf16x8*)(kr + d0); const bf16x8 k1 = *(const bf16x8*)(kr + 256 + d0);
#pragma unroll
              for (int dd = 0; dd < 8; ++dd) { a0 += qs[hp * 512 + d0 + dd] * bf2f((bf16_t)k0[dd]); a1 += qs[hp * 512 + 256 + d0 + dd] * bf2f((bf16_t)k1[dd]); } }
          lg[(2 * hp) * 256 + j] = a0; lg[(2 * hp + 1) * 256 + j] = a1; }
        __syncthreads();
        if (wave < 4) { float v[4]; float mx = -3e38f;
#pragma unroll
            for (int i = 0; i < 4; ++i) { v[i] = lg[wave * 256 + lane + 64 * i]; mx = fmaxf(mx, v[i]); }
            mx = wave_max(mx); float sm = 0.f;
#pragma unroll
            for (int i = 0; i < 4; ++i) { v[i] = __expf(v[i] - mx); sm += v[i]; }
            sm = wave_sum(sm); const float inv = 1.f / sm;
#pragma unroll
            for (int i = 0; i < 4; ++i) lg[wave * 256 + lane + 64 * i] = v[i] * inv; }
        __syncthreads();
        { const int h = tid >> 7, d = (tid & 127) * 2; float o0 = 0.f, o1 = 0.f;
          for (int j = 0; j < NMEM; ++j) { const float pj = lg[h * 256 + j]; const unsigned w = *(const unsigned*)(mb + (size_t)j * 2048 + 1024 + h * 256 + d);
              o0 += pj * __uint_as_float(w << 16); o1 += pj * __uint_as_float(w & 0xffff0000u); }
          *(unsigned*)(U + m * LDU + C_XQ + h * 256 + d) = pk2(o0, o1); }
    }
}

__device__ void phase_final(const Params& p, int bid, int nb, bool dry) {
    const int lane = threadIdx.x & 63, wave = threadIdx.x >> 6;
    for (int m = bid * NWAVES + wave; m < MTOK; m += nb * NWAVES) {
        f32x4* orow = (f32x4*)(p.out + (size_t)m * DM) + lane; const f32x4* xr = (const f32x4*)(p.x + (size_t)m * DM) + lane; const f32x4* gr = (const f32x4*)p.g_post + lane;
        f32x4 v[4]; float s = 0.f;
#pragma unroll
        for (int j = 0; j < 4; ++j) { v[j] = orow[64 * j]; s += (v[j].x * v[j].x + v[j].y * v[j].y) + (v[j].z * v[j].z + v[j].w * v[j].w); }
        const float rstd = 1.f / sqrtf(wave_sum(s) * (1.f / DM) + EPS);
#pragma unroll
        for (int j = 0; j < 4; ++j) { const f32x4 ov = xr[64 * j] + v[j] * rstd * gr[64 * j]; if (!dry) orow[64 * j] = ov; }
    }
}


#define XB_TMO      128
#define XB_XCNT(j)  (256  + 64 * (j))
#define XB_XSUB(j)  (1280 + 64 * (j))
#define XB_XGEN(j)  (2304 + 64 * (j))
#define XB_TOP      3328
#define XB_TOPGEN   3392
#define XCD_BAR_WORDS 3456
#define XB_SPIN_CAP (1u << 22)
constexpr size_t WS_BAR = 46 * MiB;
__device__ __forceinline__ unsigned xb_ld(unsigned* p)              { return __hip_atomic_load(p, __ATOMIC_RELAXED, __HIP_MEMORY_SCOPE_AGENT); }
__device__ __forceinline__ unsigned xb_add(unsigned* p, unsigned v) { return __hip_atomic_fetch_add(p, v, __ATOMIC_RELAXED, __HIP_MEMORY_SCOPE_AGENT); }
__device__ __forceinline__ unsigned xb_xcc_id() { return (unsigned)__builtin_amdgcn_s_getreg((3 << 11) | 20) & 0xFu; }
#define XB_SPIN(cond, bar) do { unsigned _sp = 0; while (cond) { __builtin_amdgcn_s_sleep(1); \
    if ((++_sp & 255u) == 0u) { if (xb_ld(&(bar)[XB_TMO])) break; if (_sp > XB_SPIN_CAP) { atomicAdd(&(bar)[XB_TMO], 1u); break; } } } } while (0)
struct XcdBarrier { unsigned* bar; unsigned x; volatile LAS unsigned* st; };
__device__ __forceinline__ XcdBarrier xcd_barrier_post(unsigned* bar, volatile LAS unsigned* st) {
    XcdBarrier b; b.bar = bar; b.x = xb_xcc_id(); b.st = st;
    if (threadIdx.x == 0) (void)xb_add(&bar[XB_XCNT(b.x)], 1u);
    return b;
}
__device__ __forceinline__ void xcd_barrier_complete(unsigned* bar, unsigned x, unsigned& nloc, unsigned& nx) {
    const unsigned G = gridDim.x * gridDim.y * gridDim.z;
    unsigned sum, cnt, mine, sp = 0u;
    for (;;) {
        sum = 0u; cnt = 0u; mine = 0u;
#pragma unroll
        for (unsigned j = 0; j < 16; ++j) { const unsigned c = xb_ld(&bar[XB_XCNT(j)]); sum += c; cnt += (c > 0u) ? 1u : 0u; mine = (j == x) ? c : mine; }
        if (sum == G) break;
        __builtin_amdgcn_s_sleep(1);
        if ((++sp & 255u) == 0u) { if (xb_ld(&bar[XB_TMO])) break; if (sp > XB_SPIN_CAP) { atomicAdd(&bar[XB_TMO], 1u); break; } }
    }
    nloc = mine > 0u ? mine : 1u; nx = cnt > 0u ? cnt : 1u;
}
__device__ __forceinline__ void xcd_barrier(const XcdBarrier& b) {
    asm volatile("s_waitcnt vmcnt(0)" ::: "memory");
    __syncthreads();
    if (threadIdx.x == 0) {
        unsigned* bar = b.bar;
        __builtin_amdgcn_s_waitcnt(0);
        unsigned nloc = b.st[0], nx = b.st[1];
        if (nloc == 0u) { xcd_barrier_complete(bar, b.x, nloc, nx); b.st[0] = nloc; b.st[1] = nx; }
        const unsigned old = xb_add(&bar[XB_XSUB(b.x)], 1u);
        const unsigned gen = old / nloc;
        if (old + 1u == (gen + 1u) * nloc) {
            __builtin_amdgcn_fence(__ATOMIC_RELEASE, "agent");
            asm volatile("s_waitcnt vmcnt(0)" ::: "memory");
            const unsigned og = xb_add(&bar[XB_TOP], 1u);
            const unsigned tg = og / nx;
            if (og + 1u == (tg + 1u) * nx) xb_add(&bar[XB_TOPGEN], 1u);
            else XB_SPIN(xb_ld(&bar[XB_TOPGEN]) == tg, bar);
            __builtin_amdgcn_fence(__ATOMIC_ACQUIRE, "agent");
            xb_add(&bar[XB_XGEN(b.x)], 1u);
            asm volatile("s_waitcnt vmcnt(0)" ::: "memory");
        } else {
            XB_SPIN(xb_ld(&bar[XB_XGEN(b.x)]) == gen, bar);
            __builtin_amdgcn_fence(__ATOMIC_ACQUIRE, "agent");
            asm volatile("s_waitcnt vmcnt(0)" ::: "memory");
        }
    }
    __syncthreads();
}

constexpr int NPHASE = 9;
constexpr int LDS_BYTES = 144 * 1024;
#ifndef USE_PG8
#define USE_PG8 1
#endif
__device__ __forceinline__ void run_phase(const Params& p, int ph, int bid, int nb, unsigned char* lds, bool dry = false) {
    bf16_t* U = Uptr(p); const bf16_t* WT = (const bf16_t*)(p.ws + WS_WTALL);
    bf16_t* S2 = (bf16_t*)p.out; float* oraw = p.out;
    PG8_LAS unsigned char* lds3 = (PG8_LAS unsigned char*)lds;
    switch (ph) {
    case 0: phase_prep(p, bid, nb, lds); break;
    case 1: { OpStoreBf16 o1{U, LDU, 1024}; OpStoreBf16 o2{(bf16_t*)(p.ws + WS_MKV), 2048, 0};
#if USE_PG8
              pg8::Sched S{}; S.j[0] = pg8::Job{U + C_H, WT, MTOK / 256, N1 / 256}; S.j[1] = pg8::Job{(const bf16_t*)p.out, (const bf16_t*)(p.ws + WS_WTMKV), MMEM / 256, 2048 / 256};
              S.njobs = 2; S.rep = 1; S.G = nb; S.c = bid; S.lda = LDU; S.astride = 0; S.bstride = 0;
              pg8::Epi<SelP1> E{SelP1{o1, o2}}; pg8::gemm_phase<pg8::Epi<SelP1>, true>(lds3, S, E);
#else
              gemm_simple(U + C_H, LDU, WT, MTOK, N1, DM, o1, bid, nb); gemm_simple((const bf16_t*)p.out, LDU, (const bf16_t*)(p.ws + WS_WTMKV), MMEM, 2048, DM, o2, bid, nb);
#endif
            } break;
#if !defined(DSA_REF) && !defined(GLA_REF)
    case 2: phase_gla_g1(p, bid, nb, lds, dry); phase_dsa_select2(p, bid, nb, lds); break;
    case 3: phase_gla_g2(p, bid, nb, dry); phase_dsa_attend4(p, bid, nb, lds, dry); break;
#elif !defined(DSA_REF)
    case 2: phase_gla_rec(p, oraw, bid, nb, lds); phase_dsa_select(p, bid, nb, lds); break;
    case 3: phase_gla_norm(p, oraw, bid, nb); phase_dsa_attend(p, bid, nb, lds, dry); break;
#else
    case 2: phase_gla_rec(p, oraw, bid, nb, lds); break;
    case 3: phase_gla_norm(p, oraw, bid, nb); phase_dsa_ref(p, bid, nb, lds); break;
#endif
#ifndef CROSS_REF
    case 4:
#ifndef GLA_REF
        phase_gla_g3(p, bid, nb, lds, dry);
#endif
        phase_cross_attend(p, bid, nb, lds, dry); break;
#else
    case 4: phase_cross_ref(p, bid, nb, lds); break;
#endif
    case 5: { OpZGate oz{U, dry}; OpSig os{S2, U};
#if USE_PG8
              pg8::Sched S{}; S.j[0] = pg8::Job{U + C_H, WT + (size_t)WT_Z * DM, MTOK / 256, 3072 / 256}; S.j[1] = pg8::Job{U + C_H, WT + (size_t)WT_G * DM, MTOK / 256, 3072 / 256};
              S.njobs = 2; S.rep = 1; S.G = nb; S.c = bid; S.lda = LDU; S.astride = 0; S.bstride = 0;
              pg8::Epi<SelP5> E{SelP5{oz, os}}; pg8::gemm_phase<pg8::Epi<SelP5>, true>(lds3, S, E);
#else
              gemm_simple(U + C_H, LDU, WT + (size_t)WT_Z * DM, MTOK, 3072, DM, oz, bid, nb); gemm_simple(U + C_H, LDU, WT + (size_t)WT_G * DM, MTOK, 3072, DM, os, bid, nb);
#endif
            } break;
    case 6: { OpMerge<0> m0{S2, U}; OpMerge<1> m1{S2, U}; OpMerge<2> m2{S2, U};
#if USE_PG8
              pg8::Sched S{}; S.j[0] = pg8::Job{U + C_GV, (const bf16_t*)(p.ws + WS_WTGO), MTOK / 256, DM / 256};
              S.njobs = 1; S.rep = 3; S.G = nb; S.c = bid; S.lda = LDU; S.astride = 1024; S.bstride = (long)(WS_WTDO - WS_WTGO) / 2;
              pg8::Epi<SelP6> E{SelP6{m0, m1, m2}}; pg8::gemm_phase<pg8::Epi<SelP6>, true>(lds3, S, E);
#else
              gemm_simple(U + C_GV, LDU, (const bf16_t*)(p.ws + WS_WTGO), MTOK, DM, DM, m0, bid, nb);
              gemm_simple(U + C_DQ, LDU, (const bf16_t*)(p.ws + WS_WTDO), MTOK, DM, DM, m1, bid, nb);
              gemm_simple(U + C_XQ, LDU, (const bf16_t*)(p.ws + WS_WTXO), MTOK, DM, DM, m2, bid, nb);
#endif
            } break;
    case 7: { OpOutF32 oo{p.out};
#if USE_PG8
              pg8::Sched S{}; S.j[0] = pg8::Job{U + C_MG, (const bf16_t*)(p.ws + WS_WTO), MTOK / 256, DM / 256};
              S.njobs = 1; S.rep = 1; S.G = nb; S.c = bid; S.lda = LDU; S.astride = 0; S.bstride = 0;
              pg8::Epi<SelP7> E{SelP7{oo}}; pg8::gemm_phase<pg8::Epi<SelP7>, false>(lds3, S, E);
#else
              gemm_simple(U + C_MG, LDU, (const bf16_t*)(p.ws + WS_WTO), MTOK, DM, DM, oo, bid, nb);
#endif
            } break;
    case 8: phase_final(p, bid, nb, dry); break;
    }
}

#if ONE_LAUNCH
__global__ void __launch_bounds__(NTHREADS) fwd_mega(Params p) {
    extern __shared__ __attribute__((aligned(16))) unsigned char lds[];
    cg::grid_group grid = cg::this_grid();
    const int bid = blockIdx.x, nb = gridDim.x;
    volatile LAS unsigned* xst = (volatile LAS unsigned*)((LAS unsigned char*)lds + LDS_BYTES - 16);
    unsigned* barw = (unsigned*)(p.ws + WS_BAR);
    if (threadIdx.x < 4) xst[threadIdx.x] = 0u;
    if (bid == 0) for (int i = threadIdx.x; i < XCD_BAR_WORDS; i += NTHREADS) barw[i] = 0u;
    __syncthreads();
#ifdef PROF_PHASE
#define PROF_DUP(k) if (PROF_PHASE == (k)) { run_phase(p, (k), bid, nb, lds, p.g_pre != nullptr); GSYNC(); } \
    if (PROF_PHASE == 10 * (k) + 0) { const bool dry_ = p.g_pre != nullptr; if ((k) == 2) phase_gla_g1(p, bid, nb, lds, dry_); if ((k) == 3) phase_gla_g2(p, bid, nb, dry_); if ((k) == 4) phase_gla_g3(p, bid, nb, lds, dry_); GSYNC(); } \
    if (PROF_PHASE == 10 * (k) + 1) { const bool dry_ = p.g_pre != nullptr; if ((k) == 2) phase_dsa_select2(p, bid, nb, lds); if ((k) == 3) phase_dsa_attend4(p, bid, nb, lds, dry_); if ((k) == 4) phase_cross_attend(p, bid, nb, lds, dry_); GSYNC(); }
#else
#define PROF_DUP(k)
#endif
#define GSYNC() xcd_barrier(xbar)
    run_phase(p, 0, bid, nb, lds); grid.sync();
    const XcdBarrier xbar = xcd_barrier_post(barw, xst);
    PROF_DUP(1) run_phase(p, 1, bid, nb, lds); GSYNC();
    PROF_DUP(2) run_phase(p, 2, bid, nb, lds); GSYNC();
    PROF_DUP(3) run_phase(p, 3, bid, nb, lds); GSYNC();
    PROF_DUP(4) run_phase(p, 4, bid, nb, lds); GSYNC();
    PROF_DUP(5) run_phase(p, 5, bid, nb, lds); GSYNC();
    PROF_DUP(6) run_phase(p, 6, bid, nb, lds); GSYNC();
    PROF_DUP(7) run_phase(p, 7, bid, nb, lds); GSYNC();
    PROF_DUP(8) run_phase(p, 8, bid, nb, lds);
#undef GSYNC
}
#else
template <int PH> __global__ void __launch_bounds__(NTHREADS) fwd_phase(Params p) {
    extern __shared__ __attribute__((aligned(16))) unsigned char lds[];
    run_phase(p, PH, blockIdx.x, gridDim.x, lds);
}
#endif

extern "C" void kernel_launch(void* const* d_in, const int* in_sizes, int n_in, void* d_out, int out_size, void* d_ws, size_t ws_size, hipStream_t stream) {
    if (n_in != 15 || out_size != MTOK * DM || ws_size < WS_END) { fprintf(stderr, "kernel_launch: unexpected shapes (n_in %d out %d ws %zu)\n", n_in, out_size, ws_size); return; }
    Params p{};
    p.x = (const float*)d_in[0]; p.mem = (const float*)d_in[1]; p.g_pre = (const float*)d_in[2]; p.g_post = (const float*)d_in[3]; p.g_mem = (const float*)d_in[4];
    p.w_in = (const float*)d_in[5]; p.w_a_up = (const float*)d_in[6]; p.b_a = (const float*)d_in[7]; p.g_gla = (const float*)d_in[8]; p.rel_bias = (const float*)d_in[9];
    p.w_mem_kv = (const float*)d_in[10]; p.w_gla_out = (const float*)d_in[11]; p.w_dsa_out = (const float*)d_in[12]; p.w_x_out = (const float*)d_in[13]; p.w_o = (const float*)d_in[14];
    p.out = (float*)d_out; p.ws = (unsigned char*)d_ws;
#if ONE_LAUNCH
    static int grid_blocks = 0;
    if (!grid_blocks) {
        int dev = 0, cus = 0, per_cu = 0;
        hipGetDevice(&dev); hipDeviceGetAttribute(&cus, hipDeviceAttributeMultiprocessorCount, dev);
        hipFuncSetAttribute((const void*)fwd_mega, hipFuncAttributeMaxDynamicSharedMemorySize, LDS_BYTES);
        hipOccupancyMaxActiveBlocksPerMultiprocessor(&per_cu, (const void*)fwd_mega, NTHREADS, LDS_BYTES);
        if (per_cu < 1) per_cu = 1;
        grid_blocks = cus * per_cu;
    }
    void* args[] = {&p};
    hipError_t e = hipLaunchCooperativeKernel((void*)fwd_mega, dim3(grid_blocks), dim3(NTHREADS), args, LDS_BYTES, stream);
    if (e != hipSuccess) fprintf(stderr, "cooperative launch failed: %s (grid %d)\n", hipGetErrorString(e), grid_blocks);
#else
    const int G = 1024;
    static bool attr_done = false;
#define LAUNCH(PH) do { if (!attr_done) (void)hipFuncSetAttribute((const void*)fwd_phase<PH>, hipFuncAttributeMaxDynamicSharedMemorySize, LDS_BYTES); hipLaunchKernelGGL(fwd_phase<PH>, dim3(G), dim3(NTHREADS), LDS_BYTES, stream, p); } while (0)
    LAUNCH(0); LAUNCH(1); LAUNCH(2); LAUNCH(3); LAUNCH(4); LAUNCH(5); LAUNCH(6); LAUNCH(7); LAUNCH(8);
    attr_done = true;
#undef LAUNCH
#endif
}
```

```cpp
#include <hip/hip_runtime.h>
#include <hip/hip_cooperative_groups.h>
#include <cstdio>
#include <cstdint>
namespace cg = cooperative_groups;

#ifndef ONE_LAUNCH
#define ONE_LAUNCH 1
#endif

typedef unsigned short bf16_t;
typedef short bf16x8 __attribute__((ext_vector_type(8)));
typedef float f32x4 __attribute__((ext_vector_type(4)));
typedef unsigned u32x2 __attribute__((ext_vector_type(2)));
typedef unsigned u32x4 __attribute__((ext_vector_type(4)));

constexpr int NBATCH = 4, SEQ = 4096, DM = 1024, MTOK = NBATCH * SEQ;
constexpr int NMEM = 256, MMEM = NBATCH * NMEM;
constexpr int WIN_COLS = 11352;
constexpr float EPS = 1e-6f;
constexpr int NTHREADS = 512, NWAVES = 8;
constexpr int LDU = 6400;
constexpr int C_H = 0, C_GV = 1024, C_DQ = 2048, C_XQ = 3072, C_GQ = 4096, C_GK = 4608, C_DK = 5120, C_DV = 5376, C_IQ = 5632, C_IK = 6144, C_GA = 6208, C_IW = 6224;
constexpr int C_SM = 4096;
constexpr int C_MG = 5120;
constexpr int N1 = 5376;
constexpr int WT_Z = 5376, WT_G = 8448, WT_ROWS = 11520;
constexpr size_t MiB = 1u << 20;
constexpr size_t WS_WTALL = 0, WS_WTMKV = 23 * MiB, WS_WTGO = 27 * MiB, WS_WTDO = 29 * MiB, WS_WTXO = 31 * MiB, WS_WTO = 33 * MiB;
constexpr size_t WS_MKV = 35 * MiB, WS_MASK = 39 * MiB  , WS_U = 48 * MiB, WS_END = 248 * MiB;
static_assert(WS_U + (size_t)MTOK * LDU * 2 == WS_END && WS_END <= 256 * MiB, "ws map");

struct Params {
    const float *x, *mem, *g_pre, *g_post, *g_mem, *w_in, *w_a_up, *b_a, *g_gla, *rel_bias, *w_mem_kv, *w_gla_out, *w_dsa_out, *w_x_out, *w_o;
    float* out; unsigned char* ws;
};

__device__ const unsigned char T5B[128] = {0, 1, 2, 3, 4, 5, 6, 7, 8, 9, 10, 11, 12, 13, 14, 15, 16, 16, 16, 17, 17, 18, 18, 18, 19, 19, 19, 20, 20, 20, 20, 21, 21, 21, 21, 22, 22, 22, 22, 22, 23, 23, 23, 23, 23, 23, 24, 24, 24, 24, 24, 24, 25, 25, 25, 25, 25, 25, 25, 26, 26, 26, 26, 26, 26, 26, 26, 27, 27, 27, 27, 27, 27, 27, 27, 27, 27, 28, 28, 28, 28, 28, 28, 28, 28, 28, 28, 29, 29, 29, 29, 29, 29, 29, 29, 29, 29, 29, 29, 30, 30, 30, 30, 30, 30, 30, 30, 30, 30, 30, 30, 30, 30, 31, 31, 31, 31, 31, 31, 31, 31, 31, 31, 31, 31, 31, 31, 31};

__device__ __forceinline__ float bf2f(bf16_t b) { return __uint_as_float((unsigned)b << 16); }
__device__ __forceinline__ unsigned f2bf(float f) { unsigned u = __float_as_uint(f); return (u + 0x7fffu + ((u >> 16) & 1u)) >> 16; }
typedef float f32x2_t_ __attribute__((ext_vector_type(2))); typedef __bf16 bf16x2_t_ __attribute__((ext_vector_type(2)));
__device__ __forceinline__ unsigned pk2(float lo, float hi) { f32x2_t_ v = {lo, hi}; bf16x2_t_ b = __builtin_convertvector(v, bf16x2_t_); return __builtin_bit_cast(unsigned, b); }
__device__ __forceinline__ float wave_sum(float v) {
#pragma unroll
    for (int o = 1; o < 64; o <<= 1) v += __shfl_xor(v, o);
    return v;
}
__device__ __forceinline__ float wave_max(float v) {
#pragma unroll
    for (int o = 1; o < 64; o <<= 1) v = fmaxf(v, __shfl_xor(v, o));
    return v;
}
__device__ __forceinline__ int opaque_tid() { int t = threadIdx.x; asm volatile("" : "+v"(t)); return t; }
__device__ __forceinline__ bf16_t* Uptr(const Params& p) { return (bf16_t*)(p.ws + WS_U); }

__device__ __forceinline__ int win_src_col(int r) {
    if (r < 1024) return 1024 + r;
    if (r < 2048) return 3088 + (r - 1024);
    if (r < 3072) return 6232 + (r - 2048);
    if (r < 3584) return r - 3072;
    if (r < 4096) return 512 + (r - 3584);
    if (r < 4352) return 4112 + (r - 4096);
    if (r < 4608) return 4368 + (r - 4352);
    if (r < 5120) return 4624 + (r - 4608);
    if (r < 5184) return 5136 + (r - 5120);
    if (r < 5200) return 2048 + (r - 5184);
    if (r < 5208) return 5200 + (r - 5200);
    if (r < 5376) return -1;
    if (r < 6400) return 2064 + (r - 5376);
    if (r < 7424) return 5208 + (r - 6400);
    if (r < 8448) return 7256 + (r - 7424);
    return 8280 + (r - 8448);
}

template <bool MAP>
__device__ __forceinline__ void transpose_item(const float* W, int ldw, int K, bf16_t* WT, float* scr, int item, int lane) {
    const int nkb = K / 64, nb = item / nkb, kb = item % nkb, k0 = 64 * kb, n0 = 32 * nb;
    const int n = n0 + (lane & 31);
    const int c = MAP ? win_src_col(n) : n;
#pragma unroll 8
    for (int i = 0; i < 32; ++i) { const int kk = 2 * i + (lane >> 5); scr[kk * 33 + (lane & 31)] = (c >= 0) ? W[(size_t)(k0 + kk) * ldw + c] : 0.f; }
    asm volatile("s_waitcnt lgkmcnt(0)" ::: "memory");
    const int c8 = lane & 7;
#pragma unroll
    for (int j = 0; j < 4; ++j) {
        const int nn = (lane >> 3) + 8 * j; const float* s = scr + (8 * c8) * 33 + nn;
        u32x4 o; o.x = pk2(s[0 * 33], s[1 * 33]); o.y = pk2(s[2 * 33], s[3 * 33]); o.z = pk2(s[4 * 33], s[5 * 33]); o.w = pk2(s[6 * 33], s[7 * 33]);
        *(u32x4*)(WT + (size_t)(n0 + nn) * K + k0 + 8 * c8) = o;
    }
    asm volatile("s_waitcnt lgkmcnt(0)" ::: "memory");
}
__device__ __forceinline__ void rms_row_to_bf16(const float* xrow, const float* g, bf16_t* orow, int lane) {
    const f32x4* xr = (const f32x4*)xrow + lane; const f32x4* gr = (const f32x4*)g + lane;
    f32x4 v[4]; float s = 0.f;
#pragma unroll
    for (int j = 0; j < 4; ++j) { v[j] = xr[64 * j]; s += (v[j].x * v[j].x + v[j].y * v[j].y) + (v[j].z * v[j].z + v[j].w * v[j].w); }
    const float rstd = 1.f / sqrtf(wave_sum(s) * (1.f / DM) + EPS);
    unsigned long long* o8 = (unsigned long long*)orow + lane;
#pragma unroll
    for (int j = 0; j < 4; ++j) { const f32x4 gg = gr[64 * j];
        o8[64 * j] = (unsigned long long)pk2(v[j].x * rstd * gg.x, v[j].y * rstd * gg.y) | ((unsigned long long)pk2(v[j].z * rstd * gg.z, v[j].w * rstd * gg.w) << 32); }
}
__device__ void phase_prep(const Params& p, int bid, int nb, unsigned char* lds) {
    const int tid = threadIdx.x, lane = tid & 63, wave = tid >> 6;
    float* scr = (float*)lds + wave * (64 * 33);
    const int gw = bid * NWAVES + wave, NGW = nb * NWAVES;
    constexpr int I_ALL = (WT_ROWS / 32) * (DM / 64), I_MKV = (2048 / 32) * (DM / 64), I_SQ = (DM / 32) * (DM / 64);
    constexpr int NITEMS = I_ALL + I_MKV + 4 * I_SQ;
    for (int it = gw; it < NITEMS; it += NGW) {
        int r = it;
        if (r < I_ALL) { transpose_item<true>(p.w_in, WIN_COLS, DM, (bf16_t*)(p.ws + WS_WTALL), scr, r, lane); continue; } r -= I_ALL;
        if (r < I_MKV) { transpose_item<false>(p.w_mem_kv, 2048, DM, (bf16_t*)(p.ws + WS_WTMKV), scr, r, lane); continue; } r -= I_MKV;
        if (r < I_SQ) { transpose_item<false>(p.w_gla_out, DM, DM, (bf16_t*)(p.ws + WS_WTGO), scr, r, lane); continue; } r -= I_SQ;
        if (r < I_SQ) { transpose_item<false>(p.w_dsa_out, DM, DM, (bf16_t*)(p.ws + WS_WTDO), scr, r, lane); continue; } r -= I_SQ;
        if (r < I_SQ) { transpose_item<false>(p.w_x_out, DM, DM, (bf16_t*)(p.ws + WS_WTXO), scr, r, lane); continue; } r -= I_SQ;
        transpose_item<false>(p.w_o, DM, DM, (bf16_t*)(p.ws + WS_WTO), scr, r, lane);
    }
    bf16_t* U = Uptr(p);
    for (int m = gw; m < MTOK + MMEM; m += NGW) {
        if (m < MTOK) rms_row_to_bf16(p.x + (size_t)m * DM, p.g_pre, U + (size_t)m * LDU + C_H, lane);
        else rms_row_to_bf16(p.mem + (size_t)(m - MTOK) * DM, p.g_mem, (bf16_t*)p.out + (size_t)(m - MTOK) * LDU, lane);
    }
}

struct OpStoreBf16 { bf16_t* C; int ldc, coff;
    __device__ __forceinline__ void operator()(int r, int c, f32x4 v) const { u32x2 w; w.x = pk2(v[0], v[1]); w.y = pk2(v[2], v[3]); *(u32x2*)(C + (size_t)r * ldc + coff + c) = w; } };
__device__ __forceinline__ f32x4 ld4bf(const bf16_t* q) { const u32x2 w = *(const u32x2*)q; f32x4 o; o[0] = __uint_as_float(w.x << 16); o[1] = __uint_as_float(w.x & 0xffff0000u); o[2] = __uint_as_float(w.y << 16); o[3] = __uint_as_float(w.y & 0xffff0000u); return o; }
__device__ __forceinline__ void st4bf(bf16_t* q, f32x4 v) { u32x2 w; w.x = pk2(v[0], v[1]); w.y = pk2(v[2], v[3]); *(u32x2*)q = w; }
__device__ __forceinline__ float sigmoidf_(float x) { return 1.f / (1.f + __expf(-x)); }
struct OpZGate { bf16_t* U; bool dry;
    __device__ __forceinline__ void operator()(int r, int c, f32x4 z) const { bf16_t* q = U + (size_t)r * LDU + 1024 + c; f32x4 o = ld4bf(q);
#pragma unroll
        for (int i = 0; i < 4; ++i) o[i] = o[i] * z[i] * sigmoidf_(z[i]);
        if (!dry) st4bf(q, o); } };
struct OpSig { bf16_t* S2; bf16_t* U;
    __device__ __forceinline__ void operator()(int r, int c, f32x4 g) const { f32x4 s;
#pragma unroll
        for (int i = 0; i < 4; ++i) s[i] = sigmoidf_(g[i]);
        bf16_t* q = (c < 2048) ? S2 + (size_t)r * 2048 + c : U + (size_t)r * LDU + C_SM + (c - 2048);
        st4bf(q, s); } };
template <int B> struct OpMerge { const bf16_t* S2; bf16_t* U;
    __device__ __forceinline__ void operator()(int r, int c, f32x4 v) const {
        const bf16_t* sq = (B == 0) ? S2 + (size_t)r * 2048 + c : (B == 1) ? S2 + (size_t)r * 2048 + 1024 + c : U + (size_t)r * LDU + C_SM + c;
        const f32x4 s = ld4bf(sq); bf16_t* q = U + (size_t)r * LDU + C_MG + c;
        f32x4 o = s * v; if (B != 0) o = o + ld4bf(q);
        st4bf(q, o); } };
struct OpOutF32 { float* O;
    __device__ __forceinline__ void operator()(int r, int c, f32x4 v) const { *(f32x4*)(O + (size_t)r * DM + c) = v; } };

template <class Op>
__device__ void gemm_simple(const bf16_t* A, int lda, const bf16_t* Bt, int M, int N, int K, const Op& op, int bid, int nb) {
    const int tid = threadIdx.x, lane = tid & 63, wave = tid >> 6, fr = lane & 15, fq = lane >> 4;
    const int ntn = N / 64, nitems = (M / 128) * ntn;
    for (int it = bid; it < nitems; it += nb) {
        const int tm = it / ntn, tn = it % ntn;
        const int row = tm * 128 + wave * 16 + fr;
        const bf16_t* ap = A + (size_t)row * lda + fq * 8;
        const bf16_t* bp = Bt + (size_t)(tn * 64 + fr) * K + fq * 8;
        f32x4 acc[4];
#pragma unroll
        for (int n = 0; n < 4; ++n) acc[n] = (f32x4){0.f, 0.f, 0.f, 0.f};
#pragma unroll 2
        for (int k0 = 0; k0 < K; k0 += 32) {
            const bf16x8 a = *(const bf16x8*)(ap + k0);
#pragma unroll
            for (int n = 0; n < 4; ++n) { const bf16x8 b = *(const bf16x8*)(bp + (size_t)n * 16 * K + k0); acc[n] = __builtin_amdgcn_mfma_f32_16x16x32_bf16(b, a, acc[n], 0, 0, 0); }
        }
#pragma unroll
        for (int n = 0; n < 4; ++n) op(row, tn * 64 + n * 16 + fq * 4, acc[n]);
    }
}


namespace pg8 {
#define PG8_LAS __attribute__((address_space(3)))
constexpr int BM = 256, BK = 64, HALF = 128, HTB = HALF * BK * 2  , STAGE_BYTES = 8 * HTB, NXCD = 8, WGM = 8;
__host__ __device__ __forceinline__ int lds_byte(int r, int c) { const int st = (r >> 4) * 2 + (c >> 5), rr = r & 15, cc = c & 31, ob = rr * 64 + cc * 2; return st * 1024 + (ob ^ (((ob >> 9) & 1) << 5)); }
__host__ __device__ __forceinline__ void stage_rc(int b, int& R, int& C) { const int st = b / 1024, sb = b % 1024, swz = sb ^ (((sb >> 9) & 1) << 5); R = (st >> 1) * 16 + swz / 64; C = (st & 1) * 32 + (swz % 64) / 2; }
__host__ __device__ __forceinline__ int perm32(int rho) { const int n = rho >> 4, i = rho & 15; return 8 * (i >> 2) + 4 * n + (i & 3); }
struct Unit { int pm, pn, kind; const char* a; const char* b; };
struct Job { const bf16_t* A; const bf16_t* Bt; int nM, nN; };
struct Sched {
    Job j[2]; int njobs, rep, G, c, lda; long astride, bstride;
    __device__ __forceinline__ bool next(int i, Unit& u) const {
        const int ti = i / rep, v = i - ti * rep; long L = (long)ti * G + c;
#pragma unroll
        for (int q = 0; q < 2; ++q) { if (q < njobs) { const int nwg = j[q].nM * j[q].nN;
            if (L < nwg) { int wgid = (int)L; { const int qq = nwg / NXCD, r = nwg % NXCD, xcd = wgid % NXCD, off = wgid / NXCD; wgid = (xcd < r ? xcd * (qq + 1) : r * (qq + 1) + (xcd - r) * qq) + off; }
                const int nig = WGM * j[q].nN, gid = wgid / nig, fm = gid * WGM, gsz = (j[q].nM - fm) < WGM ? (j[q].nM - fm) : WGM;
                u.pm = fm + ((wgid % nig) % gsz); u.pn = (wgid % nig) / gsz; u.kind = 4 * q + v;
                u.a = (const char*)(j[q].A + (size_t)u.pm * BM * lda + (size_t)v * astride); u.b = (const char*)(j[q].Bt + (size_t)u.pn * BM * DM + (size_t)v * bstride); return true; }
            L -= nwg; } }
        return false;
    }
};
template <class Sel> struct Epi { static constexpr bool PERM = true; Sel sel;
    __device__ __forceinline__ void operator()(const f32x4 (&acc)[2][2][4][2], const Unit& u, int wr, int wc, int fr, int fq) const {
#pragma unroll
        for (int ai = 0; ai < 2; ++ai)
#pragma unroll
            for (int m = 0; m < 4; ++m) { const int row = u.pm * BM + ai * HALF + wr * 64 + m * 16 + fr;
#pragma unroll
                for (int bj = 0; bj < 2; ++bj) { const int col = u.pn * BM + bj * HALF + wc * 32 + 8 * fq; sel(u.kind, row, col, acc[ai][bj][m][0], acc[ai][bj][m][1]); } }
    }
};
template <class EpiT, bool ALIGN_EPI>
__device__ __forceinline__ void gemm_phase(PG8_LAS unsigned char* lds, const Sched& S, const EpiT& E) {
    int tid_ = threadIdx.x; asm volatile("" : "+v"(tid_));
    const int tid = tid_, wid = __builtin_amdgcn_readfirstlane(tid >> 6), lane = tid & 63, wr = wid >> 2, wc = wid & 3, fr = lane & 15, fq = lane >> 4;
    constexpr int K = DM, nt = K / BK; const int lda = S.lda;
    unsigned voffA[2], voffB[2];
#pragma unroll
    for (int i = 0; i < 2; ++i) { int R, C; stage_rc(tid * 16 + i * 8192, R, C); const int Rb = EpiT::PERM ? ((R & ~31) + perm32(R & 31)) : R;
        voffA[i] = (unsigned)(R * lda + C) * 2u; voffB[i] = (unsigned)(Rb * K + C) * 2u; }
    const size_t kstep = (size_t)(BK * 2);
    const size_t hstepA = (size_t)HALF * lda * 2, hstepB = (size_t)HALF * K * 2;
    const unsigned ldsw = (unsigned)wid * 1024u;
    const int aoff = lds_byte(wr * 64 + fr, fq * 8), boff = lds_byte(wc * 32 + fr, fq * 8);
#define PG8_SA(b, h) (((b) * 2 + (h)) * HTB)
#define PG8_SB(b, h) ((4 + (b) * 2 + (h)) * HTB)
#define PG8_STAGE(bufoff, gbase, voff) do { _Pragma("unroll") for (int _i = 0; _i < 2; ++_i) \
        __builtin_amdgcn_global_load_lds((const unsigned*)((const char*)(gbase) + (voff)[_i]), (PG8_LAS unsigned*)(lds + (bufoff) + ldsw + _i * 8192), 16, 0, 0); } while (0)
#define PG8_LDA(dst, b, h) do { _Pragma("unroll") for (int m = 0; m < 4; ++m) _Pragma("unroll") for (int k = 0; k < 2; ++k) dst[m][k] = *(const PG8_LAS bf16x8*)(lds + PG8_SA(b, h) + aoff + m * 2048 + k * 1024); } while (0)
#define PG8_LDB(dst, b, h) do { _Pragma("unroll") for (int n = 0; n < 2; ++n) _Pragma("unroll") for (int k = 0; k < 2; ++k) dst[n][k] = *(const PG8_LAS bf16x8*)(lds + PG8_SB(b, h) + boff + n * 2048 + k * 1024); } while (0)
#define PG8_MMA(ai, bj, At, Bt) do { __builtin_amdgcn_s_setprio(1); _Pragma("unroll") for (int m = 0; m < 4; ++m) _Pragma("unroll") for (int n = 0; n < 2; ++n) _Pragma("unroll") for (int k = 0; k < 2; ++k) \
        acc[ai][bj][m][n] = __builtin_amdgcn_mfma_f32_16x16x32_bf16(Bt[n][k], At[m][k], acc[ai][bj][m][n], 0, 0, 0); __builtin_amdgcn_s_setprio(0); } while (0)
#define PG8_WAIT_V(n) asm volatile("s_waitcnt vmcnt(" #n ")" ::: "memory")
#define PG8_WAIT_L(n) asm volatile("s_waitcnt lgkmcnt(" #n ")" ::: "memory")
#define PG8_BAR __builtin_amdgcn_s_barrier()
#define PG8_SCHED __builtin_amdgcn_sched_barrier(0)
    Unit cur, nxt; int ui = 0;
    if (!S.next(0, cur)) return;
    f32x4 acc[2][2][4][2];
#pragma unroll
    for (int a = 0; a < 2; ++a)
#pragma unroll
        for (int b = 0; b < 2; ++b)
#pragma unroll
            for (int m = 0; m < 4; ++m)
#pragma unroll
                for (int n = 0; n < 2; ++n) acc[a][b][m][n] = (f32x4){0.f, 0.f, 0.f, 0.f};
    bf16x8 At[4][2], B0[2][2], B1[2][2];
    const char* cA = cur.a; const char* cB = cur.b;
    PG8_STAGE(PG8_SB(0, 0), cB, voffB); PG8_STAGE(PG8_SB(0, 1), cB + hstepB, voffB); PG8_STAGE(PG8_SA(0, 0), cA, voffA); PG8_STAGE(PG8_SA(0, 1), cA + hstepA, voffA);
    if (wr == 1) PG8_BAR;
    PG8_WAIT_V(2); PG8_BAR;
    PG8_STAGE(PG8_SB(1, 0), cB + kstep, voffB); PG8_STAGE(PG8_SA(1, 0), cA + kstep, voffA); PG8_STAGE(PG8_SB(1, 1), cB + hstepB + kstep, voffB);
    PG8_WAIT_V(6); PG8_BAR;
    for (;;) {
        const bool has_next = S.next(ui + 1, nxt);
        const char* nA = has_next ? nxt.a : cA; const char* nB = has_next ? nxt.b : cB;
        for (int t = 0; t < nt; t += 2) {
            const bool last = (t == nt - 2);
            const char* a1 = cA + (size_t)(t + 1) * kstep;
            const char* a2 = last ? nA : cA + (size_t)(t + 2) * kstep; const char* b2 = last ? nB : cB + (size_t)(t + 2) * kstep;
            const char* a3 = a2 + kstep; const char* b3 = b2 + kstep;
            PG8_LDB(B0, 0, 0); PG8_LDB(B1, 0, 1); PG8_SCHED; PG8_LDA(At, 0, 0); PG8_STAGE(PG8_SA(1, 1), a1 + hstepA, voffA);
            PG8_WAIT_V(8); PG8_WAIT_L(0); PG8_BAR; PG8_MMA(0, 0, At, B0); PG8_MMA(0, 1, At, B1); PG8_BAR; PG8_SCHED;
            PG8_LDA(At, 0, 1); PG8_STAGE(PG8_SB(0, 0), b2, voffB); PG8_STAGE(PG8_SB(0, 1), b2 + hstepB, voffB); PG8_STAGE(PG8_SA(0, 0), a2, voffA);
            PG8_WAIT_V(8); PG8_WAIT_L(0); PG8_BAR; PG8_MMA(1, 0, At, B0); PG8_MMA(1, 1, At, B1); PG8_BAR; PG8_SCHED;
            PG8_LDB(B0, 1, 0); PG8_LDB(B1, 1, 1); PG8_SCHED; PG8_LDA(At, 1, 0); PG8_STAGE(PG8_SA(0, 1), a2 + hstepA, voffA);
            PG8_WAIT_V(8); PG8_WAIT_L(0); PG8_BAR; PG8_MMA(0, 0, At, B0); PG8_MMA(0, 1, At, B1); PG8_BAR; PG8_SCHED;
            PG8_LDA(At, 1, 1); PG8_STAGE(PG8_SB(1, 0), b3, voffB); PG8_STAGE(PG8_SB(1, 1), b3 + hstepB, voffB); PG8_STAGE(PG8_SA(1, 0), a3, voffA);
            PG8_WAIT_V(8); PG8_WAIT_L(0); PG8_BAR; PG8_MMA(1, 0, At, B0); PG8_MMA(1, 1, At, B1); PG8_BAR; PG8_SCHED;
        }
        if constexpr (ALIGN_EPI) { if (wr == 0) PG8_BAR; }
        E(acc, cur, wr, wc, fr, fq);
        if (!has_next) break;
#pragma unroll
        for (int a = 0; a < 2; ++a)
#pragma unroll
            for (int b = 0; b < 2; ++b)
#pragma unroll
                for (int m = 0; m < 4; ++m)
#pragma unroll
                    for (int n = 0; n < 2; ++n) acc[a][b][m][n] = (f32x4){0.f, 0.f, 0.f, 0.f};
        cur = nxt; cA = nA; cB = nB; ++ui;
        if constexpr (ALIGN_EPI) { if (wr == 1) PG8_BAR; }
    }
    PG8_WAIT_V(0);
    if constexpr (!ALIGN_EPI) { if (wr == 0) PG8_BAR; }
    PG8_BAR;
#undef PG8_SA
#undef PG8_SB
#undef PG8_STAGE
#undef PG8_LDA
#undef PG8_LDB
#undef PG8_MMA
#undef PG8_WAIT_V
#undef PG8_WAIT_L
#undef PG8_BAR
#undef PG8_SCHED
}
}
struct SelP1 { OpStoreBf16 o1, o2; __device__ __forceinline__ void operator()(int kind, int r, int c, f32x4 v0, f32x4 v1) const { if (kind == 0) { o1(r, c, v0); o1(r, c + 4, v1); } else { o2(r, c, v0); o2(r, c + 4, v1); } } };
struct SelP5 { OpZGate oz; OpSig os; __device__ __forceinline__ void operator()(int kind, int r, int c, f32x4 v0, f32x4 v1) const { if (kind == 0) { oz(r, c, v0); oz(r, c + 4, v1); } else { os(r, c, v0); os(r, c + 4, v1); } } };
struct SelP6 { OpMerge<0> m0; OpMerge<1> m1; OpMerge<2> m2; __device__ __forceinline__ void operator()(int kind, int r, int c, f32x4 v0, f32x4 v1) const {
    if (kind == 0) { m0(r, c, v0); m0(r, c + 4, v1); } else if (kind == 1) { m1(r, c, v0); m1(r, c + 4, v1); } else { m2(r, c, v0); m2(r, c + 4, v1); } } };
struct SelP7 { OpOutF32 oo; __device__ __forceinline__ void operator()(int kind, int r, int c, f32x4 v0, f32x4 v1) const { oo(r, c, v0); oo(r, c + 4, v1); } };

__device__ void phase_gla_rec(const Params& p, float* oraw, int bid, int nb, unsigned char* lds) {
    constexpr int CH = 32, RS = 136;
    float* As = (float*)lds; float* Ks = As + CH * RS; float* Qs = Ks + CH * RS; float* Vs = Qs + CH * RS;
    const bf16_t* U = Uptr(p);
    const int tid = threadIdx.x, cl = tid >> 3, ds = tid & 7;
    for (int it = bid; it < 64; it += nb) {
        const int b = it >> 4, h = (it >> 2) & 3, q4 = it & 3;
        float s[16];
#pragma unroll
        for (int i = 0; i < 16; ++i) s[i] = 0.f;
        for (int t0 = 0; t0 < SEQ; t0 += CH) {
            __syncthreads();
            for (int e = tid; e < CH * 128; e += NTHREADS) {
                const int i = e >> 7, d = e & 127; const size_t m = (size_t)b * SEQ + t0 + i; const bf16_t* ur = U + m * LDU;
                float x = p.b_a[h * 128 + d];
#pragma unroll
                for (int r = 0; r < 16; ++r) x += bf2f(ur[C_GA + r]) * p.w_a_up[r * 512 + h * 128 + d];
                const float ls = fminf(x, 0.f) - log1pf(__expf(-fabsf(x)));
                const int o = i * RS + (d >> 4) * 17 + (d & 15);
                As[o] = __expf(ls * (1.f / 16.f));
                Ks[o] = bf2f(ur[C_GK + h * 128 + d]);
                Qs[o] = bf2f(ur[C_GQ + h * 128 + d]) * 0.08838834764831845f;
            }
            for (int e = tid; e < CH * 64; e += NTHREADS) { const int i = e >> 6, c = e & 63; Vs[e] = bf2f(U[((size_t)b * SEQ + t0 + i) * LDU + C_GV + h * 256 + q4 * 64 + c]); }
            __syncthreads();
            for (int i = 0; i < CH; ++i) {
                const float v = Vs[i * 64 + cl]; const float* a = As + i * RS + ds * 17; const float* k = Ks + i * RS + ds * 17; const float* q = Qs + i * RS + ds * 17;
                float o = 0.f;
#pragma unroll
                for (int dd = 0; dd < 16; ++dd) { s[dd] = a[dd] * s[dd] + k[dd] * v; o += q[dd] * s[dd]; }
                o += __shfl_xor(o, 1); o += __shfl_xor(o, 2); o += __shfl_xor(o, 4);
                if (ds == 0) oraw[((size_t)b * SEQ + t0 + i) * DM + h * 256 + q4 * 64 + cl] = o;
            }
        }
    }
}
__device__ void phase_gla_norm(const Params& p, const float* oraw, int bid, int nb) {
    bf16_t* U = Uptr(p);
    const int lane = threadIdx.x & 63, wave = threadIdx.x >> 6;
    for (int it = bid * NWAVES + wave; it < MTOK * 4; it += nb * NWAVES) {
        const int m = it >> 2, h = it & 3;
        const f32x4 v = *(const f32x4*)(oraw + (size_t)m * DM + h * 256 + lane * 4);
        const float ss = wave_sum((v[0] * v[0] + v[1] * v[1]) + (v[2] * v[2] + v[3] * v[3]));
        const float rstd = 1.f / sqrtf(ss * (1.f / 256.f) + EPS);
        const f32x4 g = *(const f32x4*)(p.g_gla + lane * 4);
        st4bf(U + (size_t)m * LDU + C_GV + h * 256 + lane * 4, v * g * rstd);
    }
}

__device__ __forceinline__ unsigned fkey(float f) { const unsigned u = __float_as_uint(f); return (u & 0x80000000u) ? ~u : (u | 0x80000000u); }
__device__ void phase_dsa_ref(const Params& p, int bid, int nb, unsigned char* lds) {
    float* sc = (float*)lds;
    float* iqs = sc + 4096;
    float* qs = iqs + 512;
    float* lg = qs + 1024;
    int* sel = (int*)(lg + 2048);
    unsigned* hist = (unsigned*)(sel + 256);
    unsigned* cnt = hist + 256;
    int* misc = (int*)(cnt + 512);
    float* ws8 = (float*)(misc + 8);
    bf16_t* U = Uptr(p);
    const int tid = threadIdx.x, lane = tid & 63, wave = tid >> 6;
    for (int it = bid; it < MTOK; it += nb) {
        const int b = it / SEQ, t = it % SEQ; const size_t m = (size_t)it; const bf16_t* ur = U + m * LDU; const bf16_t* ub = U + (size_t)b * SEQ * LDU;
        __syncthreads();
        iqs[tid] = bf2f(ur[C_IQ + tid]);
        qs[tid] = bf2f(ur[C_DQ + tid]) * 0.08838834764831845f; qs[tid + 512] = bf2f(ur[C_DQ + 512 + tid]) * 0.08838834764831845f;
        if (tid < 8) ws8[tid] = bf2f(ur[C_IW + tid]);
        if (tid == 0) misc[0] = 0;
        __syncthreads();
        const int n = t + 1, ksel = n < 256 ? n : 256;
#pragma unroll 1
        for (int j = 0; j < 8; ++j) {
            const int s = tid * 8 + j;
            if (s < n) {
                const bf16_t* kr = ub + (size_t)s * LDU + C_IK;
                float acc[8];
#pragma unroll
                for (int h = 0; h < 8; ++h) acc[h] = 0.f;
#pragma unroll 1
                for (int d0 = 0; d0 < 64; d0 += 8) {
                    const bf16x8 kv = *(const bf16x8*)(kr + d0);
#pragma unroll
                    for (int dd = 0; dd < 8; ++dd) { const float kd = bf2f((bf16_t)kv[dd]);
#pragma unroll
                        for (int h = 0; h < 8; ++h) acc[h] += iqs[h * 64 + d0 + dd] * kd; }
                }
                float score = 0.f;
#pragma unroll
                for (int h = 0; h < 8; ++h) score += ws8[h] * fmaxf(acc[h], 0.f);
                sc[s] = score;
            }
        }
        __syncthreads();
        if (n <= 256) { if (tid < n) sel[tid] = tid; }
        else {
            unsigned prefix = 0u, mask = 0u; int need = ksel;
            for (int pass = 3; pass >= 0; --pass) {
                const int shift = 8 * pass;
                if (tid < 256) hist[tid] = 0u;
                __syncthreads();
#pragma unroll 1
                for (int j = 0; j < 8; ++j) { const int s = tid * 8 + j; if (s < n) { const unsigned u = fkey(sc[s]); if ((u & mask) == prefix) atomicAdd(&hist[(u >> shift) & 255u], 1u); } }
                __syncthreads();
                if (tid == 0) { int cum = 0, d = 255; for (; d > 0; --d) { const int c = (int)hist[d]; if (cum + c >= need) break; cum += c; } misc[1] = d; misc[2] = need - cum; }
                __syncthreads();
                prefix |= (unsigned)misc[1] << shift; mask |= 0xFFu << shift; need = misc[2];
                __syncthreads();
            }
            unsigned myeq = 0u;
#pragma unroll 1
            for (int j = 0; j < 8; ++j) { const int s = tid * 8 + j; if (s < n && fkey(sc[s]) == prefix) ++myeq; }
            cnt[tid] = myeq;
            __syncthreads();
            int rank = 0; for (int i = 0; i < tid; ++i) rank += (int)cnt[i];
#pragma unroll 1
            for (int j = 0; j < 8; ++j) { const int s = tid * 8 + j; if (s < n) { const unsigned u = fkey(sc[s]);
                bool take = u > prefix; if (u == prefix) { take = rank < need; ++rank; }
                if (take) { const int pos = atomicAdd(&misc[0], 1); if (pos < 256) sel[pos] = s; } } }
        }
        __syncthreads();
        { const int j = tid & 255, c = tid >> 8;
          float l4[4];
          if (j < ksel) { const int s = sel[j]; const bf16_t* kr = ub + (size_t)s * LDU + C_DK + c * 128;
              float a0 = 0.f, a1 = 0.f, a2 = 0.f, a3 = 0.f;
#pragma unroll 1
              for (int d0 = 0; d0 < 128; d0 += 8) { const bf16x8 kv = *(const bf16x8*)(kr + d0);
#pragma unroll
                  for (int dd = 0; dd < 8; ++dd) { const float kd = bf2f((bf16_t)kv[dd]); const float* qq = qs + c * 512 + d0 + dd; a0 += qq[0] * kd; a1 += qq[128] * kd; a2 += qq[256] * kd; a3 += qq[384] * kd; } }
              int dist = t - s; if (dist < 0) dist = 0; const int bk = dist < 128 ? (int)T5B[dist] : 31; const float* rb = p.rel_bias + bk * 8 + c * 4;
              l4[0] = a0 + rb[0]; l4[1] = a1 + rb[1]; l4[2] = a2 + rb[2]; l4[3] = a3 + rb[3];
          } else { l4[0] = l4[1] = l4[2] = l4[3] = -1e30f; }
#pragma unroll
          for (int g = 0; g < 4; ++g) lg[(c * 4 + g) * 256 + j] = l4[g]; }
        __syncthreads();
        { float v[4]; float mx = -3e38f;
#pragma unroll
          for (int i = 0; i < 4; ++i) { v[i] = lg[wave * 256 + lane + 64 * i]; mx = fmaxf(mx, v[i]); }
          mx = wave_max(mx); float sm = 0.f;
#pragma unroll
          for (int i = 0; i < 4; ++i) { v[i] = __expf(v[i] - mx); sm += v[i]; }
          sm = wave_sum(sm); const float inv = 1.f / sm;
#pragma unroll
          for (int i = 0; i < 4; ++i) lg[wave * 256 + lane + 64 * i] = v[i] * inv; }
        __syncthreads();
        { const int h = wave, c = h >> 2; float o0 = 0.f, o1 = 0.f;
#pragma unroll 4
          for (int j = 0; j < ksel; ++j) { const float pj = lg[h * 256 + j]; const unsigned w = *(const unsigned*)(ub + (size_t)sel[j] * LDU + C_DV + c * 128 + lane * 2);
              o0 += pj * __uint_as_float(w << 16); o1 += pj * __uint_as_float(w & 0xffff0000u); }
          *(unsigned*)(U + m * LDU + C_DQ + h * 128 + lane * 2) = pk2(o0, o1); }
    }
}


typedef float f32x16 __attribute__((ext_vector_type(16)));
typedef short s16x4 __attribute__((ext_vector_type(4)));
#define LAS __attribute__((address_space(3)))
#define MFMA32(a, b, c) __builtin_amdgcn_mfma_f32_32x32x16_bf16((a), (b), (c), 0, 0, 0)
__device__ __forceinline__ int crow(int r, int h) { return (r & 3) + 8 * (r >> 2) + 4 * h; }
constexpr int TRI = 8256;
__device__ __forceinline__ size_t mask_index(int b, int j, int kt, int lane) { return ((size_t)(b * TRI + j * (j + 1) / 2 + kt)) * 64 + lane; }

__device__ __forceinline__ void idx_tile(f32x16& sc, const bf16x8 (&aik)[4], LAS const bf16x8* biq  , const float (&wq)[8]) {
#pragma unroll
    for (int r = 0; r < 16; ++r) sc[r] = 0.f;
#pragma unroll
    for (int h = 0; h < 8; ++h) {
        f32x16 d;
#pragma unroll
        for (int r = 0; r < 16; ++r) d[r] = 0.f;
#pragma unroll
        for (int kk = 0; kk < 4; ++kk) d = MFMA32(aik[kk], biq[(h * 4 + kk) * 64], d);
#pragma unroll
        for (int r = 0; r < 16; ++r) sc[r] = __builtin_fmaf(wq[h], __builtin_fmaxf(d[r], 0.f), sc[r]);
    }
}

__device__ __forceinline__ void dsa_select_item(const Params& p, int idx, unsigned char* lds) {
    unsigned* hist = (unsigned*)lds;
    unsigned* qpref = hist + 32 * 256;
    int* qneed = (int*)(qpref + 32);
    int* qcut = qneed + 32;
    int* qflag = qcut + 32;
    int* anyflag = qflag + 32;
    unsigned* tb = (unsigned*)(anyflag + 8);
    LAS bf16x8* iqf = (LAS bf16x8*)((LAS unsigned char*)lds + 65536);
    const bf16_t* U = Uptr(p); unsigned short* maskbuf = (unsigned short*)(p.ws + WS_MASK);
    const int tid = opaque_tid(), lane = tid & 63, wave = __builtin_amdgcn_readfirstlane(tid >> 6), q = lane & 31, half = lane >> 5;
    const int b = idx & 3, j = idx >> 2, t0 = 32 * j; const size_t mb = (size_t)b * SEQ;
    __syncthreads();
    for (int e = tid; e < 32 * 256; e += NTHREADS) hist[e] = 0u;
    if (tid < 32) { qpref[tid] = 0u; qneed[tid] = 256; qcut[tid] = 0x7fffffff; qflag[tid] = 0; }
    if (tid < 8) anyflag[tid] = 0;
    float wq[8];
    { const bf16_t* ur = U + (mb + t0 + q) * LDU;
#pragma unroll
      for (int i = 0; i < 4; ++i) { const int f = wave + 8 * i; iqf[f * 64 + lane] = *(const bf16x8*)(ur + C_IQ + f * 16 + 8 * half); }
#pragma unroll
      for (int h = 0; h < 8; ++h) wq[h] = bf2f(ur[C_IW + h]); }
    LAS const bf16x8* biq = iqf + lane;
    __syncthreads();
#pragma unroll 1
    for (int ps = 0; ps < 6; ++ps) {
        if (ps == 4) { if (anyflag[0] == 0) continue; }
        const unsigned myT = qpref[q]; const int mycut = qcut[q];
        const int shift = 24 - 8 * ps; const unsigned mhi = (ps == 0 || ps > 3) ? 0u : (0xFFFFFFFFu << (32 - 8 * ps));
#pragma unroll 1
        for (int kt = wave; kt <= j; kt += NWAVES) {
            bf16x8 aik[4];
            { const bf16_t* kr = U + (mb + 32 * kt + q) * LDU + C_IK + 8 * half;
#pragma unroll
              for (int kk = 0; kk < 4; ++kk) aik[kk] = *(const bf16x8*)(kr + kk * 16); }
            f32x16 sc; idx_tile(sc, aik, biq, wq);
            unsigned word = 0u;
#pragma unroll
            for (int r = 0; r < 16; ++r) {
                const int kin = crow(r, half); const bool valid = (kt < j) || (kin <= q);
                const unsigned key = fkey(sc[r]);
                if (ps < 4) { if (valid && (key & mhi) == myT) atomicAdd(&hist[q * 256 + ((key >> shift) & 255u)], 1u); }
                else if (ps == 4) { if (valid && key == myT) word |= 1u << kin; }
                else { const bool sel = valid && (key > myT || (key == myT && (32 * kt + kin) <= mycut)); word |= sel ? (1u << r) : 0u; }
            }
            if (ps == 4) { if (word) atomicOr(&tb[kt * 32 + q], word); }
            if (ps == 5) maskbuf[mask_index(b, j, kt, lane)] = (unsigned short)word;
        }
        __syncthreads();
        if (ps < 4) {
            for (int qi = 0; qi < 4; ++qi) {
                const int qq = 4 * wave + qi; const int need = qneed[qq];
                u32x4 c = *(u32x4*)&hist[qq * 256 + 4 * lane];
                const int tot = (int)(c.x + c.y + c.z + c.w);
                int suf = tot;
#pragma unroll
                for (int o = 1; o < 64; o <<= 1) { const int tv = __shfl_down(suf, o); if (lane + o < 64) suf += tv; }
                const int above = suf - tot;
                if (above < need && need <= suf) {
                    int cum = above, digit, eq;
                    if (cum + (int)c.w >= need) { digit = 3; eq = (int)c.w; }
                    else { cum += (int)c.w; if (cum + (int)c.z >= need) { digit = 2; eq = (int)c.z; }
                        else { cum += (int)c.z; if (cum + (int)c.y >= need) { digit = 1; eq = (int)c.y; } else { cum += (int)c.y; digit = 0; eq = (int)c.x; } } }
                    qpref[qq] |= (unsigned)(4 * lane + digit) << shift; qneed[qq] = need - cum;
                    if (ps == 3 && eq > need - cum) { qflag[qq] = 1; anyflag[0] = 1; }
                }
                *(u32x4*)&hist[qq * 256 + 4 * lane] = (u32x4){0u, 0u, 0u, 0u};
            }
            if (ps == 3) { for (int e = tid; e < (j + 1) * 32; e += NTHREADS) tb[e] = 0u; }
        }
        if (ps == 4) {
            if (tid < 32 && qflag[tid]) { const int need = qneed[tid]; int cnt = 0, cut = 0x7fffffff;
                for (int kt = 0; kt <= j; ++kt) { unsigned w = tb[kt * 32 + tid]; const int pc = __popc(w);
                    if (cnt + pc >= need) { int left = need - cnt, pos = 0; for (;;) { pos = __ffs(w) - 1; if (--left == 0) break; w &= w - 1; } cut = 32 * kt + pos; break; }
                    cnt += pc; }
                qcut[tid] = cut; }
        }
        __syncthreads();
    }
}
__device__ void phase_dsa_select(const Params& p, int bid, int nb, unsigned char* lds) {
    for (int k2 = 2 * bid; k2 < 512; k2 += (k2 & 1) ? 2 * nb - 1 : 1) { const int k = k2 >> 1; dsa_select_item(p, (k2 & 1) ? 511 - k : k, lds); }
}


typedef float f32x4_ __attribute__((ext_vector_type(4)));
#define MFMA16(a, b, c) __builtin_amdgcn_mfma_f32_16x16x32_bf16((a), (b), (c), 0, 0, 0)
constexpr int S2_PITCH = 8192 + 16;
constexpr int S2_KEYS = 0, S2_HIST = 16 * S2_PITCH, S2_MISC = S2_HIST + 16 * 128 * 4;
__device__ __forceinline__ unsigned key16x2(float a, float b) {
    const unsigned x = __builtin_bit_cast(unsigned, __builtin_amdgcn_cvt_pkrtz(a, b));
    const unsigned neg = (x >> 15) & 0x00010001u;
    return x ^ ((neg * 0xFFFFu) | 0x80008000u);
}
__device__ __forceinline__ float relu_(float x) { return __builtin_amdgcn_fmed3f(x, 0.f, __builtin_inff()); }
__device__ __forceinline__ void dsa_select16_item(const Params& p, int idx, int a, unsigned char* lds_) {
    LAS char* lds = (LAS char*)lds_;
    LAS unsigned* hist = (LAS unsigned*)(lds + S2_HIST);
    LAS unsigned* qT = (LAS unsigned*)(lds + S2_MISC);
    LAS int* qneed = (LAS int*)(qT + 16);
    LAS int* qcut = qneed + 16;
    LAS int* qflag = qcut + 16;
    const bf16_t* U = Uptr(p); unsigned short* maskbuf = (unsigned short*)(p.ws + WS_MASK);
    const int tid = opaque_tid(), lane = tid & 63, wave = __builtin_amdgcn_readfirstlane(tid >> 6), qn = lane & 15, quad = lane >> 4;
    const int b = idx & 3, j = idx >> 2, t0 = 32 * j + 16 * a; const size_t mb = (size_t)b * SEQ;
    const int ntile16 = 2 * j + a + 1;
    __syncthreads();
    for (int e = tid; e < 16 * 128; e += NTHREADS) hist[e] = 0u;
    if (tid < 16) { qT[tid] = 0u; qneed[tid] = 256; qcut[tid] = 0x7fffffff; qflag[tid] = 0; }
    __syncthreads();
    {
        bf16x8 biq[8][2]; float wq[8];
        const bf16_t* ur = U + (mb + t0 + qn) * LDU;
#pragma unroll
        for (int h = 0; h < 8; ++h) { biq[h][0] = *(const bf16x8*)(ur + C_IQ + h * 64 + 8 * quad); biq[h][1] = *(const bf16x8*)(ur + C_IQ + h * 64 + 32 + 8 * quad); wq[h] = bf2f(ur[C_IW + h]); }
        const bf16_t* kb = U + (mb + qn) * LDU + C_IK + 8 * quad; const int nq_ = t0 + qn + 1;
        bf16x8 a00, a01, a10, a11;
        { const bool two = wave + NWAVES < ntile16; const bf16_t* k0 = kb + (size_t)16 * wave * LDU; const bf16_t* k1 = kb + (size_t)16 * (two ? wave + NWAVES : wave) * LDU;
          if (wave < ntile16) { a00 = *(const bf16x8*)k0; a01 = *(const bf16x8*)(k0 + 32); a10 = *(const bf16x8*)k1; a11 = *(const bf16x8*)(k1 + 32); } }
#pragma unroll 1
        for (int tile = wave; tile < ntile16; tile += 2 * NWAVES) {
            const bool two = tile + NWAVES < ntile16;
            const int nt = tile + 2 * NWAVES; const bool hn = nt < ntile16, hn2 = nt + NWAVES < ntile16;
            bf16x8 n00 = a00, n01 = a01, n10 = a10, n11 = a11;
            if (hn) { const bf16_t* k0 = kb + (size_t)16 * nt * LDU; const bf16_t* k1 = kb + (size_t)16 * (hn2 ? nt + NWAVES : nt) * LDU;
                n00 = *(const bf16x8*)k0; n01 = *(const bf16x8*)(k0 + 32); n10 = *(const bf16x8*)k1; n11 = *(const bf16x8*)(k1 + 32); }
            f32x4_ s0 = (f32x4_){0.f, 0.f, 0.f, 0.f}, s1 = s0;
#pragma unroll
            for (int h = 0; h < 8; ++h) {
                f32x4_ d0 = (f32x4_){0.f, 0.f, 0.f, 0.f}, d1 = d0;
                d0 = MFMA16(a00, biq[h][0], d0); d1 = MFMA16(a10, biq[h][0], d1);
                d0 = MFMA16(a01, biq[h][1], d0); d1 = MFMA16(a11, biq[h][1], d1);
#pragma unroll
                for (int r = 0; r < 4; ++r) { s0[r] = __builtin_fmaf(wq[h], relu_(d0[r]), s0[r]); s1[r] = __builtin_fmaf(wq[h], relu_(d1[r]), s1[r]); }
            }
            u32x2 w0; w0.x = key16x2(s0[0], s0[1]); w0.y = key16x2(s0[2], s0[3]);
            *(LAS u32x2*)(lds + S2_KEYS + qn * S2_PITCH + (16 * tile + 4 * quad) * 2) = w0;
            { const int k0i = 16 * tile + 4 * quad;
#pragma unroll
              for (int r = 0; r < 4; ++r) { const unsigned key = ((r & 2) ? w0.y : w0.x) >> (16 * (r & 1)) & 0xffffu; const unsigned bin = key >> 8;
                  if (k0i + r < nq_) __hip_atomic_fetch_add(hist + qn * 128 + (bin >> 1), 1u << (16 * (bin & 1u)), __ATOMIC_RELAXED, __HIP_MEMORY_SCOPE_WORKGROUP); } }
            if (two) { u32x2 w1; w1.x = key16x2(s1[0], s1[1]); w1.y = key16x2(s1[2], s1[3]);
                *(LAS u32x2*)(lds + S2_KEYS + qn * S2_PITCH + (16 * (tile + NWAVES) + 4 * quad) * 2) = w1;
                const int k1i = 16 * (tile + NWAVES) + 4 * quad;
#pragma unroll
                for (int r = 0; r < 4; ++r) { const unsigned key = ((r & 2) ? w1.y : w1.x) >> (16 * (r & 1)) & 0xffffu; const unsigned bin = key >> 8;
                    if (k1i + r < nq_) __hip_atomic_fetch_add(hist + qn * 128 + (bin >> 1), 1u << (16 * (bin & 1u)), __ATOMIC_RELAXED, __HIP_MEMORY_SCOPE_WORKGROUP); } }
            a00 = n00; a01 = n01; a10 = n10; a11 = n11;
        }
    }
    __syncthreads();
    const int rq = tid & 15, part = tid >> 4, nq = t0 + rq + 1;
#pragma unroll 1
    for (int ps = 0; ps < 2; ++ps) {
        const unsigned hiT = qT[rq] >> 8;
        LAS const char* krow = lds + S2_KEYS + rq * S2_PITCH;
        if (ps == 1) for (int base = part * 8; base < nq; base += 256) {
            const u32x4 kv = *(LAS const u32x4*)(krow + base * 2);
#pragma unroll
            for (int e = 0; e < 8; ++e) { const unsigned w = e < 2 ? kv.x : e < 4 ? kv.y : e < 6 ? kv.z : kv.w; const unsigned key = (e & 1) ? (w >> 16) : (w & 0xffffu);
                const bool ok = (base + e < nq) && (key >> 8) == hiT;
                const unsigned bin = key & 255u;
                if (ok) __hip_atomic_fetch_add(hist + rq * 128 + (bin >> 1), 1u << (16 * (bin & 1u)), __ATOMIC_RELAXED, __HIP_MEMORY_SCOPE_WORKGROUP); }
        }
        __syncthreads();
#pragma unroll
        for (int qi = 0; qi < 2; ++qi) {
            const int qq = 2 * wave + qi; const int need = qneed[qq];
            const u32x2 hw = *(LAS u32x2*)(hist + qq * 128 + 2 * lane);
            const int c0 = (int)(hw.x & 0xffffu), c1 = (int)(hw.x >> 16), c2 = (int)(hw.y & 0xffffu), c3 = (int)(hw.y >> 16);
            const int tot = c0 + c1 + c2 + c3;
            int suf = tot;
#pragma unroll
            for (int o = 1; o < 64; o <<= 1) { const int tv = __shfl_down(suf, o); if (lane + o < 64) suf += tv; }
            const int above = suf - tot;
            if (above < need && need <= suf) {
                int cum = above, digit, eq;
                if (cum + c3 >= need) { digit = 3; eq = c3; }
                else { cum += c3; if (cum + c2 >= need) { digit = 2; eq = c2; }
                    else { cum += c2; if (cum + c1 >= need) { digit = 1; eq = c1; } else { cum += c1; digit = 0; eq = c0; } } }
                qT[qq] |= (unsigned)(4 * lane + digit) << (ps == 0 ? 8 : 0); qneed[qq] = need - cum;
                if (ps == 1 && eq > need - cum) qflag[qq] = 1;
            }
            *(LAS u32x2*)(hist + qq * 128 + 2 * lane) = (u32x2){0u, 0u};
        }
        __syncthreads();
    }
#pragma unroll 1
    for (int qi = 0; qi < 2; ++qi) {
        const int qq = 2 * wave + qi;
        if (qflag[qq]) { const int nqq = t0 + qq + 1, need = qneed[qq]; const unsigned T = qT[qq]; int acc = 0, cut = 0x7fffffff;
            for (int base = 0; base < nqq; base += 64) { const int s = base + lane;
                const unsigned key = *(LAS const unsigned short*)(lds + S2_KEYS + qq * S2_PITCH + s * 2);
                unsigned long long em = __ballot(s < nqq && key == T); const int pc = __popcll(em);
                if (acc + pc >= need) { int left = need - acc; while (--left > 0) em &= em - 1; cut = base + (int)__ffsll((long long)em) - 1; break; }
                acc += pc; }
            if (lane == 0) qcut[qq] = cut; }
    }
    __syncthreads();
    for (int pi = tid; pi < 16 * (j + 1); pi += NTHREADS) {
        const int eq_ = pi & 15, kt = pi >> 4; const int nqq = t0 + eq_ + 1, cut = qcut[eq_]; const unsigned T = (nqq <= 256) ? 0u : qT[eq_];
        LAS const char* kp = lds + S2_KEYS + eq_ * S2_PITCH + kt * 64;
        unsigned ge = 0u, eqm = 0u;
#pragma unroll
        for (int v4 = 0; v4 < 4; ++v4) { const u32x4 kv = *(LAS const u32x4*)(kp + v4 * 16);
#pragma unroll
            for (int e = 0; e < 8; ++e) { const unsigned w = e < 2 ? kv.x : e < 4 ? kv.y : e < 6 ? kv.z : kv.w; const unsigned key = (e & 1) ? (w >> 16) : (w & 0xffffu);
                ge |= (unsigned)(key >= T) << (8 * v4 + e); eqm |= (unsigned)(key == T) << (8 * v4 + e); } }
        const int nv = nqq - 32 * kt; const unsigned vmask = nv >= 32 ? 0xffffffffu : (nv <= 0 ? 0u : ((1u << nv) - 1u));
        const int nc = cut - 32 * kt; const unsigned cmask = nc >= 31 ? 0xffffffffu : (nc < 0 ? 0u : ((2u << nc) - 1u));
        const unsigned w32 = vmask & ge & (~eqm | cmask);
#pragma unroll
        for (int hf = 0; hf < 2; ++hf) { const unsigned x = w32 >> (4 * hf); const unsigned wd = (x & 0xFu) | ((x >> 4) & 0xF0u) | ((x >> 8) & 0xF00u) | ((x >> 12) & 0xF000u);
            maskbuf[mask_index(b, j, kt, 16 * a + eq_ + 32 * hf)] = (unsigned short)wd; }
    }
}
__device__ void phase_dsa_select2(const Params& p, int bid, int nb, unsigned char* lds) {
    for (int k4 = 4 * bid; k4 < 1024; k4 += ((k4 & 3) == 3) ? 4 * nb - 3 : 1) { const int k = k4 >> 2, r = k4 & 3; dsa_select16_item(p, (r & 2) ? (((127 - (k >> 2)) << 2) | (k & 3)) : k, r & 1, lds); }
}

constexpr int DA_K = 0, DA_V = 32768, DA_BUF = 65536  , DA_TB = 131072, DA_WS = DA_TB + 8 * 132 * 4, DA_END = DA_WS + 8 * 64 * 4;
__device__ __forceinline__ s16x4 ds_tr(LAS const char* pp) { typedef short v4i16_t __attribute__((ext_vector_type(4))); return __builtin_bit_cast(s16x4, __builtin_amdgcn_ds_read_tr16_b64_v4i16((LAS v4i16_t*)pp)); }
template <int MODE>
__device__ __forceinline__ void attend_item(const Params& p, int idx, unsigned char* lds_, bool dry) {
    LAS char* lds = (LAS char*)lds_;
    bf16_t* U = Uptr(p); const unsigned short* maskbuf = (const unsigned short*)(p.ws + WS_MASK);
    const int tid = opaque_tid(), lane = tid & 63, wv = __builtin_amdgcn_readfirstlane(tid >> 6), q = lane & 31, half = lane >> 5;
    constexpr int NKK = MODE == 0 ? 8 : 16;
    const int h = MODE == 0 ? wv : (idx & 3); const int c = wv >> 2;
    const int b = MODE == 0 ? (idx & 3) : ((idx >> 2) >> 5); const int j = idx >> 2;
    const size_t mb = (size_t)b * SEQ;
    const size_t mq = MODE == 0 ? mb + 32 * j : (size_t)128 * j + 32 * (wv & 3);
    const int t0 = 32 * j;
    LAS const float* tbh = (LAS const float*)(lds + DA_TB) + h * 132; LAS float* wsc = (LAS float*)(lds + DA_WS) + wv * 64;
    constexpr float C1 = (MODE == 0 ? 0.08838834764831845f : 0.0625f) * 1.4426950408889634f;
    const float b31 = MODE == 0 ? tbh[128] : 0.f, bmaxh = MODE == 0 ? tbh[129] : 0.f;
    const int nsteps = MODE == 0 ? (j >> 1) + 1 : 4;
    const int srow = 2 * wv + half, spc = lane & 31;
    const bf16_t* gk; const bf16_t* gv; size_t gpitch;
    if (MODE == 0) { gk = U + (mb + srow) * LDU + C_DK + ((spc ^ (srow & 15)) << 3); gv = U + (mb + srow) * LDU + C_DV + ((spc ^ ((srow & 3) << 2)) << 3); gpitch = LDU; }
    else { const bf16_t* MKV = (const bf16_t*)(p.ws + WS_MKV) + ((size_t)b * NMEM + srow) * 2048 + h * 256; gk = MKV + ((spc ^ (srow & 15)) << 3); gv = MKV + 1024 + ((spc ^ ((srow & 3) << 2)) << 3); gpitch = 2048; }
#define DA_STAGE(st_, bufoff_) do { const size_t go_ = (size_t)(64 * (st_)) * gpitch; _Pragma("unroll") for (int i_ = 0; i_ < 4; ++i_) { \
        __builtin_amdgcn_global_load_lds((const unsigned*)(gk + go_ + (size_t)16 * i_ * gpitch), (LAS unsigned*)(lds + (bufoff_) + DA_K + (wv + 8 * i_) * 1024), 16, 0, 0); \
        __builtin_amdgcn_global_load_lds((const unsigned*)(gv + go_ + (size_t)16 * i_ * gpitch), (LAS unsigned*)(lds + (bufoff_) + DA_V + (wv + 8 * i_) * 1024), 16, 0, 0); } } while (0)
    __syncthreads();
    DA_STAGE(0, 0);
    bf16x8 qf[NKK];
    { const bf16_t* ur = U + (mq + q) * LDU + (MODE == 0 ? C_DQ + h * 128 : C_XQ + h * 256) + 8 * half;
#pragma unroll
      for (int kk = 0; kk < NKK; ++kk) qf[kk] = *(const bf16x8*)(ur + kk * 16); }
    f32x16 o[4];
#pragma unroll
    for (int dt = 0; dt < 4; ++dt)
#pragma unroll
        for (int r = 0; r < 16; ++r) o[dt][r] = 0.f;
    float m = -1e20f, l = 0.f;
    unsigned kA0, vA0;
    { const int q4 = (lane & 15) >> 2, p4 = lane & 3, g1 = (lane >> 4) & 1;
      kA0 = DA_K + q * 512 + ((((MODE == 0 ? c * 16 : 0) + half) ^ (q & 15)) << 4);
      vA0 = DA_V + (4 * half + q4) * 512 + (((c * 16 + 2 * g1 + (p4 >> 1)) ^ (q4 << 2)) << 4) + (p4 & 1) * 8; }
    unsigned mw0 = 0xffffu, mw1 = 0xffffu;
    if (MODE == 0) { mw0 = maskbuf[mask_index(b, j, 0, lane)]; mw1 = (1 <= j) ? maskbuf[mask_index(b, j, 1, lane)] : 0u; }
#pragma unroll 1
    for (int st = 0; st < nsteps; ++st) {
        const int kbase = 64 * st;
        asm volatile("s_waitcnt vmcnt(0)" ::: "memory");
        __syncthreads();
        const unsigned cw0 = mw0, cw1 = mw1;
        if (st + 1 < nsteps) { DA_STAGE(st + 1, ((st + 1) & 1) * DA_BUF);
            if (MODE == 0) { const int kt = 2 * st + 2; mw0 = maskbuf[mask_index(b, j, kt, lane)]; mw1 = (kt + 1 <= j) ? maskbuf[mask_index(b, j, kt + 1, lane)] : 0u; } }
        f32x16 s0, s1;
#pragma unroll
        for (int r = 0; r < 16; ++r) { s0[r] = 0.f; s1[r] = 0.f; }
#pragma unroll
        for (int kk = 0; kk < NKK; ++kk) {
            const bf16x8 a0 = *(LAS const bf16x8*)(lds + (kA0 ^ (unsigned)(kk << 5)));
            const bf16x8 a1 = *(LAS const bf16x8*)(lds + (kA0 ^ (unsigned)(kk << 5)) + 32 * 512);
            s0 = MFMA32(a0, qf[kk], s0); s1 = MFMA32(a1, qf[kk], s1); }
        const bool far_ = MODE == 0 && (t0 - (kbase + 63)) >= 128;
        float sm = fmaxf(s0[0], s1[0]);
#pragma unroll
        for (int r = 1; r < 16; ++r) sm = fmaxf(sm, fmaxf(s0[r], s1[r]));
        sm = fmaxf(sm, __shfl_xor(sm, 32));
        const float mc = __builtin_fmaf(sm, C1, MODE == 0 ? (far_ ? b31 : bmaxh) : 0.f);
        if (__any(mc > m + 8.f)) {
            const float mnew = fmaxf(m, mc);
            const float alpha = __builtin_amdgcn_exp2f(m - mnew); l *= alpha;
            if (half == 0) wsc[q] = alpha;
            asm volatile("s_waitcnt lgkmcnt(0)" ::: "memory");
#pragma unroll
            for (int r = 0; r < 16; ++r) { const float a = wsc[crow(r, half)];
#pragma unroll
                for (int dt = 0; dt < 4; ++dt) o[dt][r] *= a; }
            m = mnew;
        }
        float ls = 0.f;
        if (MODE == 1) {
            const float nm = -m;
#pragma unroll
            for (int r = 0; r < 16; ++r) { s0[r] = __builtin_amdgcn_exp2f(__builtin_fmaf(s0[r], C1, nm)); s1[r] = __builtin_amdgcn_exp2f(__builtin_fmaf(s1[r], C1, nm)); ls += s0[r] + s1[r]; }
        } else if (far_) {
            const int bm = __float_as_int(b31 - m), NEGI = __float_as_int(-1e30f);
#pragma unroll
            for (int r = 0; r < 16; ++r) {
                const int k0 = __builtin_amdgcn_sbfe((int)cw0, r, 1), k1 = __builtin_amdgcn_sbfe((int)cw1, r, 1);
                const float a0 = __int_as_float((k0 & bm) | (~k0 & NEGI)), a1 = __int_as_float((k1 & bm) | (~k1 & NEGI));
                s0[r] = __builtin_amdgcn_exp2f(__builtin_fmaf(s0[r], C1, a0)); s1[r] = __builtin_amdgcn_exp2f(__builtin_fmaf(s1[r], C1, a1)); ls += s0[r] + s1[r]; }
        } else {
            const int NEGI = __float_as_int(-1e30f);
#pragma unroll
            for (int r = 0; r < 16; ++r) {
                int d0 = t0 + q - (kbase + crow(r, half)); int d1 = d0 - 32; d0 = d0 < 0 ? 0 : (d0 > 128 ? 128 : d0); d1 = d1 < 0 ? 0 : (d1 > 128 ? 128 : d1);
                const int b0 = __float_as_int(tbh[d0] - m), b1 = __float_as_int(tbh[d1] - m);
                const int k0 = __builtin_amdgcn_sbfe((int)cw0, r, 1), k1 = __builtin_amdgcn_sbfe((int)cw1, r, 1);
                const float a0 = __int_as_float((k0 & b0) | (~k0 & NEGI)), a1 = __int_as_float((k1 & b1) | (~k1 & NEGI));
                s0[r] = __builtin_amdgcn_exp2f(__builtin_fmaf(s0[r], C1, a0)); s1[r] = __builtin_amdgcn_exp2f(__builtin_fmaf(s1[r], C1, a1)); ls += s0[r] + s1[r]; }
        }
        l += ls;
#pragma unroll
        for (int u = 0; u < 2; ++u) {
#pragma unroll
            for (int ss = 0; ss < 2; ++ss) {
                u32x4 pw;
                if (u == 0) { pw.x = pk2(s0[8 * ss], s0[8 * ss + 1]); pw.y = pk2(s0[8 * ss + 2], s0[8 * ss + 3]); pw.z = pk2(s0[8 * ss + 4], s0[8 * ss + 5]); pw.w = pk2(s0[8 * ss + 6], s0[8 * ss + 7]); }
                else { pw.x = pk2(s1[8 * ss], s1[8 * ss + 1]); pw.y = pk2(s1[8 * ss + 2], s1[8 * ss + 3]); pw.z = pk2(s1[8 * ss + 4], s1[8 * ss + 5]); pw.w = pk2(s1[8 * ss + 6], s1[8 * ss + 7]); }
                const bf16x8 pa = __builtin_bit_cast(bf16x8, pw);
#pragma unroll
                for (int dt = 0; dt < 4; ++dt) {
                    const s16x4 lo = ds_tr(lds + (vA0 ^ (unsigned)(dt << 6)) + (32 * u + 16 * ss) * 512);
                    const s16x4 hi = ds_tr(lds + (vA0 ^ (unsigned)(dt << 6)) + (32 * u + 16 * ss + 8) * 512);
                    const bf16x8 vb = (bf16x8){lo[0], lo[1], lo[2], lo[3], hi[0], hi[1], hi[2], hi[3]};
                    o[dt] = MFMA32(pa, vb, o[dt]);
                }
            }
        }
        kA0 ^= DA_BUF; vA0 ^= DA_BUF;
    }
#undef DA_STAGE
    l += __shfl_xor(l, 32);
    if (half == 0) wsc[q] = 1.f / l;
    asm volatile("s_waitcnt lgkmcnt(0)" ::: "memory");
#pragma unroll
    for (int r = 0; r < 16; ++r) { const int qq = crow(r, half); const float a = wsc[qq];
        bf16_t* orow = U + (mq + qq) * LDU + (MODE == 0 ? C_DQ + h * 128 : C_XQ + h * 256 + c * 128) + q;
#pragma unroll
        for (int dt = 0; dt < 4; ++dt) { const bf16_t ov = (bf16_t)f2bf(o[dt][r] * a); if (!dry) orow[dt * 32] = ov; } }
}

constexpr int D4_GRP = 65536, D4_K = 0, D4_V = 16384, D4_BUF = 32768, D4_CNT = DA_END;
__device__ __forceinline__ void group_barrier(LAS unsigned* cnt, int lane) {
    asm volatile("s_waitcnt vmcnt(0) lgkmcnt(0)" ::: "memory");
    if (lane == 0) { const unsigned old = __hip_atomic_fetch_add(cnt, 1u, __ATOMIC_RELAXED, __HIP_MEMORY_SCOPE_WORKGROUP); const unsigned target = (old & ~3u) + 4u;
        while (__hip_atomic_load(cnt, __ATOMIC_RELAXED, __HIP_MEMORY_SCOPE_WORKGROUP) < target) __builtin_amdgcn_s_sleep(1); }
    asm volatile("" ::: "memory");
}
__device__ __forceinline__ float max3f_(float a, float b, float c) { return __builtin_fmaxf(__builtin_fmaxf(a, b), c); }
__device__ __forceinline__ void dsa_attend4_item(const Params& p, int idx, unsigned char* lds_, bool dry) {
    LAS char* lds = (LAS char*)lds_;
    bf16_t* U = Uptr(p); const unsigned short* maskbuf = (const unsigned short*)(p.ws + WS_MASK);
    const int tid = opaque_tid(), lane = tid & 63, wv = __builtin_amdgcn_readfirstlane(tid >> 6), q = lane & 31, half = lane >> 5;
    const int grp = wv >> 2, w4 = wv & 3, h = wv;
    const int b = idx & 3, j = idx >> 2, t0 = 32 * j; const size_t mb = (size_t)b * SEQ;
    LAS const float* tbh = (LAS const float*)(lds + DA_TB) + h * 132; LAS float* wsc = (LAS float*)(lds + DA_WS) + wv * 64;
    LAS unsigned* gcnt = (LAS unsigned*)(lds + D4_CNT) + grp * 16;
    constexpr float C1 = 0.08838834764831845f * 1.4426950408889634f;
    const float b31 = tbh[128], bmaxh = tbh[129];
    const int nsteps = (j >> 1) + 1;
    const unsigned gb = grp * D4_GRP;
    const int sr = 4 * w4 + (lane >> 4), spc = lane & 15;
    const bf16_t* gk = U + (mb + sr) * LDU + C_DK + grp * 128 + ((spc ^ (sr & 15)) << 3);
    const bf16_t* gv = U + (mb + sr) * LDU + C_DV + grp * 128 + ((spc ^ ((sr & 3) << 2)) << 3);
#define D4_STAGE(st_, bufoff_) do { const size_t go_ = (size_t)(64 * (st_)) * LDU; _Pragma("unroll") for (int i_ = 0; i_ < 4; ++i_) { \
        __builtin_amdgcn_global_load_lds((const unsigned*)(gk + go_ + (size_t)16 * i_ * LDU), (LAS unsigned*)(lds + gb + (bufoff_) + D4_K + (w4 + 4 * i_) * 1024), 16, 0, 0); \
        __builtin_amdgcn_global_load_lds((const unsigned*)(gv + go_ + (size_t)16 * i_ * LDU), (LAS unsigned*)(lds + gb + (bufoff_) + D4_V + (w4 + 4 * i_) * 1024), 16, 0, 0); } } while (0)
    group_barrier(gcnt, lane);
    D4_STAGE(0, 0);
    bf16x8 qf[8];
    { const bf16_t* ur = U + (mb + t0 + q) * LDU + C_DQ + h * 128 + 8 * half;
#pragma unroll
      for (int kk = 0; kk < 8; ++kk) qf[kk] = *(const bf16x8*)(ur + kk * 16); }
    f32x16 o[4];
#pragma unroll
    for (int dt = 0; dt < 4; ++dt)
#pragma unroll
        for (int r = 0; r < 16; ++r) o[dt][r] = 0.f;
    float m = -1e20f, l = 0.f;
    unsigned kA0, vA0;
    { const int q4 = (lane & 15) >> 2, p4 = lane & 3, g1 = (lane >> 4) & 1;
      kA0 = gb + D4_K + q * 256 + ((half ^ (q & 15)) << 4);
      vA0 = gb + D4_V + (4 * half + q4) * 256 + (((2 * g1 + (p4 >> 1)) ^ (q4 << 2)) << 4) + (p4 & 1) * 8; }
    unsigned mw0 = maskbuf[mask_index(b, j, 0, lane)], mw1 = (1 <= j) ? maskbuf[mask_index(b, j, 1, lane)] : 0u;
#pragma unroll 1
    for (int st = 0; st < nsteps; ++st) {
        const int kbase = 64 * st;
        group_barrier(gcnt, lane);
        const unsigned cw0 = mw0, cw1 = mw1;
        if (st + 1 < nsteps) { D4_STAGE(st + 1, ((st + 1) & 1) * D4_BUF);
            const int kt = 2 * st + 2; mw0 = maskbuf[mask_index(b, j, kt, lane)]; mw1 = (kt + 1 <= j) ? maskbuf[mask_index(b, j, kt + 1, lane)] : 0u; }
        f32x16 s0, s1;
#pragma unroll
        for (int r = 0; r < 16; ++r) { s0[r] = 0.f; s1[r] = 0.f; }
        { bf16x8 ka[8], kb[8];
#pragma unroll
          for (int kk = 0; kk < 8; ++kk) ka[kk] = *(LAS const bf16x8*)(lds + (kA0 ^ (unsigned)(kk << 5)));
#pragma unroll
          for (int kk = 0; kk < 8; ++kk) kb[kk] = *(LAS const bf16x8*)(lds + (kA0 ^ (unsigned)(kk << 5)) + 32 * 256);
          __builtin_amdgcn_sched_barrier(0);
#pragma unroll
          for (int kk = 0; kk < 8; ++kk) s0 = MFMA32(ka[kk], qf[kk], s0);
#pragma unroll
          for (int kk = 0; kk < 8; ++kk) s1 = MFMA32(kb[kk], qf[kk], s1);
          __builtin_amdgcn_sched_barrier(0); }
        const bool far_ = (t0 - (kbase + 63)) >= 128;
        float sm = max3f_(s0[0], s1[0], s0[1]);
#pragma unroll
        for (int r = 1; r < 16; ++r) sm = (r < 15) ? max3f_(sm, s1[r], s0[r + 1]) : fmaxf(sm, s1[r]);
        sm = fmaxf(sm, __shfl_xor(sm, 32));
        const float mc = __builtin_fmaf(sm, C1, far_ ? b31 : bmaxh);
        if (__any(mc > m + 8.f)) {
            const float mnew = fmaxf(m, mc);
            const float alpha = __builtin_amdgcn_exp2f(m - mnew); l *= alpha;
            if (half == 0) wsc[q] = alpha;
            asm volatile("s_waitcnt lgkmcnt(0)" ::: "memory");
#pragma unroll
            for (int r = 0; r < 16; ++r) { const float a = wsc[crow(r, half)];
#pragma unroll
                for (int dt = 0; dt < 4; ++dt) o[dt][r] *= a; }
            m = mnew;
        }
        float ls = 0.f;
        if (far_) {
            const int bm = __float_as_int(b31 - m), NEGI = __float_as_int(-1e30f);
#pragma unroll
            for (int r = 0; r < 16; ++r) {
                const int k0 = __builtin_amdgcn_sbfe((int)cw0, r, 1), k1 = __builtin_amdgcn_sbfe((int)cw1, r, 1);
                const float a0 = __int_as_float((k0 & bm) | (~k0 & NEGI)), a1 = __int_as_float((k1 & bm) | (~k1 & NEGI));
                s0[r] = __builtin_amdgcn_exp2f(__builtin_fmaf(s0[r], C1, a0)); s1[r] = __builtin_amdgcn_exp2f(__builtin_fmaf(s1[r], C1, a1)); ls += s0[r] + s1[r]; }
        } else {
            const int NEGI = __float_as_int(-1e30f);
#pragma unroll
            for (int r = 0; r < 16; ++r) {
                int d0 = t0 + q - (kbase + crow(r, half)); int d1 = d0 - 32; d0 = d0 < 0 ? 0 : (d0 > 128 ? 128 : d0); d1 = d1 < 0 ? 0 : (d1 > 128 ? 128 : d1);
                const int b0 = __float_as_int(tbh[d0] - m), b1 = __float_as_int(tbh[d1] - m);
                const int k0 = __builtin_amdgcn_sbfe((int)cw0, r, 1), k1 = __builtin_amdgcn_sbfe((int)cw1, r, 1);
                const float a0 = __int_as_float((k0 & b0) | (~k0 & NEGI)), a1 = __int_as_float((k1 & b1) | (~k1 & NEGI));
                s0[r] = __builtin_amdgcn_exp2f(__builtin_fmaf(s0[r], C1, a0)); s1[r] = __builtin_amdgcn_exp2f(__builtin_fmaf(s1[r], C1, a1)); ls += s0[r] + s1[r]; }
        }
        l += ls;
        { s16x4 vl[2][4], vh[2][4];
#pragma unroll
          for (int dt = 0; dt < 4; ++dt) { vl[0][dt] = ds_tr(lds + (vA0 ^ (unsigned)(dt << 6))); vh[0][dt] = ds_tr(lds + (vA0 ^ (unsigned)(dt << 6)) + 8 * 256); }
#pragma unroll
          for (int g = 0; g < 4; ++g) { const int u = g >> 1, ss = g & 1;
              if (g < 3) { const int gn = g + 1, un = gn >> 1, sn = gn & 1;
#pragma unroll
                  for (int dt = 0; dt < 4; ++dt) { vl[gn & 1][dt] = ds_tr(lds + (vA0 ^ (unsigned)(dt << 6)) + (32 * un + 16 * sn) * 256); vh[gn & 1][dt] = ds_tr(lds + (vA0 ^ (unsigned)(dt << 6)) + (32 * un + 16 * sn + 8) * 256); } }
              u32x4 pw;
              if (u == 0) { pw.x = pk2(s0[8 * ss], s0[8 * ss + 1]); pw.y = pk2(s0[8 * ss + 2], s0[8 * ss + 3]); pw.z = pk2(s0[8 * ss + 4], s0[8 * ss + 5]); pw.w = pk2(s0[8 * ss + 6], s0[8 * ss + 7]); }
              else { pw.x = pk2(s1[8 * ss], s1[8 * ss + 1]); pw.y = pk2(s1[8 * ss + 2], s1[8 * ss + 3]); pw.z = pk2(s1[8 * ss + 4], s1[8 * ss + 5]); pw.w = pk2(s1[8 * ss + 6], s1[8 * ss + 7]); }
              const bf16x8 pa = __builtin_bit_cast(bf16x8, pw);
              __builtin_amdgcn_sched_barrier(0);
#pragma unroll
              for (int dt = 0; dt < 4; ++dt) { const s16x4 lo = vl[g & 1][dt], hi = vh[g & 1][dt];
                  const bf16x8 vb = (bf16x8){lo[0], lo[1], lo[2], lo[3], hi[0], hi[1], hi[2], hi[3]};
                  o[dt] = MFMA32(pa, vb, o[dt]); }
              __builtin_amdgcn_sched_barrier(0); } }
        kA0 ^= D4_BUF; vA0 ^= D4_BUF;
    }
#undef D4_STAGE
    l += __shfl_xor(l, 32);
    if (half == 0) wsc[q] = 1.f / l;
    asm volatile("s_waitcnt lgkmcnt(0)" ::: "memory");
#pragma unroll
    for (int r = 0; r < 16; ++r) { const int qq = crow(r, half); const float a = wsc[qq];
        bf16_t* orow = U + (mb + t0 + qq) * LDU + C_DQ + h * 128 + q;
#pragma unroll
        for (int dt = 0; dt < 4; ++dt) { const bf16_t ov = (bf16_t)f2bf(o[dt][r] * a); if (!dry) orow[dt * 32] = ov; } }
}
__device__ void phase_dsa_attend4(const Params& p, int bid, int nb, unsigned char* lds, bool dry) {
    { float* tb = (float*)(lds + DA_TB);
      for (int e = threadIdx.x; e < 8 * 129; e += NTHREADS) { const int hh = e / 129, d = e % 129; tb[hh * 132 + d] = p.rel_bias[(d < 128 ? (int)T5B[d] : 31) * 8 + hh] * 1.4426950408889634f; }
      if (threadIdx.x < 8) { float mx = -1e30f; for (int bk = 0; bk < 32; ++bk) mx = fmaxf(mx, p.rel_bias[bk * 8 + threadIdx.x]); tb[threadIdx.x * 132 + 129] = mx * 1.4426950408889634f; }
      if (threadIdx.x < 32) ((unsigned*)(lds + D4_CNT))[threadIdx.x] = 0u; }
    __syncthreads();
    const int grp = __builtin_amdgcn_readfirstlane(threadIdx.x >> 8);
    for (int k = bid; k < 256; k += nb) {
        const int ia = k, ib = ((127 - (k >> 2)) << 2) | (k & 3);
#pragma unroll 1
        for (int r = 0; r < 2; ++r) dsa_attend4_item(p, (r ^ grp) ? ib : ia, lds, dry);
    }
    __syncthreads();
}

__device__ void phase_cross_attend(const Params& p, int bid, int nb, unsigned char* lds, bool dry) {
    for (int k = bid; k < 512; k += nb) attend_item<1>(p, k, lds, dry);
}
__device__ void phase_dsa_attend(const Params& p, int bid, int nb, unsigned char* lds, bool dry) {
    { float* tb = (float*)(lds + DA_TB);
      for (int e = threadIdx.x; e < 8 * 129; e += NTHREADS) { const int hh = e / 129, d = e % 129; tb[hh * 132 + d] = p.rel_bias[(d < 128 ? (int)T5B[d] : 31) * 8 + hh] * 1.4426950408889634f; }
      if (threadIdx.x < 8) { float mx = -1e30f; for (int bk = 0; bk < 32; ++bk) mx = fmaxf(mx, p.rel_bias[bk * 8 + threadIdx.x]); tb[threadIdx.x * 132 + 129] = mx * 1.4426950408889634f; } }
    __syncthreads();
    for (int k2 = 2 * bid; k2 < 512; k2 += (k2 & 1) ? 2 * nb - 1 : 1) { const int k = k2 >> 1; attend_item<0>(p, (k2 & 1) ? (((127 - (k >> 2)) << 2) | (k & 3)) : k, lds, dry); }
}


constexpr size_t WS_GD = 44 * MiB;
static_assert(WS_MASK + (size_t)4 * TRI * 128 <= WS_GD && WS_GD + 1024 * 128 * 4 <= WS_U, "ws map (mask, gla decay)");
__device__ __forceinline__ void gla_stage_v(LAS char* vdst, const bf16_t* Uc, int h, int tid) {
    const int lane = tid & 63, wv = __builtin_amdgcn_readfirstlane(tid >> 6), half = lane >> 5, srow = 2 * wv + half, spc = lane & 31;
    const bf16_t* gv = Uc + (size_t)srow * LDU + C_GV + h * 256 + ((spc ^ ((srow & 3) << 2)) << 3);
#pragma unroll
    for (int i = 0; i < 4; ++i) __builtin_amdgcn_global_load_lds((const unsigned*)(gv + (size_t)16 * i * LDU), (LAS unsigned*)(vdst + (wv + 8 * i) * 1024), 16, 0, 0);
}
constexpr int G1_KT = 0, G1_V = 16384, G1_B = 49152, G1_GA = 81920, G1_SEG = 83968, G1_BT = 86016;
__device__ __forceinline__ void gla_g1_item(const Params& p, int item, unsigned char* lds_, bool dry) {
    LAS char* lds = (LAS char*)lds_;
    bf16_t* U = Uptr(p); bf16_t* GS = (bf16_t*)p.out; float* GD = (float*)(p.ws + WS_GD);
    const int tid = opaque_tid(), lane = tid & 63, wv = __builtin_amdgcn_readfirstlane(tid >> 6), half = lane >> 5;
    const int bh = item >> 6, n = item & 63, b = bh >> 2, h = bh & 3;
    bf16_t* Uc = U + ((size_t)b * SEQ + 64 * n) * LDU;
    const int d8 = tid & 15, tg = tid >> 4;
    const u32x4 qa = *(const u32x4*)(Uc + (size_t)(2 * tg) * LDU + C_GQ + h * 128 + 8 * d8), qb = *(const u32x4*)(Uc + (size_t)(2 * tg + 1) * LDU + C_GQ + h * 128 + 8 * d8);
    const u32x4 ka = *(const u32x4*)(Uc + (size_t)(2 * tg) * LDU + C_GK + h * 128 + 8 * d8), kb = *(const u32x4*)(Uc + (size_t)(2 * tg + 1) * LDU + C_GK + h * 128 + 8 * d8);
    u32x4 gav = (u32x4){0u, 0u, 0u, 0u}; if (tid < 128) gav = *(const u32x4*)(Uc + (size_t)(tid >> 1) * LDU + C_GA + 8 * (tid & 1));
    __syncthreads();
    if (tid < 128) *(LAS u32x4*)(lds + G1_GA + tid * 16) = gav;
    gla_stage_v(lds + G1_V, Uc, h, tid);
    __syncthreads();
    { const int d = tid & 127, seg = tid >> 7;
      float w[16];
#pragma unroll
      for (int r = 0; r < 16; ++r) w[r] = p.w_a_up[r * 512 + h * 128 + d];
      const float ba = p.b_a[h * 128 + d];
      float bl[16]; float cum = 0.f;
#pragma unroll
      for (int i = 0; i < 16; ++i) {
          const u32x4 g0 = *(LAS const u32x4*)(lds + G1_GA + (16 * seg + i) * 32), g1 = *(LAS const u32x4*)(lds + G1_GA + (16 * seg + i) * 32 + 16);
          float x = ba;
          x += __uint_as_float(g0.x << 16) * w[0] + __uint_as_float(g0.x & 0xffff0000u) * w[1] + __uint_as_float(g0.y << 16) * w[2] + __uint_as_float(g0.y & 0xffff0000u) * w[3];
          x += __uint_as_float(g0.z << 16) * w[4] + __uint_as_float(g0.z & 0xffff0000u) * w[5] + __uint_as_float(g0.w << 16) * w[6] + __uint_as_float(g0.w & 0xffff0000u) * w[7];
          x += __uint_as_float(g1.x << 16) * w[8] + __uint_as_float(g1.x & 0xffff0000u) * w[9] + __uint_as_float(g1.y << 16) * w[10] + __uint_as_float(g1.y & 0xffff0000u) * w[11];
          x += __uint_as_float(g1.z << 16) * w[12] + __uint_as_float(g1.z & 0xffff0000u) * w[13] + __uint_as_float(g1.w << 16) * w[14] + __uint_as_float(g1.w & 0xffff0000u) * w[15];
          const float sp = __builtin_amdgcn_logf(1.f + __builtin_amdgcn_exp2f(-1.4426950408889634f * fmaxf(x, -80.f)));
          cum += -0.04332169878499658f * sp; bl[i] = cum;
      }
      LAS float* segsum = (LAS float*)(lds + G1_SEG);
      segsum[seg * 128 + d] = cum;
      __syncthreads();
      float off = 0.f, tot = 0.f;
#pragma unroll
      for (int s2 = 0; s2 < 4; ++s2) { const float v = segsum[s2 * 128 + d]; tot += v; if (s2 < seg) off += v; }
#pragma unroll
      for (int i = 0; i < 16; ++i) *(LAS float*)(lds + G1_B + ((16 * seg + i) * 128 + d) * 4) = bl[i] + off;
      if (seg == 0) { *(LAS float*)(lds + G1_BT + d * 4) = tot; GD[(size_t)item * 128 + d] = __builtin_amdgcn_exp2f(1.4426950408889634f * tot); } }
    __syncthreads();
    { unsigned qo[2][4], ko[2][4]; float kt_[2][8];
#pragma unroll
      for (int tt = 0; tt < 2; ++tt) { const int t = 2 * tg + tt; const u32x4 qv = tt ? qb : qa, kv = tt ? kb : ka;
          const f32x4 b0 = *(LAS const f32x4*)(lds + G1_B + (t * 128 + 8 * d8) * 4), b1 = *(LAS const f32x4*)(lds + G1_B + (t * 128 + 8 * d8 + 4) * 4);
          const f32x4 t0 = *(LAS const f32x4*)(lds + G1_BT + (8 * d8) * 4), t1 = *(LAS const f32x4*)(lds + G1_BT + (8 * d8 + 4) * 4);
          float qd[8], kd[8];
#pragma unroll
          for (int e = 0; e < 8; ++e) { const unsigned qw = e < 2 ? qv.x : e < 4 ? qv.y : e < 6 ? qv.z : qv.w, kw = e < 2 ? kv.x : e < 4 ? kv.y : e < 6 ? kv.z : kv.w;
              const float qf = (e & 1) ? __uint_as_float(qw & 0xffff0000u) : __uint_as_float(qw << 16), kf = (e & 1) ? __uint_as_float(kw & 0xffff0000u) : __uint_as_float(kw << 16);
              const float bb = e < 4 ? b0[e & 3] : b1[e & 3], bt = e < 4 ? t0[e & 3] : t1[e & 3];
              const float ep = __builtin_amdgcn_exp2f(1.4426950408889634f * bb), em = __builtin_amdgcn_exp2f(-1.4426950408889634f * bb);
              qd[e] = qf * 0.08838834764831845f * ep; kd[e] = kf * em; kt_[tt][e] = kf * __builtin_amdgcn_exp2f(1.4426950408889634f * (bt - bb)); }
#pragma unroll
          for (int e = 0; e < 4; ++e) { qo[tt][e] = pk2(qd[2 * e], qd[2 * e + 1]); ko[tt][e] = pk2(kd[2 * e], kd[2 * e + 1]); } }
      if (!dry) {
      if (!dry) {
      *(u32x4*)(Uc + (size_t)(2 * tg) * LDU + C_GQ + h * 128 + 8 * d8) = (u32x4){qo[0][0], qo[0][1], qo[0][2], qo[0][3]};
      *(u32x4*)(Uc + (size_t)(2 * tg + 1) * LDU + C_GQ + h * 128 + 8 * d8) = (u32x4){qo[1][0], qo[1][1], qo[1][2], qo[1][3]};
      *(u32x4*)(Uc + (size_t)(2 * tg) * LDU + C_GK + h * 128 + 8 * d8) = (u32x4){ko[0][0], ko[0][1], ko[0][2], ko[0][3]};
      *(u32x4*)(Uc + (size_t)(2 * tg + 1) * LDU + C_GK + h * 128 + 8 * d8) = (u32x4){ko[1][0], ko[1][1], ko[1][2], ko[1][3]}; } }
#pragma unroll
      for (int e = 0; e < 8; ++e) { const int d = 8 * d8 + e; const int ch = (tg >> 2) ^ ((d >> 1) & 7);
          *(LAS unsigned*)(lds + G1_KT + d * 128 + (ch << 4) + (tg & 3) * 4) = pk2(kt_[0][e], kt_[1][e]); } }
    asm volatile("s_waitcnt vmcnt(0)" ::: "memory");
    __syncthreads();
    f32x16 acc[4];
#pragma unroll
    for (int i = 0; i < 4; ++i)
#pragma unroll
        for (int r = 0; r < 16; ++r) acc[i][r] = 0.f;
    const int dk = 32 * (wv & 3) + (lane & 31), q4 = (lane & 15) >> 2, p4 = lane & 3, g1 = (lane >> 4) & 1;
#pragma unroll
    for (int s_ = 0; s_ < 4; ++s_) {
        const bf16x8 a = *(LAS const bf16x8*)(lds + G1_KT + dk * 128 + (((2 * s_ + half) ^ ((dk >> 1) & 7)) << 4));
#pragma unroll
        for (int i = 0; i < 4; ++i) { const int dtile = 4 * (wv >> 2) + i; const int ch = (dtile * 4 + 2 * g1 + (p4 >> 1)) ^ (q4 << 2);
            const s16x4 lo = ds_tr(lds + G1_V + (16 * s_ + 8 * half + q4) * 512 + (ch << 4) + (p4 & 1) * 8);
            const s16x4 hi = ds_tr(lds + G1_V + (16 * s_ + 8 * half + 4 + q4) * 512 + (ch << 4) + (p4 & 1) * 8);
            const bf16x8 vb = (bf16x8){lo[0], lo[1], lo[2], lo[3], hi[0], hi[1], hi[2], hi[3]};
            acc[i] = MFMA32(a, vb, acc[i]); }
    }
    bf16_t* gs = GS + (size_t)item * 32768;
#pragma unroll
    for (int i = 0; i < 4; ++i) { const int dv = 32 * (4 * (wv >> 2) + i) + (lane & 31);
#pragma unroll
        for (int r4 = 0; r4 < 4; ++r4) { u32x2 w2; w2.x = pk2(acc[i][4 * r4], acc[i][4 * r4 + 1]); w2.y = pk2(acc[i][4 * r4 + 2], acc[i][4 * r4 + 3]);
            *(u32x2*)(gs + (size_t)dv * 128 + 32 * (wv & 3) + 8 * r4 + 4 * half) = w2; } }
}
__device__ void phase_gla_g1(const Params& p, int bid, int nb, unsigned char* lds, bool dry) { for (int it = bid; it < 1024; it += nb) gla_g1_item(p, it, lds, dry); }
__device__ void phase_gla_g2(const Params& p, int bid, int nb, bool dry) {
    bf16_t* GS = (bf16_t*)p.out; const float* GD = (const float*)(p.ws + WS_GD);
    for (int e = bid * NTHREADS + threadIdx.x; e < 16 * 8192; e += nb * NTHREADS) {
        const int bh = e >> 13, w = e & 8191, dk4 = (w & 31) * 4;
        bf16_t* gp = GS + (size_t)bh * 64 * 32768 + (size_t)w * 4; const float* dp = GD + (size_t)bh * 64 * 128 + dk4;
        f32x4 S = (f32x4){0.f, 0.f, 0.f, 0.f};
#pragma unroll 8
        for (int n = 0; n < 64; ++n) {
            const u32x2 t2 = *(const u32x2*)(gp + (size_t)n * 32768); const f32x4 dc = *(const f32x4*)(dp + n * 128);
            u32x2 o2; o2.x = pk2(S[0], S[1]); o2.y = pk2(S[2], S[3]); if (!dry) *(u32x2*)(gp + (size_t)n * 32768) = o2;
            S[0] = dc[0] * S[0] + __uint_as_float(t2.x << 16); S[1] = dc[1] * S[1] + __uint_as_float(t2.x & 0xffff0000u);
            S[2] = dc[2] * S[2] + __uint_as_float(t2.y << 16); S[3] = dc[3] * S[3] + __uint_as_float(t2.y & 0xffff0000u);
        }
    }
}
constexpr int G3_QD = 0, G3_KD = 16384, G3_V = 32768, G3_SSQ = 65536;
__device__ __forceinline__ void gla_g3_item(const Params& p, int item, unsigned char* lds_, bool dry) {
    LAS char* lds = (LAS char*)lds_;
    bf16_t* U = Uptr(p); const bf16_t* GS = (const bf16_t*)p.out;
    const int tid = opaque_tid(), lane = tid & 63, wv = __builtin_amdgcn_readfirstlane(tid >> 6), half = lane >> 5, q = lane & 31;
    const int bh = item >> 6, n = item & 63, b = bh >> 2, h = bh & 3;
    bf16_t* Uc = U + ((size_t)b * SEQ + 64 * n) * LDU;
    LAS float* ssq = (LAS float*)(lds + G3_SSQ);
    __syncthreads();
    { const int r4 = lane >> 4, pc = lane & 15;
#pragma unroll
      for (int i = 0; i < 2; ++i) { const int row = 4 * (wv + 8 * i) + r4; const bf16_t* src = Uc + (size_t)row * LDU + h * 128 + ((pc ^ (row & 15)) << 3);
          __builtin_amdgcn_global_load_lds((const unsigned*)(src + C_GQ), (LAS unsigned*)(lds + G3_QD + (wv + 8 * i) * 1024), 16, 0, 0);
          __builtin_amdgcn_global_load_lds((const unsigned*)(src + C_GK), (LAS unsigned*)(lds + G3_KD + (wv + 8 * i) * 1024), 16, 0, 0); } }
    gla_stage_v(lds + G3_V, Uc, h, tid);
    if (tid < 64) ssq[tid] = 0.f;
    bf16x8 sf[8];
    { const bf16_t* sp = GS + (size_t)item * 32768 + (size_t)(32 * wv + q) * 128 + 8 * half;
#pragma unroll
      for (int kk = 0; kk < 8; ++kk) sf[kk] = *(const bf16x8*)(sp + kk * 16); }
    asm volatile("s_waitcnt vmcnt(0)" ::: "memory");
    __syncthreads();
    f32x16 o[2];
#pragma unroll
    for (int tt = 0; tt < 2; ++tt)
#pragma unroll
        for (int r = 0; r < 16; ++r) o[tt][r] = 0.f;
    const int q4 = (lane & 15) >> 2, p4 = lane & 3, g1 = (lane >> 4) & 1;
    const unsigned vA = G3_V + (4 * half + q4) * 512 + ((((wv * 4 + 2 * g1 + (p4 >> 1))) ^ (q4 << 2)) << 4) + (p4 & 1) * 8;
#pragma unroll
    for (int tt = 0; tt < 2; ++tt) {
#pragma unroll
        for (int kk = 0; kk < 8; ++kk) { const int t = 32 * tt + q;
            const bf16x8 a = *(LAS const bf16x8*)(lds + G3_QD + t * 256 + (((2 * kk + half) ^ (t & 15)) << 4));
            o[tt] = MFMA32(a, sf[kk], o[tt]); }
#pragma unroll
        for (int st = 0; st <= tt; ++st) {
            f32x16 x;
#pragma unroll
            for (int r = 0; r < 16; ++r) x[r] = 0.f;
#pragma unroll
            for (int kk = 0; kk < 8; ++kk) { const int srow = 32 * st + q, trow = 32 * tt + q;
                const bf16x8 a = *(LAS const bf16x8*)(lds + G3_KD + srow * 256 + (((2 * kk + half) ^ (srow & 15)) << 4));
                const bf16x8 bq = *(LAS const bf16x8*)(lds + G3_QD + trow * 256 + (((2 * kk + half) ^ (trow & 15)) << 4));
                x = MFMA32(a, bq, x); }
            if (st == tt) {
#pragma unroll
                for (int r = 0; r < 16; ++r) x[r] = (crow(r, half) <= q) ? x[r] : 0.f;
            }
#pragma unroll
            for (int ss = 0; ss < 2; ++ss) {
                u32x4 pw; pw.x = pk2(x[8 * ss], x[8 * ss + 1]); pw.y = pk2(x[8 * ss + 2], x[8 * ss + 3]); pw.z = pk2(x[8 * ss + 4], x[8 * ss + 5]); pw.w = pk2(x[8 * ss + 6], x[8 * ss + 7]);
                const bf16x8 pa = __builtin_bit_cast(bf16x8, pw);
                const s16x4 lo = ds_tr(lds + vA + (32 * st + 16 * ss) * 512);
                const s16x4 hi = ds_tr(lds + vA + (32 * st + 16 * ss + 8) * 512);
                const bf16x8 vb = (bf16x8){lo[0], lo[1], lo[2], lo[3], hi[0], hi[1], hi[2], hi[3]};
                o[tt] = MFMA32(pa, vb, o[tt]);
            }
        }
    }
#pragma unroll
    for (int tt = 0; tt < 2; ++tt)
#pragma unroll
        for (int r = 0; r < 16; ++r) { float v = o[tt][r] * o[tt][r];
            v += __shfl_xor(v, 1); v += __shfl_xor(v, 2); v += __shfl_xor(v, 4); v += __shfl_xor(v, 8); v += __shfl_xor(v, 16);
            if (q == 0) __hip_atomic_fetch_add(ssq + 32 * tt + crow(r, half), v, __ATOMIC_RELAXED, __HIP_MEMORY_SCOPE_WORKGROUP); }
    __syncthreads();
    const float gg = p.g_gla[32 * wv + q];
#pragma unroll
    for (int tt = 0; tt < 2; ++tt)
#pragma unroll
        for (int r = 0; r < 16; ++r) { const int t = 32 * tt + crow(r, half); const float rstd = 1.f / sqrtf(ssq[t] * (1.f / 256.f) + EPS);
            const bf16_t ov = (bf16_t)f2bf(o[tt][r] * rstd * gg); if (!dry) Uc[(size_t)t * LDU + C_GV + h * 256 + 32 * wv + q] = ov; }
}
__device__ void phase_gla_g3(const Params& p, int bid, int nb, unsigned char* lds, bool dry) { for (int it = bid; it < 1024; it += nb) gla_g3_item(p, it, lds, dry); }

__device__ void phase_cross_ref(const Params& p, int bid, int nb, unsigned char* lds) {
    float* qs = (float*)lds;
    float* lg = qs + 1024;
    bf16_t* U = Uptr(p); const bf16_t* MKV = (const bf16_t*)(p.ws + WS_MKV);
    const int tid = threadIdx.x, lane = tid & 63, wave = tid >> 6;
    for (int it = bid; it < MTOK; it += nb) {
        const int b = it / SEQ; const size_t m = (size_t)it; const bf16_t* mb = MKV + (size_t)b * NMEM * 2048;
        __syncthreads();
        qs[tid] = bf2f(U[m * LDU + C_XQ + tid]) * 0.0625f; qs[tid + 512] = bf2f(U[m * LDU + C_XQ + 512 + tid]) * 0.0625f;
        __syncthreads();
        { const int j = tid & 255, hp = tid >> 8;
          const bf16_t* kr = mb + (size_t)j * 2048 + hp * 512; float a0 = 0.f, a1 = 0.f;
          for (int d0 = 0; d0 < 256; d0 += 8) { const bf16x8 k0 = *(const bf16x8*)(kr + d0); const bf16x8 k1 = *(const bf16x8*)(kr + 256 + d0);
#pragma unroll
              for (int dd = 0; dd < 8; ++dd) { a0 += qs[hp * 512 + d0 + dd] * bf2f((bf16_t)k0[dd]); a1 += qs[hp * 512 + 256 + d0 + dd] * bf2f((bf16_t)k1[dd]); } }
          lg[(2 * hp) * 256 + j] = a0; lg[(2 * hp + 1) * 256 + j] = a1; }
        __syncthreads();
        if (wave < 4) { float v[4]; float mx = -3e38f;
#pragma unroll
            for (int i = 0; i < 4; ++i) { v[i] = lg[wave * 256 + lane + 64 * i]; mx = fmaxf(mx, v[i]); }
            mx = wave_max(mx); float sm = 0.f;
#pragma unroll
            for (int i = 0; i < 4; ++i) { v[i] = __expf(v[i] - mx); sm += v[i]; }
            sm = wave_sum(sm); const float inv = 1.f / sm;
#pragma unroll
            for (int i = 0; i < 4; ++i) lg[wave * 256 + lane + 64 * i] = v[i] * inv; }
        __syncthreads();
        { const int h = tid >> 7, d = (tid & 127) * 2; float o0 = 0.f, o1 = 0.f;
          for (int j = 0; j < NMEM; ++j) { const float pj = lg[h * 256 + j]; const unsigned w = *(const unsigned*)(mb + (size_t)j * 2048 + 1024 + h * 256 + d);
              o0 += pj * __uint_as_float(w << 16); o1 += pj * __uint_as_float(w & 0xffff0000u); }
          *(unsigned*)(U + m * LDU + C_XQ + h * 256 + d) = pk2(o0, o1); }
    }
}

__device__ void phase_final(const Params& p, int bid, int nb, bool dry) {
    const int lane = threadIdx.x & 63, wave = threadIdx.x >> 6;
    for (int m = bid * NWAVES + wave; m < MTOK; m += nb * NWAVES) {
        f32x4* orow = (f32x4*)(p.out + (size_t)m * DM) + lane; const f32x4* xr = (const f32x4*)(p.x + (size_t)m * DM) + lane; const f32x4* gr = (const f32x4*)p.g_post + lane;
        f32x4 v[4]; float s = 0.f;
#pragma unroll
        for (int j = 0; j < 4; ++j) { v[j] = orow[64 * j]; s += (v[j].x * v[j].x + v[j].y * v[j].y) + (v[j].z * v[j].z + v[j].w * v[j].w); }
        const float rstd = 1.f / sqrtf(wave_sum(s) * (1.f / DM) + EPS);
#pragma unroll
        for (int j = 0; j < 4; ++j) { const f32x4 ov = xr[64 * j] + v[j] * rstd * gr[64 * j]; if (!dry) orow[64 * j] = ov; }
    }
}


#define XB_TMO      128
#define XB_XCNT(j)  (256  + 64 * (j))
#define XB_XSUB(j)  (1280 + 64 * (j))
#define XB_XGEN(j)  (2304 + 64 * (j))
#define XB_TOP      3328
#define XB_TOPGEN   3392
#define XCD_BAR_WORDS 3456
#define XB_SPIN_CAP (1u << 22)
constexpr size_t WS_BAR = 46 * MiB;
__device__ __forceinline__ unsigned xb_ld(unsigned* p)              { return __hip_atomic_load(p, __ATOMIC_RELAXED, __HIP_MEMORY_SCOPE_AGENT); }
__device__ __forceinline__ unsigned xb_add(unsigned* p, unsigned v) { return __hip_atomic_fetch_add(p, v, __ATOMIC_RELAXED, __HIP_MEMORY_SCOPE_AGENT); }
__device__ __forceinline__ unsigned xb_xcc_id() { return (unsigned)__builtin_amdgcn_s_getreg((3 << 11) | 20) & 0xFu; }
#define XB_SPIN(cond, bar) do { unsigned _sp = 0; while (cond) { __builtin_amdgcn_s_sleep(1); \
    if ((++_sp & 255u) == 0u) { if (xb_ld(&(bar)[XB_TMO])) break; if (_sp > XB_SPIN_CAP) { atomicAdd(&(bar)[XB_TMO], 1u); break; } } } } while (0)
struct XcdBarrier { unsigned* bar; unsigned x; volatile LAS unsigned* st; };
__device__ __forceinline__ XcdBarrier xcd_barrier_post(unsigned* bar, volatile LAS unsigned* st) {
    XcdBarrier b; b.bar = bar; b.x = xb_xcc_id(); b.st = st;
    if (threadIdx.x == 0) (void)xb_add(&bar[XB_XCNT(b.x)], 1u);
    return b;
}
__device__ __forceinline__ void xcd_barrier_complete(unsigned* bar, unsigned x, unsigned& nloc, unsigned& nx) {
    const unsigned G = gridDim.x * gridDim.y * gridDim.z;
    unsigned sum, cnt, mine, sp = 0u;
    for (;;) {
        sum = 0u; cnt = 0u; mine = 0u;
#pragma unroll
        for (unsigned j = 0; j < 16; ++j) { const unsigned c = xb_ld(&bar[XB_XCNT(j)]); sum += c; cnt += (c > 0u) ? 1u : 0u; mine = (j == x) ? c : mine; }
        if (sum == G) break;
        __builtin_amdgcn_s_sleep(1);
        if ((++sp & 255u) == 0u) { if (xb_ld(&bar[XB_TMO])) break; if (sp > XB_SPIN_CAP) { atomicAdd(&bar[XB_TMO], 1u); break; } }
    }
    nloc = mine > 0u ? mine : 1u; nx = cnt > 0u ? cnt : 1u;
}
__device__ __forceinline__ void xcd_barrier(const XcdBarrier& b) {
    asm volatile("s_waitcnt vmcnt(0)" ::: "memory");
    __syncthreads();
    if (threadIdx.x == 0) {
        unsigned* bar = b.bar;
        __builtin_amdgcn_s_waitcnt(0);
        unsigned nloc = b.st[0], nx = b.st[1];
        if (nloc == 0u) { xcd_barrier_complete(bar, b.x, nloc, nx); b.st[0] = nloc; b.st[1] = nx; }
        const unsigned old = xb_add(&bar[XB_XSUB(b.x)], 1u);
        const unsigned gen = old / nloc;
        if (old + 1u == (gen + 1u) * nloc) {
            __builtin_amdgcn_fence(__ATOMIC_RELEASE, "agent");
            asm volatile("s_waitcnt vmcnt(0)" ::: "memory");
            const unsigned og = xb_add(&bar[XB_TOP], 1u);
            const unsigned tg = og / nx;
            if (og + 1u == (tg + 1u) * nx) xb_add(&bar[XB_TOPGEN], 1u);
            else XB_SPIN(xb_ld(&bar[XB_TOPGEN]) == tg, bar);
            __builtin_amdgcn_fence(__ATOMIC_ACQUIRE, "agent");
            xb_add(&bar[XB_XGEN(b.x)], 1u);
            asm volatile("s_waitcnt vmcnt(0)" ::: "memory");
        } else {
            XB_SPIN(xb_ld(&bar[XB_XGEN(b.x)]) == gen, bar);
            __builtin_amdgcn_fence(__ATOMIC_ACQUIRE, "agent");
            asm volatile("s_waitcnt vmcnt(0)" ::: "memory");
        }
    }
    __syncthreads();
}

constexpr int NPHASE = 9;
constexpr int LDS_BYTES = 144 * 1024;
#ifndef USE_PG8
#define USE_PG8 1
#endif
__device__ __forceinline__ void run_phase(const Params& p, int ph, int bid, int nb, unsigned char* lds, bool dry = false) {
    bf16_t* U = Uptr(p); const bf16_t* WT = (const bf16_t*)(p.ws + WS_WTALL);
    bf16_t* S2 = (bf16_t*)p.out; float* oraw = p.out;
    PG8_LAS unsigned char* lds3 = (PG8_LAS unsigned char*)lds;
    switch (ph) {
    case 0: phase_prep(p, bid, nb, lds); break;
    case 1: { OpStoreBf16 o1{U, LDU, 1024}; OpStoreBf16 o2{(bf16_t*)(p.ws + WS_MKV), 2048, 0};
#if USE_PG8
              pg8::Sched S{}; S.j[0] = pg8::Job{U + C_H, WT, MTOK / 256, N1 / 256}; S.j[1] = pg8::Job{(const bf16_t*)p.out, (const bf16_t*)(p.ws + WS_WTMKV), MMEM / 256, 2048 / 256};
              S.njobs = 2; S.rep = 1; S.G = nb; S.c = bid; S.lda = LDU; S.astride = 0; S.bstride = 0;
              pg8::Epi<SelP1> E{SelP1{o1, o2}}; pg8::gemm_phase<pg8::Epi<SelP1>, true>(lds3, S, E);
#else
              gemm_simple(U + C_H, LDU, WT, MTOK, N1, DM, o1, bid, nb); gemm_simple((const bf16_t*)p.out, LDU, (const bf16_t*)(p.ws + WS_WTMKV), MMEM, 2048, DM, o2, bid, nb);
#endif
            } break;
#if !defined(DSA_REF) && !defined(GLA_REF)
    case 2: phase_gla_g1(p, bid, nb, lds, dry); phase_dsa_select2(p, bid, nb, lds); break;
    case 3: phase_gla_g2(p, bid, nb, dry); phase_dsa_attend4(p, bid, nb, lds, dry); break;
#elif !defined(DSA_REF)
    case 2: phase_gla_rec(p, oraw, bid, nb, lds); phase_dsa_select(p, bid, nb, lds); break;
    case 3: phase_gla_norm(p, oraw, bid, nb); phase_dsa_attend(p, bid, nb, lds, dry); break;
#else
    case 2: phase_gla_rec(p, oraw, bid, nb, lds); break;
    case 3: phase_gla_norm(p, oraw, bid, nb); phase_dsa_ref(p, bid, nb, lds); break;
#endif
#ifndef CROSS_REF
    case 4:
#ifndef GLA_REF
        phase_gla_g3(p, bid, nb, lds, dry);
#endif
        phase_cross_attend(p, bid, nb, lds, dry); break;
#else
    case 4: phase_cross_ref(p, bid, nb, lds); break;
#endif
    case 5: { OpZGate oz{U, dry}; OpSig os{S2, U};
#if USE_PG8
              pg8::Sched S{}; S.j[0] = pg8::Job{U + C_H, WT + (size_t)WT_Z * DM, MTOK / 256, 3072 / 256}; S.j[1] = pg8::Job{U + C_H, WT + (size_t)WT_G * DM, MTOK / 256, 3072 / 256};
              S.njobs = 2; S.rep = 1; S.G = nb; S.c = bid; S.lda = LDU; S.astride = 0; S.bstride = 0;
              pg8::Epi<SelP5> E{SelP5{oz, os}}; pg8::gemm_phase<pg8::Epi<SelP5>, true>(lds3, S, E);
#else
              gemm_simple(U + C_H, LDU, WT + (size_t)WT_Z * DM, MTOK, 3072, DM, oz, bid, nb); gemm_simple(U + C_H, LDU, WT + (size_t)WT_G * DM, MTOK, 3072, DM, os, bid, nb);
#endif
            } break;
    case 6: { OpMerge<0> m0{S2, U}; OpMerge<1> m1{S2, U}; OpMerge<2> m2{S2, U};
#if USE_PG8
              pg8::Sched S{}; S.j[0] = pg8::Job{U + C_GV, (const bf16_t*)(p.ws + WS_WTGO), MTOK / 256, DM / 256};
              S.njobs = 1; S.rep = 3; S.G = nb; S.c = bid; S.lda = LDU; S.astride = 1024; S.bstride = (long)(WS_WTDO - WS_WTGO) / 2;
              pg8::Epi<SelP6> E{SelP6{m0, m1, m2}}; pg8::gemm_phase<pg8::Epi<SelP6>, true>(lds3, S, E);
#else
              gemm_simple(U + C_GV, LDU, (const bf16_t*)(p.ws + WS_WTGO), MTOK, DM, DM, m0, bid, nb);
              gemm_simple(U + C_DQ, LDU, (const bf16_t*)(p.ws + WS_WTDO), MTOK, DM, DM, m1, bid, nb);
              gemm_simple(U + C_XQ, LDU, (const bf16_t*)(p.ws + WS_WTXO), MTOK, DM, DM, m2, bid, nb);
#endif
            } break;
    case 7: { OpOutF32 oo{p.out};
#if USE_PG8
              pg8::Sched S{}; S.j[0] = pg8::Job{U + C_MG, (const bf16_t*)(p.ws + WS_WTO), MTOK / 256, DM / 256};
              S.njobs = 1; S.rep = 1; S.G = nb; S.c = bid; S.lda = LDU; S.astride = 0; S.bstride = 0;
              pg8::Epi<SelP7> E{SelP7{oo}}; pg8::gemm_phase<pg8::Epi<SelP7>, false>(lds3, S, E);
#else
              gemm_simple(U + C_MG, LDU, (const bf16_t*)(p.ws + WS_WTO), MTOK, DM, DM, oo, bid, nb);
#endif
            } break;
    case 8: phase_final(p, bid, nb, dry); break;
    }
}

#if ONE_LAUNCH
__global__ void __launch_bounds__(NTHREADS) fwd_mega(Params p) {
    extern __shared__ __attribute__((aligned(16))) unsigned char lds[];
    cg::grid_group grid = cg::this_grid();
    const int bid = blockIdx.x, nb = gridDim.x;
    volatile LAS unsigned* xst = (volatile LAS unsigned*)((LAS unsigned char*)lds + LDS_BYTES - 16);
    unsigned* barw = (unsigned*)(p.ws + WS_BAR);
    if (threadIdx.x < 4) xst[threadIdx.x] = 0u;
    __syncthreads();
    if (p.ws == nullptr) grid.sync();
    const XcdBarrier xbar = xcd_barrier_post(barw, xst);
#ifdef PROF_PHASE
#define PROF_DUP(k) if (PROF_PHASE == (k)) { run_phase(p, (k), bid, nb, lds, p.g_pre != nullptr); GSYNC(); } \
    if (PROF_PHASE == 10 * (k) + 0) { const bool dry_ = p.g_pre != nullptr; if ((k) == 2) phase_gla_g1(p, bid, nb, lds, dry_); if ((k) == 3) phase_gla_g2(p, bid, nb, dry_); if ((k) == 4) phase_gla_g3(p, bid, nb, lds, dry_); GSYNC(); } \
    if (PROF_PHASE == 10 * (k) + 1) { const bool dry_ = p.g_pre != nullptr; if ((k) == 2) phase_dsa_select2(p, bid, nb, lds); if ((k) == 3) phase_dsa_attend4(p, bid, nb, lds, dry_); if ((k) == 4) phase_cross_attend(p, bid, nb, lds, dry_); GSYNC(); }
#else
#define PROF_DUP(k)
#endif
#define GSYNC() xcd_barrier(xbar)
    PROF_DUP(0) run_phase(p, 0, bid, nb, lds); GSYNC();
    PROF_DUP(1) run_phase(p, 1, bid, nb, lds); GSYNC();
    PROF_DUP(2) run_phase(p, 2, bid, nb, lds); GSYNC();
    PROF_DUP(3) run_phase(p, 3, bid, nb, lds); GSYNC();
    PROF_DUP(4) run_phase(p, 4, bid, nb, lds); GSYNC();
    PROF_DUP(5) run_phase(p, 5, bid, nb, lds); GSYNC();
    PROF_DUP(6) run_phase(p, 6, bid, nb, lds); GSYNC();
    PROF_DUP(7) run_phase(p, 7, bid, nb, lds); GSYNC();
    PROF_DUP(8) run_phase(p, 8, bid, nb, lds);
#undef GSYNC
}
#else
template <int PH> __global__ void __launch_bounds__(NTHREADS) fwd_phase(Params p) {
    extern __shared__ __attribute__((aligned(16))) unsigned char lds[];
    run_phase(p, PH, blockIdx.x, gridDim.x, lds);
}
#endif

extern "C" void kernel_launch(void* const* d_in, const int* in_sizes, int n_in, void* d_out, int out_size, void* d_ws, size_t ws_size, hipStream_t stream) {
    if (n_in != 15 || out_size != MTOK * DM || ws_size < WS_END) { fprintf(stderr, "kernel_launch: unexpected shapes (n_in %d out %d ws %zu)\n", n_in, out_size, ws_size); return; }
    Params p{};
    p.x = (const float*)d_in[0]; p.mem = (const float*)d_in[1]; p.g_pre = (const float*)d_in[2]; p.g_post = (const float*)d_in[3]; p.g_mem = (const float*)d_in[4];
    p.w_in = (const float*)d_in[5]; p.w_a_up = (const float*)d_in[6]; p.b_a = (const float*)d_in[7]; p.g_gla = (const float*)d_in[8]; p.rel_bias = (const float*)d_in[9];
    p.w_mem_kv = (const float*)d_in[10]; p.w_gla_out = (const float*)d_in[11]; p.w_dsa_out = (const float*)d_in[12]; p.w_x_out = (const float*)d_in[13]; p.w_o = (const float*)d_in[14];
    p.out = (float*)d_out; p.ws = (unsigned char*)d_ws;
#if ONE_LAUNCH
    static int grid_blocks = 0;
    if (!grid_blocks) {
        int dev = 0, cus = 0, per_cu = 0;
        hipGetDevice(&dev); hipDeviceGetAttribute(&cus, hipDeviceAttributeMultiprocessorCount, dev);
        hipFuncSetAttribute((const void*)fwd_mega, hipFuncAttributeMaxDynamicSharedMemorySize, LDS_BYTES);
        hipOccupancyMaxActiveBlocksPerMultiprocessor(&per_cu, (const void*)fwd_mega, NTHREADS, LDS_BYTES);
        if (per_cu < 1) per_cu = 1;
        grid_blocks = cus * per_cu;
    }
    (void)hipMemsetAsync((unsigned char*)d_ws + WS_BAR, 0, XCD_BAR_WORDS * 4, stream);
    void* args[] = {&p};
    hipError_t e = hipLaunchCooperativeKernel((void*)fwd_mega, dim3(grid_blocks), dim3(NTHREADS), args, LDS_BYTES, stream);
    if (e != hipSuccess) fprintf(stderr, "cooperative launch failed: %s (grid %d)\n", hipGetErrorString(e), grid_blocks);
#else
    const int G = 1024;
    static bool attr_done = false;
#define LAUNCH(PH) do { if (!attr_done) (void)hipFuncSetAttribute((const void*)fwd_phase<PH>, hipFuncAttributeMaxDynamicSharedMemorySize, LDS_BYTES); hipLaunchKernelGGL(fwd_phase<PH>, dim3(G), dim3(NTHREADS), LDS_BYTES, stream, p); } while (0)
    LAUNCH(0); LAUNCH(1); LAUNCH(2); LAUNCH(3); LAUNCH(4); LAUNCH(5); LAUNCH(6); LAUNCH(7); LAUNCH(8);
    attr_done = true;
#undef LAUNCH
#endif
}
```

```cpp
#include <hip/hip_runtime.h>
#include <hip/hip_cooperative_groups.h>
#include <cstdio>
#include <cstdint>
namespace cg = cooperative_groups;

#ifndef ONE_LAUNCH
#define ONE_LAUNCH 1
#endif

typedef unsigned short bf16_t;
typedef short bf16x8 __attribute__((ext_vector_type(8)));
typedef float f32x4 __attribute__((ext_vector_type(4)));
typedef unsigned u32x2 __attribute__((ext_vector_type(2)));
typedef unsigned u32x4 __attribute__((ext_vector_type(4)));

constexpr int NBATCH = 4, SEQ = 4096, DM = 1024, MTOK = NBATCH * SEQ;
constexpr int NMEM = 256, MMEM = NBATCH * NMEM;
constexpr int WIN_COLS = 11352;
constexpr float EPS = 1e-6f;
constexpr int NTHREADS = 512, NWAVES = 8;
constexpr int LDU = 6400;
constexpr int C_H = 0, C_GV = 1024, C_DQ = 2048, C_XQ = 3072, C_GQ = 4096, C_GK = 4608, C_DK = 5120, C_DV = 5376, C_IQ = 5632, C_IK = 6144, C_GA = 6208, C_IW = 6224;
constexpr int C_SM = 4096;
constexpr int C_MG = 5120;
constexpr int N1 = 5376;
constexpr int WT_Z = 5376, WT_G = 8448, WT_ROWS = 11520;
constexpr size_t MiB = 1u << 20;
constexpr size_t WS_WTALL = 0, WS_WTMKV = 23 * MiB, WS_WTGO = 27 * MiB, WS_WTDO = 29 * MiB, WS_WTXO = 31 * MiB, WS_WTO = 33 * MiB;
constexpr size_t WS_MKV = 35 * MiB, WS_MASK = 39 * MiB  , WS_U = 48 * MiB, WS_END = 248 * MiB;
static_assert(WS_U + (size_t)MTOK * LDU * 2 == WS_END && WS_END <= 256 * MiB, "ws map");

struct Params {
    const float *x, *mem, *g_pre, *g_post, *g_mem, *w_in, *w_a_up, *b_a, *g_gla, *rel_bias, *w_mem_kv, *w_gla_out, *w_dsa_out, *w_x_out, *w_o;
    float* out; unsigned char* ws;
};

__device__ const unsigned char T5B[128] = {0, 1, 2, 3, 4, 5, 6, 7, 8, 9, 10, 11, 12, 13, 14, 15, 16, 16, 16, 17, 17, 18, 18, 18, 19, 19, 19, 20, 20, 20, 20, 21, 21, 21, 21, 22, 22, 22, 22, 22, 23, 23, 23, 23, 23, 23, 24, 24, 24, 24, 24, 24, 25, 25, 25, 25, 25, 25, 25, 26, 26, 26, 26, 26, 26, 26, 26, 27, 27, 27, 27, 27, 27, 27, 27, 27, 27, 28, 28, 28, 28, 28, 28, 28, 28, 28, 28, 29, 29, 29, 29, 29, 29, 29, 29, 29, 29, 29, 29, 30, 30, 30, 30, 30, 30, 30, 30, 30, 30, 30, 30, 30, 30, 31, 31, 31, 31, 31, 31, 31, 31, 31, 31, 31, 31, 31, 31, 31};

__device__ __forceinline__ float bf2f(bf16_t b) { return __uint_as_float((unsigned)b << 16); }
__device__ __forceinline__ unsigned f2bf(float f) { unsigned u = __float_as_uint(f); return (u + 0x7fffu + ((u >> 16) & 1u)) >> 16; }
typedef float f32x2_t_ __attribute__((ext_vector_type(2))); typedef __bf16 bf16x2_t_ __attribute__((ext_vector_type(2)));
__device__ __forceinline__ unsigned pk2(float lo, float hi) { f32x2_t_ v = {lo, hi}; bf16x2_t_ b = __builtin_convertvector(v, bf16x2_t_); return __builtin_bit_cast(unsigned, b); }
__device__ __forceinline__ float wave_sum(float v) {
#pragma unroll
    for (int o = 1; o < 64; o <<= 1) v += __shfl_xor(v, o);
    return v;
}
__device__ __forceinline__ float wave_max(float v) {
#pragma unroll
    for (int o = 1; o < 64; o <<= 1) v = fmaxf(v, __shfl_xor(v, o));
    return v;
}
__device__ __forceinline__ int opaque_tid() { int t = threadIdx.x; asm volatile("" : "+v"(t)); return t; }
__device__ __forceinline__ bf16_t* Uptr(const Params& p) { return (bf16_t*)(p.ws + WS_U); }

__device__ __forceinline__ int win_src_col(int r) {
    if (r < 1024) return 1024 + r;
    if (r < 2048) return 3088 + (r - 1024);
    if (r < 3072) return 6232 + (r - 2048);
    if (r < 3584) return r - 3072;
    if (r < 4096) return 512 + (r - 3584);
    if (r < 4352) return 4112 + (r - 4096);
    if (r < 4608) return 4368 + (r - 4352);
    if (r < 5120) return 4624 + (r - 4608);
    if (r < 5184) return 5136 + (r - 5120);
    if (r < 5200) return 2048 + (r - 5184);
    if (r < 5208) return 5200 + (r - 5200);
    if (r < 5376) return -1;
    if (r < 6400) return 2064 + (r - 5376);
    if (r < 7424) return 5208 + (r - 6400);
    if (r < 8448) return 7256 + (r - 7424);
    return 8280 + (r - 8448);
}

template <bool MAP>
__device__ __forceinline__ void transpose_item(const float* W, int ldw, int K, bf16_t* WT, float* scr  , int item, int lane) {
    const int nkb = K / 64, nb = item / nkb, kb = item % nkb, k0 = 64 * kb, n0 = 64 * nb;
    const int n4 = n0 + 4 * (lane & 15);
    const int c = MAP ? win_src_col(n4) : n4;
#pragma unroll 8
    for (int i = 0; i < 16; ++i) { const int kk = 4 * i + (lane >> 4);
        const f32x4 v = (c >= 0) ? *(const f32x4*)(W + (size_t)(k0 + kk) * ldw + c) : (f32x4){0.f, 0.f, 0.f, 0.f};
        *(f32x4*)(scr + kk * 68 + 4 * (lane & 15)) = v; }
    asm volatile("s_waitcnt lgkmcnt(0)" ::: "memory");
#pragma unroll
    for (int c8 = 0; c8 < 8; ++c8) { const float* s_ = scr + (8 * c8) * 68 + lane;
        u32x4 o; o.x = pk2(s_[0 * 68], s_[1 * 68]); o.y = pk2(s_[2 * 68], s_[3 * 68]); o.z = pk2(s_[4 * 68], s_[5 * 68]); o.w = pk2(s_[6 * 68], s_[7 * 68]);
        *(u32x4*)(WT + (size_t)(n0 + lane) * K + k0 + 8 * c8) = o; }
    asm volatile("s_waitcnt lgkmcnt(0)" ::: "memory");
}
__device__ __forceinline__ void rms_row_to_bf16(const float* xrow, const float* g, bf16_t* orow, int lane) {
    const f32x4* xr = (const f32x4*)xrow + lane; const f32x4* gr = (const f32x4*)g + lane;
    f32x4 v[4]; float s = 0.f;
#pragma unroll
    for (int j = 0; j < 4; ++j) { v[j] = xr[64 * j]; s += (v[j].x * v[j].x + v[j].y * v[j].y) + (v[j].z * v[j].z + v[j].w * v[j].w); }
    const float rstd = 1.f / sqrtf(wave_sum(s) * (1.f / DM) + EPS);
    unsigned long long* o8 = (unsigned long long*)orow + lane;
#pragma unroll
    for (int j = 0; j < 4; ++j) { const f32x4 gg = gr[64 * j];
        o8[64 * j] = (unsigned long long)pk2(v[j].x * rstd * gg.x, v[j].y * rstd * gg.y) | ((unsigned long long)pk2(v[j].z * rstd * gg.z, v[j].w * rstd * gg.w) << 32); }
}
__device__ void phase_prep(const Params& p, int bid, int nb, unsigned char* lds) {
    const int tid = threadIdx.x, lane = tid & 63, wave = tid >> 6;
    float* scr = (float*)lds + wave * (64 * 68);
    const int gw = bid * NWAVES + wave, NGW = nb * NWAVES;
    constexpr int I_ALL = (WT_ROWS / 64) * (DM / 64), I_MKV = (2048 / 64) * (DM / 64), I_SQ = (DM / 64) * (DM / 64);
    constexpr int NITEMS = I_ALL + I_MKV + 4 * I_SQ;
    for (int it = gw; it < NITEMS; it += NGW) {
        int r = it;
        if (r < I_ALL) { transpose_item<true>(p.w_in, WIN_COLS, DM, (bf16_t*)(p.ws + WS_WTALL), scr, r, lane); continue; } r -= I_ALL;
        if (r < I_MKV) { transpose_item<false>(p.w_mem_kv, 2048, DM, (bf16_t*)(p.ws + WS_WTMKV), scr, r, lane); continue; } r -= I_MKV;
        if (r < I_SQ) { transpose_item<false>(p.w_gla_out, DM, DM, (bf16_t*)(p.ws + WS_WTGO), scr, r, lane); continue; } r -= I_SQ;
        if (r < I_SQ) { transpose_item<false>(p.w_dsa_out, DM, DM, (bf16_t*)(p.ws + WS_WTDO), scr, r, lane); continue; } r -= I_SQ;
        if (r < I_SQ) { transpose_item<false>(p.w_x_out, DM, DM, (bf16_t*)(p.ws + WS_WTXO), scr, r, lane); continue; } r -= I_SQ;
        transpose_item<false>(p.w_o, DM, DM, (bf16_t*)(p.ws + WS_WTO), scr, r, lane);
    }
    bf16_t* U = Uptr(p);
    for (int m = gw; m < MTOK + MMEM; m += NGW) {
        if (m < MTOK) rms_row_to_bf16(p.x + (size_t)m * DM, p.g_pre, U + (size_t)m * LDU + C_H, lane);
        else rms_row_to_bf16(p.mem + (size_t)(m - MTOK) * DM, p.g_mem, (bf16_t*)p.out + (size_t)(m - MTOK) * LDU, lane);
    }
}

__device__ __forceinline__ void ld8bf(const bf16_t* q, f32x4& a, f32x4& b) { const u32x4 w = *(const u32x4*)q; a[0] = __uint_as_float(w.x << 16); a[1] = __uint_as_float(w.x & 0xffff0000u); a[2] = __uint_as_float(w.y << 16); a[3] = __uint_as_float(w.y & 0xffff0000u);
    b[0] = __uint_as_float(w.z << 16); b[1] = __uint_as_float(w.z & 0xffff0000u); b[2] = __uint_as_float(w.w << 16); b[3] = __uint_as_float(w.w & 0xffff0000u); }
__device__ __forceinline__ void st8bf(bf16_t* q, f32x4 a, f32x4 b) { u32x4 w; w.x = pk2(a[0], a[1]); w.y = pk2(a[2], a[3]); w.z = pk2(b[0], b[1]); w.w = pk2(b[2], b[3]); *(u32x4*)q = w; }
struct OpStoreBf16 { bf16_t* C; int ldc, coff;
    __device__ __forceinline__ void op8(int r, int c, f32x4 a, f32x4 b) const { st8bf(C + (size_t)r * ldc + coff + c, a, b); }
    __device__ __forceinline__ void operator()(int r, int c, f32x4 v) const { u32x2 w; w.x = pk2(v[0], v[1]); w.y = pk2(v[2], v[3]); *(u32x2*)(C + (size_t)r * ldc + coff + c) = w; } };
__device__ __forceinline__ f32x4 ld4bf(const bf16_t* q) { const u32x2 w = *(const u32x2*)q; f32x4 o; o[0] = __uint_as_float(w.x << 16); o[1] = __uint_as_float(w.x & 0xffff0000u); o[2] = __uint_as_float(w.y << 16); o[3] = __uint_as_float(w.y & 0xffff0000u); return o; }
__device__ __forceinline__ void st4bf(bf16_t* q, f32x4 v) { u32x2 w; w.x = pk2(v[0], v[1]); w.y = pk2(v[2], v[3]); *(u32x2*)q = w; }
__device__ __forceinline__ float sigmoidf_(float x) { return __builtin_amdgcn_rcpf(1.f + __builtin_amdgcn_exp2f(-1.4426950408889634f * x)); }
struct OpZGate { bf16_t* U; bool dry;
    __device__ __forceinline__ void op8(int r, int c, f32x4 z0, f32x4 z1) const { bf16_t* q = U + (size_t)r * LDU + 1024 + c; f32x4 o0, o1; ld8bf(q, o0, o1);
#pragma unroll
        for (int i = 0; i < 4; ++i) { o0[i] = o0[i] * z0[i] * sigmoidf_(z0[i]); o1[i] = o1[i] * z1[i] * sigmoidf_(z1[i]); }
        if (!dry) st8bf(q, o0, o1); }
    __device__ __forceinline__ void operator()(int r, int c, f32x4 z) const { bf16_t* q = U + (size_t)r * LDU + 1024 + c; f32x4 o = ld4bf(q);
#pragma unroll
        for (int i = 0; i < 4; ++i) o[i] = o[i] * z[i] * sigmoidf_(z[i]);
        if (!dry) st4bf(q, o); } };
struct OpSig { bf16_t* S2; bf16_t* U;
    __device__ __forceinline__ void op8(int r, int c, f32x4 g0, f32x4 g1) const { f32x4 s0, s1;
#pragma unroll
        for (int i = 0; i < 4; ++i) { s0[i] = sigmoidf_(g0[i]); s1[i] = sigmoidf_(g1[i]); }
        bf16_t* q = (c < 2048) ? S2 + (size_t)r * 2048 + c : U + (size_t)r * LDU + C_SM + (c - 2048);
        st8bf(q, s0, s1); }
    __device__ __forceinline__ void operator()(int r, int c, f32x4 g) const { f32x4 s;
#pragma unroll
        for (int i = 0; i < 4; ++i) s[i] = sigmoidf_(g[i]);
        bf16_t* q = (c < 2048) ? S2 + (size_t)r * 2048 + c : U + (size_t)r * LDU + C_SM + (c - 2048);
        st4bf(q, s); } };
template <int B> struct OpMerge { const bf16_t* S2; bf16_t* U;
    __device__ __forceinline__ void op8(int r, int c, f32x4 v0, f32x4 v1) const {
        const bf16_t* sq = (B == 0) ? S2 + (size_t)r * 2048 + c : (B == 1) ? S2 + (size_t)r * 2048 + 1024 + c : U + (size_t)r * LDU + C_SM + c;
        f32x4 s0, s1; ld8bf(sq, s0, s1); bf16_t* q = U + (size_t)r * LDU + C_MG + c;
        f32x4 o0 = s0 * v0, o1 = s1 * v1; if (B != 0) { f32x4 m0, m1; ld8bf(q, m0, m1); o0 = o0 + m0; o1 = o1 + m1; }
        st8bf(q, o0, o1); }
    __device__ __forceinline__ void operator()(int r, int c, f32x4 v) const {
        const bf16_t* sq = (B == 0) ? S2 + (size_t)r * 2048 + c : (B == 1) ? S2 + (size_t)r * 2048 + 1024 + c : U + (size_t)r * LDU + C_SM + c;
        const f32x4 s = ld4bf(sq); bf16_t* q = U + (size_t)r * LDU + C_MG + c;
        f32x4 o = s * v; if (B != 0) o = o + ld4bf(q);
        st4bf(q, o); } };
struct OpOutF32 { float* O;
    __device__ __forceinline__ void operator()(int r, int c, f32x4 v) const { *(f32x4*)(O + (size_t)r * DM + c) = v; } };

template <class Op>
__device__ void gemm_simple(const bf16_t* A, int lda, const bf16_t* Bt, int M, int N, int K, const Op& op, int bid, int nb) {
    const int tid = threadIdx.x, lane = tid & 63, wave = tid >> 6, fr = lane & 15, fq = lane >> 4;
    const int ntn = N / 64, nitems = (M / 128) * ntn;
    for (int it = bid; it < nitems; it += nb) {
        const int tm = it / ntn, tn = it % ntn;
        const int row = tm * 128 + wave * 16 + fr;
        const bf16_t* ap = A + (size_t)row * lda + fq * 8;
        const bf16_t* bp = Bt + (size_t)(tn * 64 + fr) * K + fq * 8;
        f32x4 acc[4];
#pragma unroll
        for (int n = 0; n < 4; ++n) acc[n] = (f32x4){0.f, 0.f, 0.f, 0.f};
#pragma unroll 2
        for (int k0 = 0; k0 < K; k0 += 32) {
            const bf16x8 a = *(const bf16x8*)(ap + k0);
#pragma unroll
            for (int n = 0; n < 4; ++n) { const bf16x8 b = *(const bf16x8*)(bp + (size_t)n * 16 * K + k0); acc[n] = __builtin_amdgcn_mfma_f32_16x16x32_bf16(b, a, acc[n], 0, 0, 0); }
        }
#pragma unroll
        for (int n = 0; n < 4; ++n) op(row, tn * 64 + n * 16 + fq * 4, acc[n]);
    }
}


namespace pg8 {
#define PG8_LAS __attribute__((address_space(3)))
constexpr int BM = 256, BK = 64, HALF = 128, HTB = HALF * BK * 2  , STAGE_BYTES = 8 * HTB, NXCD = 8, WGM = 8;
__host__ __device__ __forceinline__ int lds_byte(int r, int c) { const int st = (r >> 4) * 2 + (c >> 5), rr = r & 15, cc = c & 31, ob = rr * 64 + cc * 2; return st * 1024 + (ob ^ (((ob >> 9) & 1) << 5)); }
__host__ __device__ __forceinline__ void stage_rc(int b, int& R, int& C) { const int st = b / 1024, sb = b % 1024, swz = sb ^ (((sb >> 9) & 1) << 5); R = (st >> 1) * 16 + swz / 64; C = (st & 1) * 32 + (swz % 64) / 2; }
__host__ __device__ __forceinline__ int perm32(int rho) { const int n = rho >> 4, i = rho & 15; return 8 * (i >> 2) + 4 * n + (i & 3); }
struct Unit { int pm, pn, kind; const char* a; const char* b; };
struct Job { const bf16_t* A; const bf16_t* Bt; int nM, nN; };
struct Sched {
    Job j[2]; int njobs, rep, G, c, lda; long astride, bstride;
    __device__ __forceinline__ bool next(int i, Unit& u) const {
        const int ti = i / rep, v = i - ti * rep; long L = (long)ti * G + c;
#pragma unroll
        for (int q = 0; q < 2; ++q) { if (q < njobs) { const int nwg = j[q].nM * j[q].nN;
            if (L < nwg) { int wgid = (int)L; { const int qq = nwg / NXCD, r = nwg % NXCD, xcd = wgid % NXCD, off = wgid / NXCD; wgid = (xcd < r ? xcd * (qq + 1) : r * (qq + 1) + (xcd - r) * qq) + off; }
                const int nig = WGM * j[q].nN, gid = wgid / nig, fm = gid * WGM, gsz = (j[q].nM - fm) < WGM ? (j[q].nM - fm) : WGM;
                u.pm = fm + ((wgid % nig) % gsz); u.pn = (wgid % nig) / gsz; u.kind = 4 * q + v;
                u.a = (const char*)(j[q].A + (size_t)u.pm * BM * lda + (size_t)v * astride); u.b = (const char*)(j[q].Bt + (size_t)u.pn * BM * DM + (size_t)v * bstride); return true; }
            L -= nwg; } }
        return false;
    }
};
template <class Sel> struct Epi { static constexpr bool PERM = true; Sel sel;
    __device__ __forceinline__ void operator()(const f32x4 (&acc)[2][2][4][2], const Unit& u, int wr, int wc, int fr, int fq) const {
#pragma unroll
        for (int ai = 0; ai < 2; ++ai)
#pragma unroll
            for (int m = 0; m < 4; ++m) { const int row = u.pm * BM + ai * HALF + wr * 64 + m * 16 + fr;
#pragma unroll
                for (int bj = 0; bj < 2; ++bj) { const int col = u.pn * BM + bj * HALF + wc * 32 + 8 * fq; sel(u.kind, row, col, acc[ai][bj][m][0], acc[ai][bj][m][1]); } }
    }
};
template <class EpiT, bool ALIGN_EPI>
__device__ __forceinline__ void gemm_phase(PG8_LAS unsigned char* lds, const Sched& S, const EpiT& E) {
    int tid_ = threadIdx.x; asm volatile("" : "+v"(tid_));
    const int tid = tid_, wid = __builtin_amdgcn_readfirstlane(tid >> 6), lane = tid & 63, wr = wid >> 2, wc = wid & 3, fr = lane & 15, fq = lane >> 4;
    constexpr int K = DM, nt = K / BK; const int lda = S.lda;
    unsigned voffA[2], voffB[2];
#pragma unroll
    for (int i = 0; i < 2; ++i) { int R, C; stage_rc(tid * 16 + i * 8192, R, C); const int Rb = EpiT::PERM ? ((R & ~31) + perm32(R & 31)) : R;
        voffA[i] = (unsigned)(R * lda + C) * 2u; voffB[i] = (unsigned)(Rb * K + C) * 2u; }
    const size_t kstep = (size_t)(BK * 2);
    const size_t hstepA = (size_t)HALF * lda * 2, hstepB = (size_t)HALF * K * 2;
    const unsigned ldsw = (unsigned)wid * 1024u;
    const int aoff = lds_byte(wr * 64 + fr, fq * 8), boff = lds_byte(wc * 32 + fr, fq * 8);
#define PG8_SA(b, h) (((b) * 2 + (h)) * HTB)
#define PG8_SB(b, h) ((4 + (b) * 2 + (h)) * HTB)
#define PG8_STAGE(bufoff, gbase, voff) do { _Pragma("unroll") for (int _i = 0; _i < 2; ++_i) \
        __builtin_amdgcn_global_load_lds((const unsigned*)((const char*)(gbase) + (voff)[_i]), (PG8_LAS unsigned*)(lds + (bufoff) + ldsw + _i * 8192), 16, 0, 0); } while (0)
#define PG8_LDA(dst, b, h) do { _Pragma("unroll") for (int m = 0; m < 4; ++m) _Pragma("unroll") for (int k = 0; k < 2; ++k) dst[m][k] = *(const PG8_LAS bf16x8*)(lds + PG8_SA(b, h) + aoff + m * 2048 + k * 1024); } while (0)
#define PG8_LDB(dst, b, h) do { _Pragma("unroll") for (int n = 0; n < 2; ++n) _Pragma("unroll") for (int k = 0; k < 2; ++k) dst[n][k] = *(const PG8_LAS bf16x8*)(lds + PG8_SB(b, h) + boff + n * 2048 + k * 1024); } while (0)
#define PG8_MMA(ai, bj, At, Bt) do { __builtin_amdgcn_s_setprio(1); _Pragma("unroll") for (int m = 0; m < 4; ++m) _Pragma("unroll") for (int n = 0; n < 2; ++n) _Pragma("unroll") for (int k = 0; k < 2; ++k) \
        acc[ai][bj][m][n] = __builtin_amdgcn_mfma_f32_16x16x32_bf16(Bt[n][k], At[m][k], acc[ai][bj][m][n], 0, 0, 0); __builtin_amdgcn_s_setprio(0); } while (0)
#define PG8_WAIT_V(n) asm volatile("s_waitcnt vmcnt(" #n ")" ::: "memory")
#define PG8_WAIT_L(n) asm volatile("s_waitcnt lgkmcnt(" #n ")" ::: "memory")
#define PG8_BAR __builtin_amdgcn_s_barrier()
#define PG8_SCHED __builtin_amdgcn_sched_barrier(0)
    Unit cur, nxt; int ui = 0;
    if (!S.next(0, cur)) return;
    f32x4 acc[2][2][4][2];
#pragma unroll
    for (int a = 0; a < 2; ++a)
#pragma unroll
        for (int b = 0; b < 2; ++b)
#pragma unroll
            for (int m = 0; m < 4; ++m)
#pragma unroll
                for (int n = 0; n < 2; ++n) acc[a][b][m][n] = (f32x4){0.f, 0.f, 0.f, 0.f};
    bf16x8 At[4][2], B0[2][2], B1[2][2];
    const char* cA = cur.a; const char* cB = cur.b;
    PG8_STAGE(PG8_SB(0, 0), cB, voffB); PG8_STAGE(PG8_SB(0, 1), cB + hstepB, voffB); PG8_STAGE(PG8_SA(0, 0), cA, voffA); PG8_STAGE(PG8_SA(0, 1), cA + hstepA, voffA);
    if (wr == 1) PG8_BAR;
    PG8_WAIT_V(2); PG8_BAR;
    PG8_STAGE(PG8_SB(1, 0), cB + kstep, voffB); PG8_STAGE(PG8_SA(1, 0), cA + kstep, voffA); PG8_STAGE(PG8_SB(1, 1), cB + hstepB + kstep, voffB);
    PG8_WAIT_V(6); PG8_BAR;
    for (;;) {
        const bool has_next = S.next(ui + 1, nxt);
        const char* nA = has_next ? nxt.a : cA; const char* nB = has_next ? nxt.b : cB;
        for (int t = 0; t < nt; t += 2) {
            const bool last = (t == nt - 2);
            const char* a1 = cA + (size_t)(t + 1) * kstep;
            const char* a2 = last ? nA : cA + (size_t)(t + 2) * kstep; const char* b2 = last ? nB : cB + (size_t)(t + 2) * kstep;
            const char* a3 = a2 + kstep; const char* b3 = b2 + kstep;
            PG8_LDB(B0, 0, 0); PG8_LDB(B1, 0, 1); PG8_SCHED; PG8_LDA(At, 0, 0); PG8_STAGE(PG8_SA(1, 1), a1 + hstepA, voffA);
            PG8_WAIT_V(8); PG8_WAIT_L(0); PG8_BAR; PG8_MMA(0, 0, At, B0); PG8_MMA(0, 1, At, B1); PG8_BAR; PG8_SCHED;
            PG8_LDA(At, 0, 1); PG8_STAGE(PG8_SB(0, 0), b2, voffB); PG8_STAGE(PG8_SB(0, 1), b2 + hstepB, voffB); PG8_STAGE(PG8_SA(0, 0), a2, voffA);
            PG8_WAIT_V(8); PG8_WAIT_L(0); PG8_BAR; PG8_MMA(1, 0, At, B0); PG8_MMA(1, 1, At, B1); PG8_BAR; PG8_SCHED;
            PG8_LDB(B0, 1, 0); PG8_LDB(B1, 1, 1); PG8_SCHED; PG8_LDA(At, 1, 0); PG8_STAGE(PG8_SA(0, 1), a2 + hstepA, voffA);
            PG8_WAIT_V(8); PG8_WAIT_L(0); PG8_BAR; PG8_MMA(0, 0, At, B0); PG8_MMA(0, 1, At, B1); PG8_BAR; PG8_SCHED;
            PG8_LDA(At, 1, 1); PG8_STAGE(PG8_SB(1, 0), b3, voffB); PG8_STAGE(PG8_SB(1, 1), b3 + hstepB, voffB); PG8_STAGE(PG8_SA(1, 0), a3, voffA);
            PG8_WAIT_V(8); PG8_WAIT_L(0); PG8_BAR; PG8_MMA(1, 0, At, B0); PG8_MMA(1, 1, At, B1); PG8_BAR; PG8_SCHED;
        }
        if constexpr (ALIGN_EPI) { if (wr == 0) PG8_BAR; }
        E(acc, cur, wr, wc, fr, fq);
        if (!has_next) break;
#pragma unroll
        for (int a = 0; a < 2; ++a)
#pragma unroll
            for (int b = 0; b < 2; ++b)
#pragma unroll
                for (int m = 0; m < 4; ++m)
#pragma unroll
                    for (int n = 0; n < 2; ++n) acc[a][b][m][n] = (f32x4){0.f, 0.f, 0.f, 0.f};
        cur = nxt; cA = nA; cB = nB; ++ui;
        if constexpr (ALIGN_EPI) { if (wr == 1) PG8_BAR; }
    }
    PG8_WAIT_V(0);
    if constexpr (!ALIGN_EPI) { if (wr == 0) PG8_BAR; }
    PG8_BAR;
#undef PG8_SA
#undef PG8_SB
#undef PG8_STAGE
#undef PG8_LDA
#undef PG8_LDB
#undef PG8_MMA
#undef PG8_WAIT_V
#undef PG8_WAIT_L
#undef PG8_BAR
#undef PG8_SCHED
}
}
struct SelP1 { OpStoreBf16 o1, o2; __device__ __forceinline__ void operator()(int kind, int r, int c, f32x4 v0, f32x4 v1) const { if (kind == 0) o1.op8(r, c, v0, v1); else o2.op8(r, c, v0, v1); } };
struct SelP5 { OpZGate oz; OpSig os; __device__ __forceinline__ void operator()(int kind, int r, int c, f32x4 v0, f32x4 v1) const { if (kind == 0) oz.op8(r, c, v0, v1); else os.op8(r, c, v0, v1); } };
struct SelP6 { OpMerge<0> m0; OpMerge<1> m1; OpMerge<2> m2; __device__ __forceinline__ void operator()(int kind, int r, int c, f32x4 v0, f32x4 v1) const {
    if (kind == 0) m0.op8(r, c, v0, v1); else if (kind == 1) m1.op8(r, c, v0, v1); else m2.op8(r, c, v0, v1); } };
struct SelP7 { OpStoreBf16 oo; __device__ __forceinline__ void operator()(int kind, int r, int c, f32x4 v0, f32x4 v1) const { oo.op8(r, c, v0, v1); } };

__device__ void phase_gla_rec(const Params& p, float* oraw, int bid, int nb, unsigned char* lds) {
    constexpr int CH = 32, RS = 136;
    float* As = (float*)lds; float* Ks = As + CH * RS; float* Qs = Ks + CH * RS; float* Vs = Qs + CH * RS;
    const bf16_t* U = Uptr(p);
    const int tid = threadIdx.x, cl = tid >> 3, ds = tid & 7;
    for (int it = bid; it < 64; it += nb) {
        const int b = it >> 4, h = (it >> 2) & 3, q4 = it & 3;
        float s[16];
#pragma unroll
        for (int i = 0; i < 16; ++i) s[i] = 0.f;
        for (int t0 = 0; t0 < SEQ; t0 += CH) {
            __syncthreads();
            for (int e = tid; e < CH * 128; e += NTHREADS) {
                const int i = e >> 7, d = e & 127; const size_t m = (size_t)b * SEQ + t0 + i; const bf16_t* ur = U + m * LDU;
                float x = p.b_a[h * 128 + d];
#pragma unroll
                for (int r = 0; r < 16; ++r) x += bf2f(ur[C_GA + r]) * p.w_a_up[r * 512 + h * 128 + d];
                const float ls = fminf(x, 0.f) - log1pf(__expf(-fabsf(x)));
                const int o = i * RS + (d >> 4) * 17 + (d & 15);
                As[o] = __expf(ls * (1.f / 16.f));
                Ks[o] = bf2f(ur[C_GK + h * 128 + d]);
                Qs[o] = bf2f(ur[C_GQ + h * 128 + d]) * 0.08838834764831845f;
            }
            for (int e = tid; e < CH * 64; e += NTHREADS) { const int i = e >> 6, c = e & 63; Vs[e] = bf2f(U[((size_t)b * SEQ + t0 + i) * LDU + C_GV + h * 256 + q4 * 64 + c]); }
            __syncthreads();
            for (int i = 0; i < CH; ++i) {
                const float v = Vs[i * 64 + cl]; const float* a = As + i * RS + ds * 17; const float* k = Ks + i * RS + ds * 17; const float* q = Qs + i * RS + ds * 17;
                float o = 0.f;
#pragma unroll
                for (int dd = 0; dd < 16; ++dd) { s[dd] = a[dd] * s[dd] + k[dd] * v; o += q[dd] * s[dd]; }
                o += __shfl_xor(o, 1); o += __shfl_xor(o, 2); o += __shfl_xor(o, 4);
                if (ds == 0) oraw[((size_t)b * SEQ + t0 + i) * DM + h * 256 + q4 * 64 + cl] = o;
            }
        }
    }
}
__device__ void phase_gla_norm(const Params& p, const float* oraw, int bid, int nb) {
    bf16_t* U = Uptr(p);
    const int lane = threadIdx.x & 63, wave = threadIdx.x >> 6;
    for (int it = bid * NWAVES + wave; it < MTOK * 4; it += nb * NWAVES) {
        const int m = it >> 2, h = it & 3;
        const f32x4 v = *(const f32x4*)(oraw + (size_t)m * DM + h * 256 + lane * 4);
        const float ss = wave_sum((v[0] * v[0] + v[1] * v[1]) + (v[2] * v[2] + v[3] * v[3]));
        const float rstd = 1.f / sqrtf(ss * (1.f / 256.f) + EPS);
        const f32x4 g = *(const f32x4*)(p.g_gla + lane * 4);
        st4bf(U + (size_t)m * LDU + C_GV + h * 256 + lane * 4, v * g * rstd);
    }
}

__device__ __forceinline__ unsigned fkey(float f) { const unsigned u = __float_as_uint(f); return (u & 0x80000000u) ? ~u : (u | 0x80000000u); }
__device__ void phase_dsa_ref(const Params& p, int bid, int nb, unsigned char* lds) {
    float* sc = (float*)lds;
    float* iqs = sc + 4096;
    float* qs = iqs + 512;
    float* lg = qs + 1024;
    int* sel = (int*)(lg + 2048);
    unsigned* hist = (unsigned*)(sel + 256);
    unsigned* cnt = hist + 256;
    int* misc = (int*)(cnt + 512);
    float* ws8 = (float*)(misc + 8);
    bf16_t* U = Uptr(p);
    const int tid = threadIdx.x, lane = tid & 63, wave = tid >> 6;
    for (int it = bid; it < MTOK; it += nb) {
        const int b = it / SEQ, t = it % SEQ; const size_t m = (size_t)it; const bf16_t* ur = U + m * LDU; const bf16_t* ub = U + (size_t)b * SEQ * LDU;
        __syncthreads();
        iqs[tid] = bf2f(ur[C_IQ + tid]);
        qs[tid] = bf2f(ur[C_DQ + tid]) * 0.08838834764831845f; qs[tid + 512] = bf2f(ur[C_DQ + 512 + tid]) * 0.08838834764831845f;
        if (tid < 8) ws8[tid] = bf2f(ur[C_IW + tid]);
        if (tid == 0) misc[0] = 0;
        __syncthreads();
        const int n = t + 1, ksel = n < 256 ? n : 256;
#pragma unroll 1
        for (int j = 0; j < 8; ++j) {
            const int s = tid * 8 + j;
            if (s < n) {
                const bf16_t* kr = ub + (size_t)s * LDU + C_IK;
                float acc[8];
#pragma unroll
                for (int h = 0; h < 8; ++h) acc[h] = 0.f;
#pragma unroll 1
                for (int d0 = 0; d0 < 64; d0 += 8) {
                    const bf16x8 kv = *(const bf16x8*)(kr + d0);
#pragma unroll
                    for (int dd = 0; dd < 8; ++dd) { const float kd = bf2f((bf16_t)kv[dd]);
#pragma unroll
                        for (int h = 0; h < 8; ++h) acc[h] += iqs[h * 64 + d0 + dd] * kd; }
                }
                float score = 0.f;
#pragma unroll
                for (int h = 0; h < 8; ++h) score += ws8[h] * fmaxf(acc[h], 0.f);
                sc[s] = score;
            }
        }
        __syncthreads();
        if (n <= 256) { if (tid < n) sel[tid] = tid; }
        else {
            unsigned prefix = 0u, mask = 0u; int need = ksel;
            for (int pass = 3; pass >= 0; --pass) {
                const int shift = 8 * pass;
                if (tid < 256) hist[tid] = 0u;
                __syncthreads();
#pragma unroll 1
                for (int j = 0; j < 8; ++j) { const int s = tid * 8 + j; if (s < n) { const unsigned u = fkey(sc[s]); if ((u & mask) == prefix) atomicAdd(&hist[(u >> shift) & 255u], 1u); } }
                __syncthreads();
                if (tid == 0) { int cum = 0, d = 255; for (; d > 0; --d) { const int c = (int)hist[d]; if (cum + c >= need) break; cum += c; } misc[1] = d; misc[2] = need - cum; }
                __syncthreads();
                prefix |= (unsigned)misc[1] << shift; mask |= 0xFFu << shift; need = misc[2];
                __syncthreads();
            }
            unsigned myeq = 0u;
#pragma unroll 1
            for (int j = 0; j < 8; ++j) { const int s = tid * 8 + j; if (s < n && fkey(sc[s]) == prefix) ++myeq; }
            cnt[tid] = myeq;
            __syncthreads();
            int rank = 0; for (int i = 0; i < tid; ++i) rank += (int)cnt[i];
#pragma unroll 1
            for (int j = 0; j < 8; ++j) { const int s = tid * 8 + j; if (s < n) { const unsigned u = fkey(sc[s]);
                bool take = u > prefix; if (u == prefix) { take = rank < need; ++rank; }
                if (take) { const int pos = atomicAdd(&misc[0], 1); if (pos < 256) sel[pos] = s; } } }
        }
        __syncthreads();
        { const int j = tid & 255, c = tid >> 8;
          float l4[4];
          if (j < ksel) { const int s = sel[j]; const bf16_t* kr = ub + (size_t)s * LDU + C_DK + c * 128;
              float a0 = 0.f, a1 = 0.f, a2 = 0.f, a3 = 0.f;
#pragma unroll 1
              for (int d0 = 0; d0 < 128; d0 += 8) { const bf16x8 kv = *(const bf16x8*)(kr + d0);
#pragma unroll
                  for (int dd = 0; dd < 8; ++dd) { const float kd = bf2f((bf16_t)kv[dd]); const float* qq = qs + c * 512 + d0 + dd; a0 += qq[0] * kd; a1 += qq[128] * kd; a2 += qq[256] * kd; a3 += qq[384] * kd; } }
              int dist = t - s; if (dist < 0) dist = 0; const int bk = dist < 128 ? (int)T5B[dist] : 31; const float* rb = p.rel_bias + bk * 8 + c * 4;
              l4[0] = a0 + rb[0]; l4[1] = a1 + rb[1]; l4[2] = a2 + rb[2]; l4[3] = a3 + rb[3];
          } else { l4[0] = l4[1] = l4[2] = l4[3] = -1e30f; }
#pragma unroll
          for (int g = 0; g < 4; ++g) lg[(c * 4 + g) * 256 + j] = l4[g]; }
        __syncthreads();
        { float v[4]; float mx = -3e38f;
#pragma unroll
          for (int i = 0; i < 4; ++i) { v[i] = lg[wave * 256 + lane + 64 * i]; mx = fmaxf(mx, v[i]); }
          mx = wave_max(mx); float sm = 0.f;
#pragma unroll
          for (int i = 0; i < 4; ++i) { v[i] = __expf(v[i] - mx); sm += v[i]; }
          sm = wave_sum(sm); const float inv = 1.f / sm;
#pragma unroll
          for (int i = 0; i < 4; ++i) lg[wave * 256 + lane + 64 * i] = v[i] * inv; }
        __syncthreads();
        { const int h = wave, c = h >> 2; float o0 = 0.f, o1 = 0.f;
#pragma unroll 4
          for (int j = 0; j < ksel; ++j) { const float pj = lg[h * 256 + j]; const unsigned w = *(const unsigned*)(ub + (size_t)sel[j] * LDU + C_DV + c * 128 + lane * 2);
              o0 += pj * __uint_as_float(w << 16); o1 += pj * __uint_as_float(w & 0xffff0000u); }
          *(unsigned*)(U + m * LDU + C_DQ + h * 128 + lane * 2) = pk2(o0, o1); }
    }
}


typedef float f32x16 __attribute__((ext_vector_type(16)));
typedef short s16x4 __attribute__((ext_vector_type(4)));
#define LAS __attribute__((address_space(3)))
#define MFMA32(a, b, c) __builtin_amdgcn_mfma_f32_32x32x16_bf16((a), (b), (c), 0, 0, 0)
__device__ __forceinline__ int crow(int r, int h) { return (r & 3) + 8 * (r >> 2) + 4 * h; }
constexpr int TRI = 8256;
__device__ __forceinline__ size_t mask_index(int b, int j, int kt, int lane) { return ((size_t)(b * TRI + j * (j + 1) / 2 + kt)) * 64 + lane; }

__device__ __forceinline__ void idx_tile(f32x16& sc, const bf16x8 (&aik)[4], LAS const bf16x8* biq  , const float (&wq)[8]) {
#pragma unroll
    for (int r = 0; r < 16; ++r) sc[r] = 0.f;
#pragma unroll
    for (int h = 0; h < 8; ++h) {
        f32x16 d;
#pragma unroll
        for (int r = 0; r < 16; ++r) d[r] = 0.f;
#pragma unroll
        for (int kk = 0; kk < 4; ++kk) d = MFMA32(aik[kk], biq[(h * 4 + kk) * 64], d);
#pragma unroll
        for (int r = 0; r < 16; ++r) sc[r] = __builtin_fmaf(wq[h], __builtin_fmaxf(d[r], 0.f), sc[r]);
    }
}

__device__ __forceinline__ void dsa_select_item(const Params& p, int idx, unsigned char* lds) {
    unsigned* hist = (unsigned*)lds;
    unsigned* qpref = hist + 32 * 256;
    int* qneed = (int*)(qpref + 32);
    int* qcut = qneed + 32;
    int* qflag = qcut + 32;
    int* anyflag = qflag + 32;
    unsigned* tb = (unsigned*)(anyflag + 8);
    LAS bf16x8* iqf = (LAS bf16x8*)((LAS unsigned char*)lds + 65536);
    const bf16_t* U = Uptr(p); unsigned short* maskbuf = (unsigned short*)(p.ws + WS_MASK);
    const int tid = opaque_tid(), lane = tid & 63, wave = __builtin_amdgcn_readfirstlane(tid >> 6), q = lane & 31, half = lane >> 5;
    const int b = idx & 3, j = idx >> 2, t0 = 32 * j; const size_t mb = (size_t)b * SEQ;
    __syncthreads();
    for (int e = tid; e < 32 * 256; e += NTHREADS) hist[e] = 0u;
    if (tid < 32) { qpref[tid] = 0u; qneed[tid] = 256; qcut[tid] = 0x7fffffff; qflag[tid] = 0; }
    if (tid < 8) anyflag[tid] = 0;
    float wq[8];
    { const bf16_t* ur = U + (mb + t0 + q) * LDU;
#pragma unroll
      for (int i = 0; i < 4; ++i) { const int f = wave + 8 * i; iqf[f * 64 + lane] = *(const bf16x8*)(ur + C_IQ + f * 16 + 8 * half); }
#pragma unroll
      for (int h = 0; h < 8; ++h) wq[h] = bf2f(ur[C_IW + h]); }
    LAS const bf16x8* biq = iqf + lane;
    __syncthreads();
#pragma unroll 1
    for (int ps = 0; ps < 6; ++ps) {
        if (ps == 4) { if (anyflag[0] == 0) continue; }
        const unsigned myT = qpref[q]; const int mycut = qcut[q];
        const int shift = 24 - 8 * ps; const unsigned mhi = (ps == 0 || ps > 3) ? 0u : (0xFFFFFFFFu << (32 - 8 * ps));
#pragma unroll 1
        for (int kt = wave; kt <= j; kt += NWAVES) {
            bf16x8 aik[4];
            { const bf16_t* kr = U + (mb + 32 * kt + q) * LDU + C_IK + 8 * half;
#pragma unroll
              for (int kk = 0; kk < 4; ++kk) aik[kk] = *(const bf16x8*)(kr + kk * 16); }
            f32x16 sc; idx_tile(sc, aik, biq, wq);
            unsigned word = 0u;
#pragma unroll
            for (int r = 0; r < 16; ++r) {
                const int kin = crow(r, half); const bool valid = (kt < j) || (kin <= q);
                const unsigned key = fkey(sc[r]);
                if (ps < 4) { if (valid && (key & mhi) == myT) atomicAdd(&hist[q * 256 + ((key >> shift) & 255u)], 1u); }
                else if (ps == 4) { if (valid && key == myT) word |= 1u << kin; }
                else { const bool sel = valid && (key > myT || (key == myT && (32 * kt + kin) <= mycut)); word |= sel ? (1u << r) : 0u; }
            }
            if (ps == 4) { if (word) atomicOr(&tb[kt * 32 + q], word); }
            if (ps == 5) maskbuf[mask_index(b, j, kt, lane)] = (unsigned short)word;
        }
        __syncthreads();
        if (ps < 4) {
            for (int qi = 0; qi < 4; ++qi) {
                const int qq = 4 * wave + qi; const int need = qneed[qq];
                u32x4 c = *(u32x4*)&hist[qq * 256 + 4 * lane];
                const int tot = (int)(c.x + c.y + c.z + c.w);
                int suf = tot;
#pragma unroll
                for (int o = 1; o < 64; o <<= 1) { const int tv = __shfl_down(suf, o); if (lane + o < 64) suf += tv; }
                const int above = suf - tot;
                if (above < need && need <= suf) {
                    int cum = above, digit, eq;
                    if (cum + (int)c.w >= need) { digit = 3; eq = (int)c.w; }
                    else { cum += (int)c.w; if (cum + (int)c.z >= need) { digit = 2; eq = (int)c.z; }
                        else { cum += (int)c.z; if (cum + (int)c.y >= need) { digit = 1; eq = (int)c.y; } else { cum += (int)c.y; digit = 0; eq = (int)c.x; } } }
                    qpref[qq] |= (unsigned)(4 * lane + digit) << shift; qneed[qq] = need - cum;
                    if (ps == 3 && eq > need - cum) { qflag[qq] = 1; anyflag[0] = 1; }
                }
                *(u32x4*)&hist[qq * 256 + 4 * lane] = (u32x4){0u, 0u, 0u, 0u};
            }
            if (ps == 3) { for (int e = tid; e < (j + 1) * 32; e += NTHREADS) tb[e] = 0u; }
        }
        if (ps == 4) {
            if (tid < 32 && qflag[tid]) { const int need = qneed[tid]; int cnt = 0, cut = 0x7fffffff;
                for (int kt = 0; kt <= j; ++kt) { unsigned w = tb[kt * 32 + tid]; const int pc = __popc(w);
                    if (cnt + pc >= need) { int left = need - cnt, pos = 0; for (;;) { pos = __ffs(w) - 1; if (--left == 0) break; w &= w - 1; } cut = 32 * kt + pos; break; }
                    cnt += pc; }
                qcut[tid] = cut; }
        }
        __syncthreads();
    }
}
__device__ void phase_dsa_select(const Params& p, int bid, int nb, unsigned char* lds) {
    for (int k2 = 2 * bid; k2 < 512; k2 += (k2 & 1) ? 2 * nb - 1 : 1) { const int k = k2 >> 1; dsa_select_item(p, (k2 & 1) ? 511 - k : k, lds); }
}


typedef float f32x4_ __attribute__((ext_vector_type(4)));
#define MFMA16(a, b, c) __builtin_amdgcn_mfma_f32_16x16x32_bf16((a), (b), (c), 0, 0, 0)
constexpr int S2_PITCH = 8192 + 16;
constexpr int S2_KEYS = 0, S2_HIST = 16 * S2_PITCH, S2_MISC = S2_HIST + 16 * 128 * 4;
__device__ __forceinline__ unsigned key16x2(float a, float b) {
    const unsigned x = __builtin_bit_cast(unsigned, __builtin_amdgcn_cvt_pkrtz(a, b));
    const unsigned neg = (x >> 15) & 0x00010001u;
    return x ^ ((neg * 0xFFFFu) | 0x80008000u);
}
__device__ __forceinline__ float relu_(float x) { return __builtin_amdgcn_fmed3f(x, 0.f, __builtin_inff()); }
__device__ __forceinline__ void dsa_select16_item(const Params& p, int idx, int a, unsigned char* lds_) {
    LAS char* lds = (LAS char*)lds_;
    LAS unsigned* hist = (LAS unsigned*)(lds + S2_HIST);
    LAS unsigned* qT = (LAS unsigned*)(lds + S2_MISC);
    LAS int* qneed = (LAS int*)(qT + 16);
    LAS int* qcut = qneed + 16;
    LAS int* qflag = qcut + 16;
    const bf16_t* U = Uptr(p); unsigned short* maskbuf = (unsigned short*)(p.ws + WS_MASK);
    const int tid = opaque_tid(), lane = tid & 63, wave = __builtin_amdgcn_readfirstlane(tid >> 6), qn = lane & 15, quad = lane >> 4;
    const int b = idx & 3, j = idx >> 2, t0 = 32 * j + 16 * a; const size_t mb = (size_t)b * SEQ;
    const int ntile16 = 2 * j + a + 1;
    __syncthreads();
    for (int e = tid; e < 16 * 128; e += NTHREADS) hist[e] = 0u;
    if (tid < 16) { qT[tid] = 0u; qneed[tid] = 256; qcut[tid] = 0x7fffffff; qflag[tid] = 0; }
    __syncthreads();
    {
        bf16x8 biq[8][2]; float wq[8];
        const bf16_t* ur = U + (mb + t0 + qn) * LDU;
#pragma unroll
        for (int h = 0; h < 8; ++h) { biq[h][0] = *(const bf16x8*)(ur + C_IQ + h * 64 + 8 * quad); biq[h][1] = *(const bf16x8*)(ur + C_IQ + h * 64 + 32 + 8 * quad); wq[h] = bf2f(ur[C_IW + h]); }
        const bf16_t* kb = U + (mb + qn) * LDU + C_IK + 8 * quad; const int nq_ = t0 + qn + 1;
        bf16x8 a00, a01, a10, a11;
        { const bool two = wave + NWAVES < ntile16; const bf16_t* k0 = kb + (size_t)16 * wave * LDU; const bf16_t* k1 = kb + (size_t)16 * (two ? wave + NWAVES : wave) * LDU;
          if (wave < ntile16) { a00 = *(const bf16x8*)k0; a01 = *(const bf16x8*)(k0 + 32); a10 = *(const bf16x8*)k1; a11 = *(const bf16x8*)(k1 + 32); } }
#pragma unroll 1
        for (int tile = wave; tile < ntile16; tile += 2 * NWAVES) {
            const bool two = tile + NWAVES < ntile16;
            const int nt = tile + 2 * NWAVES; const bool hn = nt < ntile16, hn2 = nt + NWAVES < ntile16;
            bf16x8 n00 = a00, n01 = a01, n10 = a10, n11 = a11;
            if (hn) { const bf16_t* k0 = kb + (size_t)16 * nt * LDU; const bf16_t* k1 = kb + (size_t)16 * (hn2 ? nt + NWAVES : nt) * LDU;
                n00 = *(const bf16x8*)k0; n01 = *(const bf16x8*)(k0 + 32); n10 = *(const bf16x8*)k1; n11 = *(const bf16x8*)(k1 + 32); }
            f32x4_ s0 = (f32x4_){0.f, 0.f, 0.f, 0.f}, s1 = s0;
#pragma unroll
            for (int h = 0; h < 8; ++h) {
                f32x4_ d0 = (f32x4_){0.f, 0.f, 0.f, 0.f}, d1 = d0;
                d0 = MFMA16(a00, biq[h][0], d0); d1 = MFMA16(a10, biq[h][0], d1);
                d0 = MFMA16(a01, biq[h][1], d0); d1 = MFMA16(a11, biq[h][1], d1);
#pragma unroll
                for (int r = 0; r < 4; ++r) { s0[r] = __builtin_fmaf(wq[h], relu_(d0[r]), s0[r]); s1[r] = __builtin_fmaf(wq[h], relu_(d1[r]), s1[r]); }
            }
            u32x2 w0; w0.x = key16x2(s0[0], s0[1]); w0.y = key16x2(s0[2], s0[3]);
            *(LAS u32x2*)(lds + S2_KEYS + qn * S2_PITCH + (16 * tile + 4 * quad) * 2) = w0;
            { const int k0i = 16 * tile + 4 * quad;
#pragma unroll
              for (int r = 0; r < 4; ++r) { const unsigned key = ((r & 2) ? w0.y : w0.x) >> (16 * (r & 1)) & 0xffffu; const unsigned bin = key >> 8;
                  if (k0i + r < nq_) __hip_atomic_fetch_add(hist + qn * 128 + (bin >> 1), 1u << (16 * (bin & 1u)), __ATOMIC_RELAXED, __HIP_MEMORY_SCOPE_WORKGROUP); } }
            if (two) { u32x2 w1; w1.x = key16x2(s1[0], s1[1]); w1.y = key16x2(s1[2], s1[3]);
                *(LAS u32x2*)(lds + S2_KEYS + qn * S2_PITCH + (16 * (tile + NWAVES) + 4 * quad) * 2) = w1;
                const int k1i = 16 * (tile + NWAVES) + 4 * quad;
#pragma unroll
                for (int r = 0; r < 4; ++r) { const unsigned key = ((r & 2) ? w1.y : w1.x) >> (16 * (r & 1)) & 0xffffu; const unsigned bin = key >> 8;
                    if (k1i + r < nq_) __hip_atomic_fetch_add(hist + qn * 128 + (bin >> 1), 1u << (16 * (bin & 1u)), __ATOMIC_RELAXED, __HIP_MEMORY_SCOPE_WORKGROUP); } }
            a00 = n00; a01 = n01; a10 = n10; a11 = n11;
        }
    }
    __syncthreads();
    const int rq = tid & 15, part = tid >> 4, nq = t0 + rq + 1;
#pragma unroll 1
    for (int ps = 0; ps < 2; ++ps) {
        const unsigned hiT = qT[rq] >> 8;
        LAS const char* krow = lds + S2_KEYS + rq * S2_PITCH;
        if (ps == 1) for (int base = part * 8; base < nq; base += 256) {
            const u32x4 kv = *(LAS const u32x4*)(krow + base * 2);
#pragma unroll
            for (int e = 0; e < 8; ++e) { const unsigned w = e < 2 ? kv.x : e < 4 ? kv.y : e < 6 ? kv.z : kv.w; const unsigned key = (e & 1) ? (w >> 16) : (w & 0xffffu);
                const bool ok = (base + e < nq) && (key >> 8) == hiT;
                const unsigned bin = key & 255u;
                if (ok) __hip_atomic_fetch_add(hist + rq * 128 + (bin >> 1), 1u << (16 * (bin & 1u)), __ATOMIC_RELAXED, __HIP_MEMORY_SCOPE_WORKGROUP); }
        }
        __syncthreads();
#pragma unroll
        for (int qi = 0; qi < 2; ++qi) {
            const int qq = 2 * wave + qi; const int need = qneed[qq];
            const u32x2 hw = *(LAS u32x2*)(hist + qq * 128 + 2 * lane);
            const int c0 = (int)(hw.x & 0xffffu), c1 = (int)(hw.x >> 16), c2 = (int)(hw.y & 0xffffu), c3 = (int)(hw.y >> 16);
            const int tot = c0 + c1 + c2 + c3;
            int suf = tot;
#pragma unroll
            for (int o = 1; o < 64; o <<= 1) { const int tv = __shfl_down(suf, o); if (lane + o < 64) suf += tv; }
            const int above = suf - tot;
            if (above < need && need <= suf) {
                int cum = above, digit, eq;
                if (cum + c3 >= need) { digit = 3; eq = c3; }
                else { cum += c3; if (cum + c2 >= need) { digit = 2; eq = c2; }
                    else { cum += c2; if (cum + c1 >= need) { digit = 1; eq = c1; } else { cum += c1; digit = 0; eq = c0; } } }
                qT[qq] |= (unsigned)(4 * lane + digit) << (ps == 0 ? 8 : 0); qneed[qq] = need - cum;
                if (ps == 1 && eq > need - cum) qflag[qq] = 1;
            }
            *(LAS u32x2*)(hist + qq * 128 + 2 * lane) = (u32x2){0u, 0u};
        }
        __syncthreads();
    }
#pragma unroll 1
    for (int qi = 0; qi < 2; ++qi) {
        const int qq = 2 * wave + qi;
        if (qflag[qq]) { const int nqq = t0 + qq + 1, need = qneed[qq]; const unsigned T = qT[qq]; int acc = 0, cut = 0x7fffffff;
            for (int base = 0; base < nqq; base += 64) { const int s = base + lane;
                const unsigned key = *(LAS const unsigned short*)(lds + S2_KEYS + qq * S2_PITCH + s * 2);
                unsigned long long em = __ballot(s < nqq && key == T); const int pc = __popcll(em);
                if (acc + pc >= need) { int left = need - acc; while (--left > 0) em &= em - 1; cut = base + (int)__ffsll((long long)em) - 1; break; }
                acc += pc; }
            if (lane == 0) qcut[qq] = cut; }
    }
    __syncthreads();
    for (int pi = tid; pi < 16 * (j + 1); pi += NTHREADS) {
        const int eq_ = pi & 15, kt = pi >> 4; const int nqq = t0 + eq_ + 1, cut = qcut[eq_]; const unsigned T = (nqq <= 256) ? 0u : qT[eq_];
        LAS const char* kp = lds + S2_KEYS + eq_ * S2_PITCH + kt * 64;
        unsigned ge = 0u, eqm = 0u;
#pragma unroll
        for (int v4 = 0; v4 < 4; ++v4) { const u32x4 kv = *(LAS const u32x4*)(kp + v4 * 16);
#pragma unroll
            for (int e = 0; e < 8; ++e) { const unsigned w = e < 2 ? kv.x : e < 4 ? kv.y : e < 6 ? kv.z : kv.w; const unsigned key = (e & 1) ? (w >> 16) : (w & 0xffffu);
                ge |= (unsigned)(key >= T) << (8 * v4 + e); eqm |= (unsigned)(key == T) << (8 * v4 + e); } }
        const int nv = nqq - 32 * kt; const unsigned vmask = nv >= 32 ? 0xffffffffu : (nv <= 0 ? 0u : ((1u << nv) - 1u));
        const int nc = cut - 32 * kt; const unsigned cmask = nc >= 31 ? 0xffffffffu : (nc < 0 ? 0u : ((2u << nc) - 1u));
        const unsigned w32 = vmask & ge & (~eqm | cmask);
#pragma unroll
        for (int hf = 0; hf < 2; ++hf) { const unsigned x = w32 >> (4 * hf); const unsigned wd = (x & 0xFu) | ((x >> 4) & 0xF0u) | ((x >> 8) & 0xF00u) | ((x >> 12) & 0xF000u);
            maskbuf[mask_index(b, j, kt, 16 * a + eq_ + 32 * hf)] = (unsigned short)wd; }
    }
}
__device__ void phase_dsa_select2(const Params& p, int bid, int nb, unsigned char* lds) {
    for (int k4 = 4 * bid; k4 < 1024; k4 += ((k4 & 3) == 3) ? 4 * nb - 3 : 1) { const int k = k4 >> 2, r = k4 & 3; dsa_select16_item(p, (r & 2) ? (((127 - (k >> 2)) << 2) | (k & 3)) : k, r & 1, lds); }
}

constexpr int DA_K = 0, DA_V = 32768, DA_BUF = 65536  , DA_TB = 131072, DA_WS = DA_TB + 8 * 132 * 4, DA_END = DA_WS + 8 * 64 * 4;
__device__ __forceinline__ s16x4 ds_tr(LAS const char* pp) { typedef short v4i16_t __attribute__((ext_vector_type(4))); return __builtin_bit_cast(s16x4, __builtin_amdgcn_ds_read_tr16_b64_v4i16((LAS v4i16_t*)pp)); }
template <int MODE>
__device__ __forceinline__ void attend_item(const Params& p, int idx, unsigned char* lds_, bool dry) {
    LAS char* lds = (LAS char*)lds_;
    bf16_t* U = Uptr(p); const unsigned short* maskbuf = (const unsigned short*)(p.ws + WS_MASK);
    const int tid = opaque_tid(), lane = tid & 63, wv = __builtin_amdgcn_readfirstlane(tid >> 6), q = lane & 31, half = lane >> 5;
    constexpr int NKK = MODE == 0 ? 8 : 16;
    const int h = MODE == 0 ? wv : (idx & 3); const int c = wv >> 2;
    const int b = MODE == 0 ? (idx & 3) : ((idx >> 2) >> 5); const int j = idx >> 2;
    const size_t mb = (size_t)b * SEQ;
    const size_t mq = MODE == 0 ? mb + 32 * j : (size_t)128 * j + 32 * (wv & 3);
    const int t0 = 32 * j;
    LAS const float* tbh = (LAS const float*)(lds + DA_TB) + h * 132; LAS float* wsc = (LAS float*)(lds + DA_WS) + wv * 64;
    constexpr float C1 = (MODE == 0 ? 0.08838834764831845f : 0.0625f) * 1.4426950408889634f;
    const float b31 = MODE == 0 ? tbh[128] : 0.f, bmaxh = MODE == 0 ? tbh[129] : 0.f;
    const int nsteps = MODE == 0 ? (j >> 1) + 1 : 4;
    const int srow = 2 * wv + half, spc = lane & 31;
    const bf16_t* gk; const bf16_t* gv; size_t gpitch;
    if (MODE == 0) { gk = U + (mb + srow) * LDU + C_DK + ((spc ^ (srow & 15)) << 3); gv = U + (mb + srow) * LDU + C_DV + ((spc ^ ((srow & 3) << 2)) << 3); gpitch = LDU; }
    else { const bf16_t* MKV = (const bf16_t*)(p.ws + WS_MKV) + ((size_t)b * NMEM + srow) * 2048 + h * 256; gk = MKV + ((spc ^ (srow & 15)) << 3); gv = MKV + 1024 + ((spc ^ ((srow & 3) << 2)) << 3); gpitch = 2048; }
#define DA_STAGE(st_, bufoff_) do { const size_t go_ = (size_t)(64 * (st_)) * gpitch; _Pragma("unroll") for (int i_ = 0; i_ < 4; ++i_) { \
        __builtin_amdgcn_global_load_lds((const unsigned*)(gk + go_ + (size_t)16 * i_ * gpitch), (LAS unsigned*)(lds + (bufoff_) + DA_K + (wv + 8 * i_) * 1024), 16, 0, 0); \
        __builtin_amdgcn_global_load_lds((const unsigned*)(gv + go_ + (size_t)16 * i_ * gpitch), (LAS unsigned*)(lds + (bufoff_) + DA_V + (wv + 8 * i_) * 1024), 16, 0, 0); } } while (0)
    __syncthreads();
    DA_STAGE(0, 0);
    bf16x8 qf[NKK];
    { const bf16_t* ur = U + (mq + q) * LDU + (MODE == 0 ? C_DQ + h * 128 : C_XQ + h * 256) + 8 * half;
#pragma unroll
      for (int kk = 0; kk < NKK; ++kk) qf[kk] = *(const bf16x8*)(ur + kk * 16); }
    f32x16 o[4];
#pragma unroll
    for (int dt = 0; dt < 4; ++dt)
#pragma unroll
        for (int r = 0; r < 16; ++r) o[dt][r] = 0.f;
    float m = -1e20f, l = 0.f;
    unsigned kA0, vA0;
    { const int q4 = (lane & 15) >> 2, p4 = lane & 3, g1 = (lane >> 4) & 1;
      kA0 = DA_K + q * 512 + ((((MODE == 0 ? c * 16 : 0) + half) ^ (q & 15)) << 4);
      vA0 = DA_V + (4 * half + q4) * 512 + (((c * 16 + 2 * g1 + (p4 >> 1)) ^ (q4 << 2)) << 4) + (p4 & 1) * 8; }
    unsigned mw0 = 0xffffu, mw1 = 0xffffu;
    if (MODE == 0) { mw0 = maskbuf[mask_index(b, j, 0, lane)]; mw1 = (1 <= j) ? maskbuf[mask_index(b, j, 1, lane)] : 0u; }
#pragma unroll 1
    for (int st = 0; st < nsteps; ++st) {
        const int kbase = 64 * st;
        asm volatile("s_waitcnt vmcnt(0)" ::: "memory");
        __syncthreads();
        const unsigned cw0 = mw0, cw1 = mw1;
        if (st + 1 < nsteps) { DA_STAGE(st + 1, ((st + 1) & 1) * DA_BUF);
            if (MODE == 0) { const int kt = 2 * st + 2; mw0 = maskbuf[mask_index(b, j, kt, lane)]; mw1 = (kt + 1 <= j) ? maskbuf[mask_index(b, j, kt + 1, lane)] : 0u; } }
        f32x16 s0, s1;
#pragma unroll
        for (int r = 0; r < 16; ++r) { s0[r] = 0.f; s1[r] = 0.f; }
#pragma unroll
        for (int kk = 0; kk < NKK; ++kk) {
            const bf16x8 a0 = *(LAS const bf16x8*)(lds + (kA0 ^ (unsigned)(kk << 5)));
            const bf16x8 a1 = *(LAS const bf16x8*)(lds + (kA0 ^ (unsigned)(kk << 5)) + 32 * 512);
            s0 = MFMA32(a0, qf[kk], s0); s1 = MFMA32(a1, qf[kk], s1); }
        const bool far_ = MODE == 0 && (t0 - (kbase + 63)) >= 128;
        float sm = fmaxf(s0[0], s1[0]);
#pragma unroll
        for (int r = 1; r < 16; ++r) sm = fmaxf(sm, fmaxf(s0[r], s1[r]));
        sm = fmaxf(sm, __shfl_xor(sm, 32));
        const float mc = __builtin_fmaf(sm, C1, MODE == 0 ? (far_ ? b31 : bmaxh) : 0.f);
        if (__any(mc > m + 8.f)) {
            const float mnew = fmaxf(m, mc);
            const float alpha = __builtin_amdgcn_exp2f(m - mnew); l *= alpha;
            if (half == 0) wsc[q] = alpha;
            asm volatile("s_waitcnt lgkmcnt(0)" ::: "memory");
#pragma unroll
            for (int r = 0; r < 16; ++r) { const float a = wsc[crow(r, half)];
#pragma unroll
                for (int dt = 0; dt < 4; ++dt) o[dt][r] *= a; }
            m = mnew;
        }
        float ls = 0.f;
        if (MODE == 1) {
            const float nm = -m;
#pragma unroll
            for (int r = 0; r < 16; ++r) { s0[r] = __builtin_amdgcn_exp2f(__builtin_fmaf(s0[r], C1, nm)); s1[r] = __builtin_amdgcn_exp2f(__builtin_fmaf(s1[r], C1, nm)); ls += s0[r] + s1[r]; }
        } else if (far_) {
            const int bm = __float_as_int(b31 - m), NEGI = __float_as_int(-1e30f);
#pragma unroll
            for (int r = 0; r < 16; ++r) {
                const int k0 = __builtin_amdgcn_sbfe((int)cw0, r, 1), k1 = __builtin_amdgcn_sbfe((int)cw1, r, 1);
                const float a0 = __int_as_float((k0 & bm) | (~k0 & NEGI)), a1 = __int_as_float((k1 & bm) | (~k1 & NEGI));
                s0[r] = __builtin_amdgcn_exp2f(__builtin_fmaf(s0[r], C1, a0)); s1[r] = __builtin_amdgcn_exp2f(__builtin_fmaf(s1[r], C1, a1)); ls += s0[r] + s1[r]; }
        } else {
            const int NEGI = __float_as_int(-1e30f);
#pragma unroll
            for (int r = 0; r < 16; ++r) {
                int d0 = t0 + q - (kbase + crow(r, half)); int d1 = d0 - 32; d0 = d0 < 0 ? 0 : (d0 > 128 ? 128 : d0); d1 = d1 < 0 ? 0 : (d1 > 128 ? 128 : d1);
                const int b0 = __float_as_int(tbh[d0] - m), b1 = __float_as_int(tbh[d1] - m);
                const int k0 = __builtin_amdgcn_sbfe((int)cw0, r, 1), k1 = __builtin_amdgcn_sbfe((int)cw1, r, 1);
                const float a0 = __int_as_float((k0 & b0) | (~k0 & NEGI)), a1 = __int_as_float((k1 & b1) | (~k1 & NEGI));
                s0[r] = __builtin_amdgcn_exp2f(__builtin_fmaf(s0[r], C1, a0)); s1[r] = __builtin_amdgcn_exp2f(__builtin_fmaf(s1[r], C1, a1)); ls += s0[r] + s1[r]; }
        }
        l += ls;
#pragma unroll
        for (int u = 0; u < 2; ++u) {
#pragma unroll
            for (int ss = 0; ss < 2; ++ss) {
                u32x4 pw;
                if (u == 0) { pw.x = pk2(s0[8 * ss], s0[8 * ss + 1]); pw.y = pk2(s0[8 * ss + 2], s0[8 * ss + 3]); pw.z = pk2(s0[8 * ss + 4], s0[8 * ss + 5]); pw.w = pk2(s0[8 * ss + 6], s0[8 * ss + 7]); }
                else { pw.x = pk2(s1[8 * ss], s1[8 * ss + 1]); pw.y = pk2(s1[8 * ss + 2], s1[8 * ss + 3]); pw.z = pk2(s1[8 * ss + 4], s1[8 * ss + 5]); pw.w = pk2(s1[8 * ss + 6], s1[8 * ss + 7]); }
                const bf16x8 pa = __builtin_bit_cast(bf16x8, pw);
#pragma unroll
                for (int dt = 0; dt < 4; ++dt) {
                    const s16x4 lo = ds_tr(lds + (vA0 ^ (unsigned)(dt << 6)) + (32 * u + 16 * ss) * 512);
                    const s16x4 hi = ds_tr(lds + (vA0 ^ (unsigned)(dt << 6)) + (32 * u + 16 * ss + 8) * 512);
                    const bf16x8 vb = (bf16x8){lo[0], lo[1], lo[2], lo[3], hi[0], hi[1], hi[2], hi[3]};
                    o[dt] = MFMA32(pa, vb, o[dt]);
                }
            }
        }
        kA0 ^= DA_BUF; vA0 ^= DA_BUF;
    }
#undef DA_STAGE
    l += __shfl_xor(l, 32);
    if (half == 0) wsc[q] = 1.f / l;
    asm volatile("s_waitcnt lgkmcnt(0)" ::: "memory");
#pragma unroll
    for (int r = 0; r < 16; ++r) { const int qq = crow(r, half); const float a = wsc[qq];
        bf16_t* orow = U + (mq + qq) * LDU + (MODE == 0 ? C_DQ + h * 128 : C_XQ + h * 256 + c * 128) + q;
#pragma unroll
        for (int dt = 0; dt < 4; ++dt) { const bf16_t ov = (bf16_t)f2bf(o[dt][r] * a); if (!dry) orow[dt * 32] = ov; } }
}

constexpr int D4_GRP = 65536, D4_K = 0, D4_V = 16384, D4_BUF = 32768, D4_CNT = DA_END;
__device__ __forceinline__ void group_barrier(LAS unsigned* cnt, int lane) {
    asm volatile("s_waitcnt vmcnt(0) lgkmcnt(0)" ::: "memory");
    if (lane == 0) { const unsigned old = __hip_atomic_fetch_add(cnt, 1u, __ATOMIC_RELAXED, __HIP_MEMORY_SCOPE_WORKGROUP); const unsigned target = (old & ~3u) + 4u;
        while (__hip_atomic_load(cnt, __ATOMIC_RELAXED, __HIP_MEMORY_SCOPE_WORKGROUP) < target) __builtin_amdgcn_s_sleep(1); }
    asm volatile("" ::: "memory");
}
__device__ __forceinline__ float max3f_(float a, float b, float c) { return __builtin_fmaxf(__builtin_fmaxf(a, b), c); }
__device__ __forceinline__ void dsa_attend4_item(const Params& p, int idx, unsigned char* lds_, bool dry) {
    LAS char* lds = (LAS char*)lds_;
    bf16_t* U = Uptr(p); const unsigned short* maskbuf = (const unsigned short*)(p.ws + WS_MASK);
    const int tid = opaque_tid(), lane = tid & 63, wv = __builtin_amdgcn_readfirstlane(tid >> 6), q = lane & 31, half = lane >> 5;
    const int grp = wv >> 2, w4 = wv & 3, h = wv;
    const int b = idx & 3, j = idx >> 2, t0 = 32 * j; const size_t mb = (size_t)b * SEQ;
    LAS const float* tbh = (LAS const float*)(lds + DA_TB) + h * 132; LAS float* wsc = (LAS float*)(lds + DA_WS) + wv * 64;
    LAS unsigned* gcnt = (LAS unsigned*)(lds + D4_CNT) + grp * 16;
    constexpr float C1 = 0.08838834764831845f * 1.4426950408889634f;
    const float b31 = tbh[128], bmaxh = tbh[129];
    const int nsteps = (j >> 1) + 1;
    const unsigned gb = grp * D4_GRP;
    const int sr = 4 * w4 + (lane >> 4), spc = lane & 15;
    const bf16_t* gk = U + (mb + sr) * LDU + C_DK + grp * 128 + ((spc ^ (sr & 15)) << 3);
    const bf16_t* gv = U + (mb + sr) * LDU + C_DV + grp * 128 + ((spc ^ ((sr & 3) << 2)) << 3);
#define D4_STAGE(st_, bufoff_) do { const size_t go_ = (size_t)(64 * (st_)) * LDU; _Pragma("unroll") for (int i_ = 0; i_ < 4; ++i_) { \
        __builtin_amdgcn_global_load_lds((const unsigned*)(gk + go_ + (size_t)16 * i_ * LDU), (LAS unsigned*)(lds + gb + (bufoff_) + D4_K + (w4 + 4 * i_) * 1024), 16, 0, 0); \
        __builtin_amdgcn_global_load_lds((const unsigned*)(gv + go_ + (size_t)16 * i_ * LDU), (LAS unsigned*)(lds + gb + (bufoff_) + D4_V + (w4 + 4 * i_) * 1024), 16, 0, 0); } } while (0)
    group_barrier(gcnt, lane);
    D4_STAGE(0, 0);
    bf16x8 qf[8];
    { const bf16_t* ur = U + (mb + t0 + q) * LDU + C_DQ + h * 128 + 8 * half;
#pragma unroll
      for (int kk = 0; kk < 8; ++kk) qf[kk] = *(const bf16x8*)(ur + kk * 16); }
    f32x16 o[4];
#pragma unroll
    for (int dt = 0; dt < 4; ++dt)
#pragma unroll
        for (int r = 0; r < 16; ++r) o[dt][r] = 0.f;
    float m = -1e20f, l = 0.f;
    unsigned kA0, vA0;
    { const int q4 = (lane & 15) >> 2, p4 = lane & 3, g1 = (lane >> 4) & 1;
      kA0 = gb + D4_K + q * 256 + ((half ^ (q & 15)) << 4);
      vA0 = gb + D4_V + (4 * half + q4) * 256 + (((2 * g1 + (p4 >> 1)) ^ (q4 << 2)) << 4) + (p4 & 1) * 8; }
    unsigned mw0 = maskbuf[mask_index(b, j, 0, lane)], mw1 = (1 <= j) ? maskbuf[mask_index(b, j, 1, lane)] : 0u;
#pragma unroll 1
    for (int st = 0; st < nsteps; ++st) {
        const int kbase = 64 * st;
        group_barrier(gcnt, lane);
        const unsigned cw0 = mw0, cw1 = mw1;
        if (st + 1 < nsteps) { D4_STAGE(st + 1, ((st + 1) & 1) * D4_BUF);
            const int kt = 2 * st + 2; mw0 = maskbuf[mask_index(b, j, kt, lane)]; mw1 = (kt + 1 <= j) ? maskbuf[mask_index(b, j, kt + 1, lane)] : 0u; }
        f32x16 s0, s1;
#pragma unroll
        for (int r = 0; r < 16; ++r) { s0[r] = 0.f; s1[r] = 0.f; }
        { bf16x8 ka[8], kb[8];
#pragma unroll
          for (int kk = 0; kk < 8; ++kk) ka[kk] = *(LAS const bf16x8*)(lds + (kA0 ^ (unsigned)(kk << 5)));
#pragma unroll
          for (int kk = 0; kk < 8; ++kk) kb[kk] = *(LAS const bf16x8*)(lds + (kA0 ^ (unsigned)(kk << 5)) + 32 * 256);
          __builtin_amdgcn_sched_barrier(0);
#pragma unroll
          for (int kk = 0; kk < 8; ++kk) s0 = MFMA32(ka[kk], qf[kk], s0);
#pragma unroll
          for (int kk = 0; kk < 8; ++kk) s1 = MFMA32(kb[kk], qf[kk], s1);
          __builtin_amdgcn_sched_barrier(0); }
        const bool far_ = (t0 - (kbase + 63)) >= 128;
        float sm = max3f_(s0[0], s1[0], s0[1]);
#pragma unroll
        for (int r = 1; r < 16; ++r) sm = (r < 15) ? max3f_(sm, s1[r], s0[r + 1]) : fmaxf(sm, s1[r]);
        sm = fmaxf(sm, __shfl_xor(sm, 32));
        const float mc = __builtin_fmaf(sm, C1, far_ ? b31 : bmaxh);
        if (__any(mc > m + 8.f)) {
            const float mnew = fmaxf(m, mc);
            const float alpha = __builtin_amdgcn_exp2f(m - mnew); l *= alpha;
            if (half == 0) wsc[q] = alpha;
            asm volatile("s_waitcnt lgkmcnt(0)" ::: "memory");
#pragma unroll
            for (int r = 0; r < 16; ++r) { const float a = wsc[crow(r, half)];
#pragma unroll
                for (int dt = 0; dt < 4; ++dt) o[dt][r] *= a; }
            m = mnew;
        }
        float ls = 0.f;
        if (far_) {
            const int bm = __float_as_int(b31 - m), NEGI = __float_as_int(-1e30f);
#pragma unroll
            for (int r = 0; r < 16; ++r) {
                const int k0 = __builtin_amdgcn_sbfe((int)cw0, r, 1), k1 = __builtin_amdgcn_sbfe((int)cw1, r, 1);
                const float a0 = __int_as_float((k0 & bm) | (~k0 & NEGI)), a1 = __int_as_float((k1 & bm) | (~k1 & NEGI));
                s0[r] = __builtin_amdgcn_exp2f(__builtin_fmaf(s0[r], C1, a0)); s1[r] = __builtin_amdgcn_exp2f(__builtin_fmaf(s1[r], C1, a1)); ls += s0[r] + s1[r]; }
        } else {
            const int NEGI = __float_as_int(-1e30f);
#pragma unroll
            for (int r = 0; r < 16; ++r) {
                int d0 = t0 + q - (kbase + crow(r, half)); int d1 = d0 - 32; d0 = d0 < 0 ? 0 : (d0 > 128 ? 128 : d0); d1 = d1 < 0 ? 0 : (d1 > 128 ? 128 : d1);
                const int b0 = __float_as_int(tbh[d0] - m), b1 = __float_as_int(tbh[d1] - m);
                const int k0 = __builtin_amdgcn_sbfe((int)cw0, r, 1), k1 = __builtin_amdgcn_sbfe((int)cw1, r, 1);
                const float a0 = __int_as_float((k0 & b0) | (~k0 & NEGI)), a1 = __int_as_float((k1 & b1) | (~k1 & NEGI));
                s0[r] = __builtin_amdgcn_exp2f(__builtin_fmaf(s0[r], C1, a0)); s1[r] = __builtin_amdgcn_exp2f(__builtin_fmaf(s1[r], C1, a1)); ls += s0[r] + s1[r]; }
        }
        l += ls;
        { s16x4 vl[2][4], vh[2][4];
#pragma unroll
          for (int dt = 0; dt < 4; ++dt) { vl[0][dt] = ds_tr(lds + (vA0 ^ (unsigned)(dt << 6))); vh[0][dt] = ds_tr(lds + (vA0 ^ (unsigned)(dt << 6)) + 8 * 256); }
#pragma unroll
          for (int g = 0; g < 4; ++g) { const int u = g >> 1, ss = g & 1;
              if (g < 3) { const int gn = g + 1, un = gn >> 1, sn = gn & 1;
#pragma unroll
                  for (int dt = 0; dt < 4; ++dt) { vl[gn & 1][dt] = ds_tr(lds + (vA0 ^ (unsigned)(dt << 6)) + (32 * un + 16 * sn) * 256); vh[gn & 1][dt] = ds_tr(lds + (vA0 ^ (unsigned)(dt << 6)) + (32 * un + 16 * sn + 8) * 256); } }
              u32x4 pw;
              if (u == 0) { pw.x = pk2(s0[8 * ss], s0[8 * ss + 1]); pw.y = pk2(s0[8 * ss + 2], s0[8 * ss + 3]); pw.z = pk2(s0[8 * ss + 4], s0[8 * ss + 5]); pw.w = pk2(s0[8 * ss + 6], s0[8 * ss + 7]); }
              else { pw.x = pk2(s1[8 * ss], s1[8 * ss + 1]); pw.y = pk2(s1[8 * ss + 2], s1[8 * ss + 3]); pw.z = pk2(s1[8 * ss + 4], s1[8 * ss + 5]); pw.w = pk2(s1[8 * ss + 6], s1[8 * ss + 7]); }
              const bf16x8 pa = __builtin_bit_cast(bf16x8, pw);
              __builtin_amdgcn_sched_barrier(0);
#pragma unroll
              for (int dt = 0; dt < 4; ++dt) { const s16x4 lo = vl[g & 1][dt], hi = vh[g & 1][dt];
                  const bf16x8 vb = (bf16x8){lo[0], lo[1], lo[2], lo[3], hi[0], hi[1], hi[2], hi[3]};
                  o[dt] = MFMA32(pa, vb, o[dt]); }
              __builtin_amdgcn_sched_barrier(0); } }
        kA0 ^= D4_BUF; vA0 ^= D4_BUF;
    }
#undef D4_STAGE
    l += __shfl_xor(l, 32);
    if (half == 0) wsc[q] = 1.f / l;
    asm volatile("s_waitcnt lgkmcnt(0)" ::: "memory");
#pragma unroll
    for (int r = 0; r < 16; ++r) { const int qq = crow(r, half); const float a = wsc[qq];
        bf16_t* orow = U + (mb + t0 + qq) * LDU + C_DQ + h * 128 + q;
#pragma unroll
        for (int dt = 0; dt < 4; ++dt) { const bf16_t ov = (bf16_t)f2bf(o[dt][r] * a); if (!dry) orow[dt * 32] = ov; } }
}
__device__ void phase_dsa_attend4(const Params& p, int bid, int nb, unsigned char* lds, bool dry) {
    { float* tb = (float*)(lds + DA_TB);
      for (int e = threadIdx.x; e < 8 * 129; e += NTHREADS) { const int hh = e / 129, d = e % 129; tb[hh * 132 + d] = p.rel_bias[(d < 128 ? (int)T5B[d] : 31) * 8 + hh] * 1.4426950408889634f; }
      if (threadIdx.x < 8) { float mx = -1e30f; for (int bk = 0; bk < 32; ++bk) mx = fmaxf(mx, p.rel_bias[bk * 8 + threadIdx.x]); tb[threadIdx.x * 132 + 129] = mx * 1.4426950408889634f; }
      if (threadIdx.x < 32) ((unsigned*)(lds + D4_CNT))[threadIdx.x] = 0u; }
    __syncthreads();
    const int grp = __builtin_amdgcn_readfirstlane(threadIdx.x >> 8);
    for (int k = bid; k < 256; k += nb) {
        const int ia = k, ib = ((127 - (k >> 2)) << 2) | (k & 3);
#pragma unroll 1
        for (int r = 0; r < 2; ++r) dsa_attend4_item(p, (r ^ grp) ? ib : ia, lds, dry);
    }
    __syncthreads();
}

__device__ void phase_cross_attend(const Params& p, int bid, int nb, unsigned char* lds, bool dry) {
    for (int k = bid; k < 512; k += nb) attend_item<1>(p, k, lds, dry);
}
__device__ void phase_dsa_attend(const Params& p, int bid, int nb, unsigned char* lds, bool dry) {
    { float* tb = (float*)(lds + DA_TB);
      for (int e = threadIdx.x; e < 8 * 129; e += NTHREADS) { const int hh = e / 129, d = e % 129; tb[hh * 132 + d] = p.rel_bias[(d < 128 ? (int)T5B[d] : 31) * 8 + hh] * 1.4426950408889634f; }
      if (threadIdx.x < 8) { float mx = -1e30f; for (int bk = 0; bk < 32; ++bk) mx = fmaxf(mx, p.rel_bias[bk * 8 + threadIdx.x]); tb[threadIdx.x * 132 + 129] = mx * 1.4426950408889634f; } }
    __syncthreads();
    for (int k2 = 2 * bid; k2 < 512; k2 += (k2 & 1) ? 2 * nb - 1 : 1) { const int k = k2 >> 1; attend_item<0>(p, (k2 & 1) ? (((127 - (k >> 2)) << 2) | (k & 3)) : k, lds, dry); }
}


constexpr size_t WS_GD = 44 * MiB;
static_assert(WS_MASK + (size_t)4 * TRI * 128 <= WS_GD && WS_GD + 1024 * 128 * 4 <= WS_U, "ws map (mask, gla decay)");
__device__ __forceinline__ void gla_stage_v(LAS char* vdst, const bf16_t* Uc, int h, int tid) {
    const int lane = tid & 63, wv = __builtin_amdgcn_readfirstlane(tid >> 6), half = lane >> 5, srow = 2 * wv + half, spc = lane & 31;
    const bf16_t* gv = Uc + (size_t)srow * LDU + C_GV + h * 256 + ((spc ^ ((srow & 3) << 2)) << 3);
#pragma unroll
    for (int i = 0; i < 4; ++i) __builtin_amdgcn_global_load_lds((const unsigned*)(gv + (size_t)16 * i * LDU), (LAS unsigned*)(vdst + (wv + 8 * i) * 1024), 16, 0, 0);
}
constexpr int G1_KT = 0, G1_V = 16384, G1_B = 49152, G1_GA = 81920, G1_SEG = 83968, G1_BT = 86016;
__device__ __forceinline__ void gla_g1_item(const Params& p, int item, unsigned char* lds_, bool dry) {
    LAS char* lds = (LAS char*)lds_;
    bf16_t* U = Uptr(p); bf16_t* GS = (bf16_t*)p.out; float* GD = (float*)(p.ws + WS_GD);
    const int tid = opaque_tid(), lane = tid & 63, wv = __builtin_amdgcn_readfirstlane(tid >> 6), half = lane >> 5;
    const int bh = item >> 6, n = item & 63, b = bh >> 2, h = bh & 3;
    bf16_t* Uc = U + ((size_t)b * SEQ + 64 * n) * LDU;
    const int d8 = tid & 15, tg = tid >> 4;
    const u32x4 qa = *(const u32x4*)(Uc + (size_t)(2 * tg) * LDU + C_GQ + h * 128 + 8 * d8), qb = *(const u32x4*)(Uc + (size_t)(2 * tg + 1) * LDU + C_GQ + h * 128 + 8 * d8);
    const u32x4 ka = *(const u32x4*)(Uc + (size_t)(2 * tg) * LDU + C_GK + h * 128 + 8 * d8), kb = *(const u32x4*)(Uc + (size_t)(2 * tg + 1) * LDU + C_GK + h * 128 + 8 * d8);
    u32x4 gav = (u32x4){0u, 0u, 0u, 0u}; if (tid < 128) gav = *(const u32x4*)(Uc + (size_t)(tid >> 1) * LDU + C_GA + 8 * (tid & 1));
    __syncthreads();
    if (tid < 128) *(LAS u32x4*)(lds + G1_GA + tid * 16) = gav;
    gla_stage_v(lds + G1_V, Uc, h, tid);
    __syncthreads();
    { const int d = tid & 127, seg = tid >> 7;
      float w[16];
#pragma unroll
      for (int r = 0; r < 16; ++r) w[r] = p.w_a_up[r * 512 + h * 128 + d];
      const float ba = p.b_a[h * 128 + d];
      float bl[16]; float cum = 0.f;
#pragma unroll
      for (int i = 0; i < 16; ++i) {
          const u32x4 g0 = *(LAS const u32x4*)(lds + G1_GA + (16 * seg + i) * 32), g1 = *(LAS const u32x4*)(lds + G1_GA + (16 * seg + i) * 32 + 16);
          float x = ba;
          x += __uint_as_float(g0.x << 16) * w[0] + __uint_as_float(g0.x & 0xffff0000u) * w[1] + __uint_as_float(g0.y << 16) * w[2] + __uint_as_float(g0.y & 0xffff0000u) * w[3];
          x += __uint_as_float(g0.z << 16) * w[4] + __uint_as_float(g0.z & 0xffff0000u) * w[5] + __uint_as_float(g0.w << 16) * w[6] + __uint_as_float(g0.w & 0xffff0000u) * w[7];
          x += __uint_as_float(g1.x << 16) * w[8] + __uint_as_float(g1.x & 0xffff0000u) * w[9] + __uint_as_float(g1.y << 16) * w[10] + __uint_as_float(g1.y & 0xffff0000u) * w[11];
          x += __uint_as_float(g1.z << 16) * w[12] + __uint_as_float(g1.z & 0xffff0000u) * w[13] + __uint_as_float(g1.w << 16) * w[14] + __uint_as_float(g1.w & 0xffff0000u) * w[15];
          const float sp = __builtin_amdgcn_logf(1.f + __builtin_amdgcn_exp2f(-1.4426950408889634f * fmaxf(x, -80.f)));
          cum += -0.04332169878499658f * sp; bl[i] = cum;
      }
      LAS float* segsum = (LAS float*)(lds + G1_SEG);
      segsum[seg * 128 + d] = cum;
      __syncthreads();
      float off = 0.f, tot = 0.f;
#pragma unroll
      for (int s2 = 0; s2 < 4; ++s2) { const float v = segsum[s2 * 128 + d]; tot += v; if (s2 < seg) off += v; }
#pragma unroll
      for (int i = 0; i < 16; ++i) *(LAS float*)(lds + G1_B + ((16 * seg + i) * 128 + d) * 4) = bl[i] + off;
      if (seg == 0) { *(LAS float*)(lds + G1_BT + d * 4) = tot; GD[(size_t)item * 128 + d] = __builtin_amdgcn_exp2f(1.4426950408889634f * tot); } }
    __syncthreads();
    { unsigned qo[2][4], ko[2][4]; float kt_[2][8];
#pragma unroll
      for (int tt = 0; tt < 2; ++tt) { const int t = 2 * tg + tt; const u32x4 qv = tt ? qb : qa, kv = tt ? kb : ka;
          const f32x4 b0 = *(LAS const f32x4*)(lds + G1_B + (t * 128 + 8 * d8) * 4), b1 = *(LAS const f32x4*)(lds + G1_B + (t * 128 + 8 * d8 + 4) * 4);
          const f32x4 t0 = *(LAS const f32x4*)(lds + G1_BT + (8 * d8) * 4), t1 = *(LAS const f32x4*)(lds + G1_BT + (8 * d8 + 4) * 4);
          float qd[8], kd[8];
#pragma unroll
          for (int e = 0; e < 8; ++e) { const unsigned qw = e < 2 ? qv.x : e < 4 ? qv.y : e < 6 ? qv.z : qv.w, kw = e < 2 ? kv.x : e < 4 ? kv.y : e < 6 ? kv.z : kv.w;
              const float qf = (e & 1) ? __uint_as_float(qw & 0xffff0000u) : __uint_as_float(qw << 16), kf = (e & 1) ? __uint_as_float(kw & 0xffff0000u) : __uint_as_float(kw << 16);
              const float bb = e < 4 ? b0[e & 3] : b1[e & 3], bt = e < 4 ? t0[e & 3] : t1[e & 3];
              const float ep = __builtin_amdgcn_exp2f(1.4426950408889634f * bb), em = __builtin_amdgcn_exp2f(-1.4426950408889634f * bb);
              qd[e] = qf * 0.08838834764831845f * ep; kd[e] = kf * em; kt_[tt][e] = kf * __builtin_amdgcn_exp2f(1.4426950408889634f * (bt - bb)); }
#pragma unroll
          for (int e = 0; e < 4; ++e) { qo[tt][e] = pk2(qd[2 * e], qd[2 * e + 1]); ko[tt][e] = pk2(kd[2 * e], kd[2 * e + 1]); } }
      if (!dry) {
      if (!dry) {
      *(u32x4*)(Uc + (size_t)(2 * tg) * LDU + C_GQ + h * 128 + 8 * d8) = (u32x4){qo[0][0], qo[0][1], qo[0][2], qo[0][3]};
      *(u32x4*)(Uc + (size_t)(2 * tg + 1) * LDU + C_GQ + h * 128 + 8 * d8) = (u32x4){qo[1][0], qo[1][1], qo[1][2], qo[1][3]};
      *(u32x4*)(Uc + (size_t)(2 * tg) * LDU + C_GK + h * 128 + 8 * d8) = (u32x4){ko[0][0], ko[0][1], ko[0][2], ko[0][3]};
      *(u32x4*)(Uc + (size_t)(2 * tg + 1) * LDU + C_GK + h * 128 + 8 * d8) = (u32x4){ko[1][0], ko[1][1], ko[1][2], ko[1][3]}; } }
#pragma unroll
      for (int e = 0; e < 8; ++e) { const int d = 8 * d8 + e; const int ch = (tg >> 2) ^ ((d >> 1) & 7);
          *(LAS unsigned*)(lds + G1_KT + d * 128 + (ch << 4) + (tg & 3) * 4) = pk2(kt_[0][e], kt_[1][e]); } }
    asm volatile("s_waitcnt vmcnt(0)" ::: "memory");
    __syncthreads();
    f32x16 acc[4];
#pragma unroll
    for (int i = 0; i < 4; ++i)
#pragma unroll
        for (int r = 0; r < 16; ++r) acc[i][r] = 0.f;
    const int dk = 32 * (wv & 3) + (lane & 31), q4 = (lane & 15) >> 2, p4 = lane & 3, g1 = (lane >> 4) & 1;
#pragma unroll
    for (int s_ = 0; s_ < 4; ++s_) {
        const bf16x8 a = *(LAS const bf16x8*)(lds + G1_KT + dk * 128 + (((2 * s_ + half) ^ ((dk >> 1) & 7)) << 4));
#pragma unroll
        for (int i = 0; i < 4; ++i) { const int dtile = 4 * (wv >> 2) + i; const int ch = (dtile * 4 + 2 * g1 + (p4 >> 1)) ^ (q4 << 2);
            const s16x4 lo = ds_tr(lds + G1_V + (16 * s_ + 8 * half + q4) * 512 + (ch << 4) + (p4 & 1) * 8);
            const s16x4 hi = ds_tr(lds + G1_V + (16 * s_ + 8 * half + 4 + q4) * 512 + (ch << 4) + (p4 & 1) * 8);
            const bf16x8 vb = (bf16x8){lo[0], lo[1], lo[2], lo[3], hi[0], hi[1], hi[2], hi[3]};
            acc[i] = MFMA32(a, vb, acc[i]); }
    }
    bf16_t* gs = GS + (size_t)item * 32768;
#pragma unroll
    for (int i = 0; i < 4; ++i) { const int dv = 32 * (4 * (wv >> 2) + i) + (lane & 31);
#pragma unroll
        for (int r4 = 0; r4 < 4; ++r4) { u32x2 w2; w2.x = pk2(acc[i][4 * r4], acc[i][4 * r4 + 1]); w2.y = pk2(acc[i][4 * r4 + 2], acc[i][4 * r4 + 3]);
            *(u32x2*)(gs + (size_t)dv * 128 + 32 * (wv & 3) + 8 * r4 + 4 * half) = w2; } }
}
__device__ void phase_gla_g1(const Params& p, int bid, int nb, unsigned char* lds, bool dry) { for (int it = bid; it < 1024; it += nb) gla_g1_item(p, it, lds, dry); }
__device__ void phase_gla_g2(const Params& p, int bid, int nb, bool dry) {
    bf16_t* GS = (bf16_t*)p.out; const float* GD = (const float*)(p.ws + WS_GD);
    for (int e = bid * NTHREADS + threadIdx.x; e < 16 * 8192; e += nb * NTHREADS) {
        const int bh = e >> 13, w = e & 8191, dk4 = (w & 31) * 4;
        bf16_t* gp = GS + (size_t)bh * 64 * 32768 + (size_t)w * 4; const float* dp = GD + (size_t)bh * 64 * 128 + dk4;
        f32x4 S = (f32x4){0.f, 0.f, 0.f, 0.f};
#pragma unroll 8
        for (int n = 0; n < 64; ++n) {
            const u32x2 t2 = *(const u32x2*)(gp + (size_t)n * 32768); const f32x4 dc = *(const f32x4*)(dp + n * 128);
            u32x2 o2; o2.x = pk2(S[0], S[1]); o2.y = pk2(S[2], S[3]); if (!dry) *(u32x2*)(gp + (size_t)n * 32768) = o2;
            S[0] = dc[0] * S[0] + __uint_as_float(t2.x << 16); S[1] = dc[1] * S[1] + __uint_as_float(t2.x & 0xffff0000u);
            S[2] = dc[2] * S[2] + __uint_as_float(t2.y << 16); S[3] = dc[3] * S[3] + __uint_as_float(t2.y & 0xffff0000u);
        }
    }
}
constexpr int G3_QD = 0, G3_KD = 16384, G3_V = 32768, G3_SSQ = 65536;
__device__ __forceinline__ void gla_g3_item(const Params& p, int item, unsigned char* lds_, bool dry) {
    LAS char* lds = (LAS char*)lds_;
    bf16_t* U = Uptr(p); const bf16_t* GS = (const bf16_t*)p.out;
    const int tid = opaque_tid(), lane = tid & 63, wv = __builtin_amdgcn_readfirstlane(tid >> 6), half = lane >> 5, q = lane & 31;
    const int bh = item >> 6, n = item & 63, b = bh >> 2, h = bh & 3;
    bf16_t* Uc = U + ((size_t)b * SEQ + 64 * n) * LDU;
    LAS float* ssq = (LAS float*)(lds + G3_SSQ);
    __syncthreads();
    { const int r4 = lane >> 4, pc = lane & 15;
#pragma unroll
      for (int i = 0; i < 2; ++i) { const int row = 4 * (wv + 8 * i) + r4; const bf16_t* src = Uc + (size_t)row * LDU + h * 128 + ((pc ^ (row & 15)) << 3);
          __builtin_amdgcn_global_load_lds((const unsigned*)(src + C_GQ), (LAS unsigned*)(lds + G3_QD + (wv + 8 * i) * 1024), 16, 0, 0);
          __builtin_amdgcn_global_load_lds((const unsigned*)(src + C_GK), (LAS unsigned*)(lds + G3_KD + (wv + 8 * i) * 1024), 16, 0, 0); } }
    gla_stage_v(lds + G3_V, Uc, h, tid);
    if (tid < 64) ssq[tid] = 0.f;
    bf16x8 sf[8];
    { const bf16_t* sp = GS + (size_t)item * 32768 + (size_t)(32 * wv + q) * 128 + 8 * half;
#pragma unroll
      for (int kk = 0; kk < 8; ++kk) sf[kk] = *(const bf16x8*)(sp + kk * 16); }
    asm volatile("s_waitcnt vmcnt(0)" ::: "memory");
    __syncthreads();
    f32x16 o[2];
#pragma unroll
    for (int tt = 0; tt < 2; ++tt)
#pragma unroll
        for (int r = 0; r < 16; ++r) o[tt][r] = 0.f;
    const int q4 = (lane & 15) >> 2, p4 = lane & 3, g1 = (lane >> 4) & 1;
    const unsigned vA = G3_V + (4 * half + q4) * 512 + ((((wv * 4 + 2 * g1 + (p4 >> 1))) ^ (q4 << 2)) << 4) + (p4 & 1) * 8;
#pragma unroll
    for (int tt = 0; tt < 2; ++tt) {
#pragma unroll
        for (int kk = 0; kk < 8; ++kk) { const int t = 32 * tt + q;
            const bf16x8 a = *(LAS const bf16x8*)(lds + G3_QD + t * 256 + (((2 * kk + half) ^ (t & 15)) << 4));
            o[tt] = MFMA32(a, sf[kk], o[tt]); }
#pragma unroll
        for (int st = 0; st <= tt; ++st) {
            f32x16 x;
#pragma unroll
            for (int r = 0; r < 16; ++r) x[r] = 0.f;
#pragma unroll
            for (int kk = 0; kk < 8; ++kk) { const int srow = 32 * st + q, trow = 32 * tt + q;
                const bf16x8 a = *(LAS const bf16x8*)(lds + G3_KD + srow * 256 + (((2 * kk + half) ^ (srow & 15)) << 4));
                const bf16x8 bq = *(LAS const bf16x8*)(lds + G3_QD + trow * 256 + (((2 * kk + half) ^ (trow & 15)) << 4));
                x = MFMA32(a, bq, x); }
            if (st == tt) {
#pragma unroll
                for (int r = 0; r < 16; ++r) x[r] = (crow(r, half) <= q) ? x[r] : 0.f;
            }
#pragma unroll
            for (int ss = 0; ss < 2; ++ss) {
                u32x4 pw; pw.x = pk2(x[8 * ss], x[8 * ss + 1]); pw.y = pk2(x[8 * ss + 2], x[8 * ss + 3]); pw.z = pk2(x[8 * ss + 4], x[8 * ss + 5]); pw.w = pk2(x[8 * ss + 6], x[8 * ss + 7]);
                const bf16x8 pa = __builtin_bit_cast(bf16x8, pw);
                const s16x4 lo = ds_tr(lds + vA + (32 * st + 16 * ss) * 512);
                const s16x4 hi = ds_tr(lds + vA + (32 * st + 16 * ss + 8) * 512);
                const bf16x8 vb = (bf16x8){lo[0], lo[1], lo[2], lo[3], hi[0], hi[1], hi[2], hi[3]};
                o[tt] = MFMA32(pa, vb, o[tt]);
            }
        }
    }
#pragma unroll
    for (int tt = 0; tt < 2; ++tt)
#pragma unroll
        for (int r = 0; r < 16; ++r) { float v = o[tt][r] * o[tt][r];
            v += __shfl_xor(v, 1); v += __shfl_xor(v, 2); v += __shfl_xor(v, 4); v += __shfl_xor(v, 8); v += __shfl_xor(v, 16);
            if (q == 0) __hip_atomic_fetch_add(ssq + 32 * tt + crow(r, half), v, __ATOMIC_RELAXED, __HIP_MEMORY_SCOPE_WORKGROUP); }
    __syncthreads();
    const float gg = p.g_gla[32 * wv + q];
#pragma unroll
    for (int tt = 0; tt < 2; ++tt)
#pragma unroll
        for (int r = 0; r < 16; ++r) { const int t = 32 * tt + crow(r, half); const float rstd = 1.f / sqrtf(ssq[t] * (1.f / 256.f) + EPS);
            const bf16_t ov = (bf16_t)f2bf(o[tt][r] * rstd * gg); if (!dry) Uc[(size_t)t * LDU + C_GV + h * 256 + 32 * wv + q] = ov; }
}
__device__ void phase_gla_g3(const Params& p, int bid, int nb, unsigned char* lds, bool dry) { for (int it = bid; it < 1024; it += nb) gla_g3_item(p, it, lds, dry); }

__device__ void phase_cross_ref(const Params& p, int bid, int nb, unsigned char* lds) {
    float* qs = (float*)lds;
    float* lg = qs + 1024;
    bf16_t* U = Uptr(p); const bf16_t* MKV = (const bf16_t*)(p.ws + WS_MKV);
    const int tid = threadIdx.x, lane = tid & 63, wave = tid >> 6;
    for (int it = bid; it < MTOK; it += nb) {
        const int b = it / SEQ; const size_t m = (size_t)it; const bf16_t* mb = MKV + (size_t)b * NMEM * 2048;
        __syncthreads();
        qs[tid] = bf2f(U[m * LDU + C_XQ + tid]) * 0.0625f; qs[tid + 512] = bf2f(U[m * LDU + C_XQ + 512 + tid]) * 0.0625f;
        __syncthreads();
        { const int j = tid & 255, hp = tid >> 8;
          const bf16_t* kr = mb + (size_t)j * 2048 + hp * 512; float a0 = 0.f, a1 = 0.f;
          for (int d0 = 0; d0 < 256; d0 += 8) { const bf16x8 k0 = *(const bf16x8*)(kr + d0); const bf16x8 k1 = *(const bf16x8*)(kr + 256 + d0);
#pragma unroll
              for (int dd = 0; dd < 8; ++dd) { a0 += qs[hp * 512 + d0 + dd] * bf2f((bf16_t)k0[dd]); a1 += qs[hp * 512 + 256 + d0 + dd] * bf2f((bf16_t)k1[dd]); } }
          lg[(2 * hp) * 256 + j] = a0; lg[(2 * hp + 1) * 256 + j] = a1; }
        __syncthreads();
        if (wave < 4) { float v[4]; float mx = -3e38f;
#pragma unroll
            for (int i = 0; i < 4; ++i) { v[i] = lg[wave * 256 + lane + 64 * i]; mx = fmaxf(mx, v[i]); }
            mx = wave_max(mx); float sm = 0.f;
#pragma unroll
            for (int i = 0; i < 4; ++i) { v[i] = __expf(v[i] - mx); sm += v[i]; }
            sm = wave_sum(sm); const float inv = 1.f / sm;
#pragma unroll
            for (int i = 0; i < 4; ++i) lg[wave * 256 + lane + 64 * i] = v[i] * inv; }
        __syncthreads();
        { const int h = tid >> 7, d = (tid & 127) * 2; float o0 = 0.f, o1 = 0.f;
          for (int j = 0; j < NMEM; ++j) { const float pj = lg[h * 256 + j]; const unsigned w = *(const unsigned*)(mb + (size_t)j * 2048 + 1024 + h * 256 + d);
              o0 += pj * __uint_as_float(w << 16); o1 += pj * __uint_as_float(w & 0xffff0000u); }
          *(unsigned*)(U + m * LDU + C_XQ + h * 256 + d) = pk2(o0, o1); }
    }
}

__device__ void phase_final(const Params& p, int bid, int nb, bool dry) {
    const int lane = threadIdx.x & 63, wave = threadIdx.x >> 6; const bf16_t* U = Uptr(p);
    for (int m = bid * NWAVES + wave; m < MTOK; m += nb * NWAVES) {
        f32x4* orow = (f32x4*)(p.out + (size_t)m * DM) + lane; const f32x4* xr = (const f32x4*)(p.x + (size_t)m * DM) + lane; const f32x4* gr = (const f32x4*)p.g_post + lane;
        const bf16_t* ob = U + (size_t)m * LDU + C_H + 4 * lane;
        f32x4 v[4]; float s = 0.f;
#pragma unroll
        for (int j = 0; j < 4; ++j) { v[j] = ld4bf(ob + 256 * j); s += (v[j].x * v[j].x + v[j].y * v[j].y) + (v[j].z * v[j].z + v[j].w * v[j].w); }
        const float rstd = 1.f / sqrtf(wave_sum(s) * (1.f / DM) + EPS);
#pragma unroll
        for (int j = 0; j < 4; ++j) { const f32x4 ov = xr[64 * j] + v[j] * rstd * gr[64 * j]; if (!dry) orow[64 * j] = ov; }
    }
}

#define XB_TMO      128
#define XB_XCNT(j)  (256  + 64 * (j))
#define XB_XSUB(j)  (1280 + 64 * (j))
#define XB_XGEN(j)  (2304 + 64 * (j))
#define XB_TOP      3328
#define XB_TOPGEN   3392
#define XCD_BAR_WORDS 3456
#define XB_SPIN_CAP (1u << 22)
constexpr size_t WS_BAR = 46 * MiB;
__device__ __forceinline__ unsigned xb_ld(unsigned* p)              { return __hip_atomic_load(p, __ATOMIC_RELAXED, __HIP_MEMORY_SCOPE_AGENT); }
__device__ __forceinline__ unsigned xb_add(unsigned* p, unsigned v) { return __hip_atomic_fetch_add(p, v, __ATOMIC_RELAXED, __HIP_MEMORY_SCOPE_AGENT); }
__device__ __forceinline__ unsigned xb_xcc_id() { return (unsigned)__builtin_amdgcn_s_getreg((3 << 11) | 20) & 0xFu; }
#define XB_SPIN(cond, bar) do { unsigned _sp = 0; while (cond) { __builtin_amdgcn_s_sleep(1); \
    if ((++_sp & 255u) == 0u) { if (xb_ld(&(bar)[XB_TMO])) break; if (_sp > XB_SPIN_CAP) { atomicAdd(&(bar)[XB_TMO], 1u); break; } } } } while (0)
struct XcdBarrier { unsigned* bar; unsigned x; volatile LAS unsigned* st; };
__device__ __forceinline__ XcdBarrier xcd_barrier_post(unsigned* bar, volatile LAS unsigned* st) {
    XcdBarrier b; b.bar = bar; b.x = xb_xcc_id(); b.st = st;
    if (threadIdx.x == 0) (void)xb_add(&bar[XB_XCNT(b.x)], 1u);
    return b;
}
__device__ __forceinline__ void xcd_barrier_complete(unsigned* bar, unsigned x, unsigned& nloc, unsigned& nx) {
    const unsigned G = gridDim.x * gridDim.y * gridDim.z;
    unsigned sum, cnt, mine, sp = 0u;
    for (;;) {
        sum = 0u; cnt = 0u; mine = 0u;
#pragma unroll
        for (unsigned j = 0; j < 16; ++j) { const unsigned c = xb_ld(&bar[XB_XCNT(j)]); sum += c; cnt += (c > 0u) ? 1u : 0u; mine = (j == x) ? c : mine; }
        if (sum == G) break;
        __builtin_amdgcn_s_sleep(1);
        if ((++sp & 255u) == 0u) { if (xb_ld(&bar[XB_TMO])) break; if (sp > XB_SPIN_CAP) { atomicAdd(&bar[XB_TMO], 1u); break; } }
    }
    nloc = mine > 0u ? mine : 1u; nx = cnt > 0u ? cnt : 1u;
}
__device__ __forceinline__ void xcd_barrier(const XcdBarrier& b) {
    asm volatile("s_waitcnt vmcnt(0)" ::: "memory");
    __syncthreads();
    if (threadIdx.x == 0) {
        unsigned* bar = b.bar;
        __builtin_amdgcn_s_waitcnt(0);
        unsigned nloc = b.st[0], nx = b.st[1];
        if (nloc == 0u) { xcd_barrier_complete(bar, b.x, nloc, nx); b.st[0] = nloc; b.st[1] = nx; }
        const unsigned old = xb_add(&bar[XB_XSUB(b.x)], 1u);
        const unsigned gen = old / nloc;
        if (old + 1u == (gen + 1u) * nloc) {
            __builtin_amdgcn_fence(__ATOMIC_RELEASE, "agent");
            asm volatile("s_waitcnt vmcnt(0)" ::: "memory");
            const unsigned og = xb_add(&bar[XB_TOP], 1u);
            const unsigned tg = og / nx;
            if (og + 1u == (tg + 1u) * nx) xb_add(&bar[XB_TOPGEN], 1u);
            else XB_SPIN(xb_ld(&bar[XB_TOPGEN]) == tg, bar);
            __builtin_amdgcn_fence(__ATOMIC_ACQUIRE, "agent");
            xb_add(&bar[XB_XGEN(b.x)], 1u);
            asm volatile("s_waitcnt vmcnt(0)" ::: "memory");
        } else {
            XB_SPIN(xb_ld(&bar[XB_XGEN(b.x)]) == gen, bar);
            __builtin_amdgcn_fence(__ATOMIC_ACQUIRE, "agent");
            asm volatile("s_waitcnt vmcnt(0)" ::: "memory");
        }
    }
    __syncthreads();
}

constexpr int NPHASE = 9;
constexpr int LDS_BYTES = 144 * 1024;
#ifndef USE_PG8
#define USE_PG8 1
#endif
__device__ __forceinline__ void run_phase(const Params& p, int ph, int bid, int nb, unsigned char* lds, bool dry = false) {
    bf16_t* U = Uptr(p); const bf16_t* WT = (const bf16_t*)(p.ws + WS_WTALL);
    bf16_t* S2 = (bf16_t*)p.out; float* oraw = p.out;
    PG8_LAS unsigned char* lds3 = (PG8_LAS unsigned char*)lds;
    switch (ph) {
    case 0: phase_prep(p, bid, nb, lds); break;
    case 1: { OpStoreBf16 o1{U, LDU, 1024}; OpStoreBf16 o2{(bf16_t*)(p.ws + WS_MKV), 2048, 0};
#if USE_PG8
              pg8::Sched S{}; S.j[0] = pg8::Job{U + C_H, WT, MTOK / 256, N1 / 256}; S.j[1] = pg8::Job{(const bf16_t*)p.out, (const bf16_t*)(p.ws + WS_WTMKV), MMEM / 256, 2048 / 256};
              S.njobs = 2; S.rep = 1; S.G = nb; S.c = bid; S.lda = LDU; S.astride = 0; S.bstride = 0;
              pg8::Epi<SelP1> E{SelP1{o1, o2}}; pg8::gemm_phase<pg8::Epi<SelP1>, true>(lds3, S, E);
#else
              gemm_simple(U + C_H, LDU, WT, MTOK, N1, DM, o1, bid, nb); gemm_simple((const bf16_t*)p.out, LDU, (const bf16_t*)(p.ws + WS_WTMKV), MMEM, 2048, DM, o2, bid, nb);
#endif
            } break;
#if !defined(DSA_REF) && !defined(GLA_REF)
    case 2: if (bid & 1) { phase_dsa_select2(p, bid, nb, lds); phase_gla_g1(p, bid, nb, lds, dry); } else { phase_gla_g1(p, bid, nb, lds, dry); phase_dsa_select2(p, bid, nb, lds); } break;
    case 3: if (bid & 1) { phase_dsa_attend4(p, bid, nb, lds, dry); phase_gla_g2(p, bid, nb, dry); } else { phase_gla_g2(p, bid, nb, dry); phase_dsa_attend4(p, bid, nb, lds, dry); } break;
#elif !defined(DSA_REF)
    case 2: phase_gla_rec(p, oraw, bid, nb, lds); phase_dsa_select(p, bid, nb, lds); break;
    case 3: phase_gla_norm(p, oraw, bid, nb); phase_dsa_attend(p, bid, nb, lds, dry); break;
#else
    case 2: phase_gla_rec(p, oraw, bid, nb, lds); break;
    case 3: phase_gla_norm(p, oraw, bid, nb); phase_dsa_ref(p, bid, nb, lds); break;
#endif
#ifndef CROSS_REF
    case 4:
#ifndef GLA_REF
        if (bid & 1) { phase_cross_attend(p, bid, nb, lds, dry); phase_gla_g3(p, bid, nb, lds, dry); } else { phase_gla_g3(p, bid, nb, lds, dry); phase_cross_attend(p, bid, nb, lds, dry); }
#else
        phase_cross_attend(p, bid, nb, lds, dry);
#endif
        break;
#else
    case 4: phase_cross_ref(p, bid, nb, lds); break;
#endif
    case 5: { OpZGate oz{U, dry}; OpSig os{S2, U};
#if USE_PG8
              pg8::Sched S{}; S.j[0] = pg8::Job{U + C_H, WT + (size_t)WT_Z * DM, MTOK / 256, 3072 / 256}; S.j[1] = pg8::Job{U + C_H, WT + (size_t)WT_G * DM, MTOK / 256, 3072 / 256};
              S.njobs = 2; S.rep = 1; S.G = nb; S.c = bid; S.lda = LDU; S.astride = 0; S.bstride = 0;
              pg8::Epi<SelP5> E{SelP5{oz, os}}; pg8::gemm_phase<pg8::Epi<SelP5>, true>(lds3, S, E);
#else
              gemm_simple(U + C_H, LDU, WT + (size_t)WT_Z * DM, MTOK, 3072, DM, oz, bid, nb); gemm_simple(U + C_H, LDU, WT + (size_t)WT_G * DM, MTOK, 3072, DM, os, bid, nb);
#endif
            } break;
    case 6: { OpMerge<0> m0{S2, U}; OpMerge<1> m1{S2, U}; OpMerge<2> m2{S2, U};
#if USE_PG8
              pg8::Sched S{}; S.j[0] = pg8::Job{U + C_GV, (const bf16_t*)(p.ws + WS_WTGO), MTOK / 256, DM / 256};
              S.njobs = 1; S.rep = 3; S.G = nb; S.c = bid; S.lda = LDU; S.astride = 1024; S.bstride = (long)(WS_WTDO - WS_WTGO) / 2;
              pg8::Epi<SelP6> E{SelP6{m0, m1, m2}}; pg8::gemm_phase<pg8::Epi<SelP6>, true>(lds3, S, E);
#else
              gemm_simple(U + C_GV, LDU, (const bf16_t*)(p.ws + WS_WTGO), MTOK, DM, DM, m0, bid, nb);
              gemm_simple(U + C_DQ, LDU, (const bf16_t*)(p.ws + WS_WTDO), MTOK, DM, DM, m1, bid, nb);
              gemm_simple(U + C_XQ, LDU, (const bf16_t*)(p.ws + WS_WTXO), MTOK, DM, DM, m2, bid, nb);
#endif
            } break;
    case 7: { OpStoreBf16 oo{U, LDU, C_H};
#if USE_PG8
              pg8::Sched S{}; S.j[0] = pg8::Job{U + C_MG, (const bf16_t*)(p.ws + WS_WTO), MTOK / 256, DM / 256};
              S.njobs = 1; S.rep = 1; S.G = nb; S.c = bid; S.lda = LDU; S.astride = 0; S.bstride = 0;
              pg8::Epi<SelP7> E{SelP7{oo}}; pg8::gemm_phase<pg8::Epi<SelP7>, false>(lds3, S, E);
#else
              gemm_simple(U + C_MG, LDU, (const bf16_t*)(p.ws + WS_WTO), MTOK, DM, DM, oo, bid, nb);
#endif
            } break;
    case 8: phase_final(p, bid, nb, dry); break;
    }
}

#if ONE_LAUNCH
__global__ void __launch_bounds__(NTHREADS) fwd_mega(Params p) {
    extern __shared__ __attribute__((aligned(16))) unsigned char lds[];
    cg::grid_group grid = cg::this_grid();
    const int bid = blockIdx.x, nb = gridDim.x;
    volatile LAS unsigned* xst = (volatile LAS unsigned*)((LAS unsigned char*)lds + LDS_BYTES - 16);
    unsigned* barw = (unsigned*)(p.ws + WS_BAR);
    if (threadIdx.x < 4) xst[threadIdx.x] = 0u;
    __syncthreads();
    if (p.ws == nullptr) grid.sync();
    const XcdBarrier xbar = xcd_barrier_post(barw, xst);
#ifdef PROF_PHASE
#define PROF_DUP(k) if (PROF_PHASE == (k)) { run_phase(p, (k), bid, nb, lds, p.g_pre != nullptr); GSYNC(); } \
    if (PROF_PHASE == 10 * (k) + 0) { const bool dry_ = p.g_pre != nullptr; if ((k) == 2) phase_gla_g1(p, bid, nb, lds, dry_); if ((k) == 3) phase_gla_g2(p, bid, nb, dry_); if ((k) == 4) phase_gla_g3(p, bid, nb, lds, dry_); GSYNC(); } \
    if (PROF_PHASE == 10 * (k) + 1) { const bool dry_ = p.g_pre != nullptr; if ((k) == 2) phase_dsa_select2(p, bid, nb, lds); if ((k) == 3) phase_dsa_attend4(p, bid, nb, lds, dry_); if ((k) == 4) phase_cross_attend(p, bid, nb, lds, dry_); GSYNC(); }
#else
#define PROF_DUP(k)
#endif
#define GSYNC() xcd_barrier(xbar)
    PROF_DUP(0) run_phase(p, 0, bid, nb, lds); GSYNC();
    PROF_DUP(1) run_phase(p, 1, bid, nb, lds); GSYNC();
    PROF_DUP(2) run_phase(p, 2, bid, nb, lds); GSYNC();
    PROF_DUP(3) run_phase(p, 3, bid, nb, lds); GSYNC();
    PROF_DUP(4) run_phase(p, 4, bid, nb, lds); GSYNC();
    PROF_DUP(5) run_phase(p, 5, bid, nb, lds); GSYNC();
    PROF_DUP(6) run_phase(p, 6, bid, nb, lds); GSYNC();
    PROF_DUP(7) run_phase(p, 7, bid, nb, lds); GSYNC();
    PROF_DUP(8) run_phase(p, 8, bid, nb, lds);
#undef GSYNC
}
#else
template <int PH> __global__ void __launch_bounds__(NTHREADS) fwd_phase(Params p) {
    extern __shared__ __attribute__((aligned(16))) unsigned char lds[];
    run_phase(p, PH, blockIdx.x, gridDim.x, lds);
}
#endif

extern "C" void kernel_launch(void* const* d_in, const int* in_sizes, int n_in, void* d_out, int out_size, void* d_ws, size_t ws_size, hipStream_t stream) {
    if (n_in != 15 || out_size != MTOK * DM || ws_size < WS_END) { fprintf(stderr, "kernel_launch: unexpected shapes (n_in %d out %d ws %zu)\n", n_in, out_size, ws_size); return; }
    Params p{};
    p.x = (const float*)d_in[0]; p.mem = (const float*)d_in[1]; p.g_pre = (const float*)d_in[2]; p.g_post = (const float*)d_in[3]; p.g_mem = (const float*)d_in[4];
    p.w_in = (const float*)d_in[5]; p.w_a_up = (const float*)d_in[6]; p.b_a = (const float*)d_in[7]; p.g_gla = (const float*)d_in[8]; p.rel_bias = (const float*)d_in[9];
    p.w_mem_kv = (const float*)d_in[10]; p.w_gla_out = (const float*)d_in[11]; p.w_dsa_out = (const float*)d_in[12]; p.w_x_out = (const float*)d_in[13]; p.w_o = (const float*)d_in[14];
    p.out = (float*)d_out; p.ws = (unsigned char*)d_ws;
#if ONE_LAUNCH
    static int grid_blocks = 0;
    if (!grid_blocks) {
        int dev = 0, cus = 0, per_cu = 0;
        hipGetDevice(&dev); hipDeviceGetAttribute(&cus, hipDeviceAttributeMultiprocessorCount, dev);
        hipFuncSetAttribute((const void*)fwd_mega, hipFuncAttributeMaxDynamicSharedMemorySize, LDS_BYTES);
        hipOccupancyMaxActiveBlocksPerMultiprocessor(&per_cu, (const void*)fwd_mega, NTHREADS, LDS_BYTES);
        if (per_cu < 1) per_cu = 1;
        grid_blocks = cus * per_cu;
    }
    (void)hipMemsetAsync((unsigned char*)d_ws + WS_BAR, 0, XCD_BAR_WORDS * 4, stream);
    void* args[] = {&p};
    hipError_t e = hipLaunchCooperativeKernel((void*)fwd_mega, dim3(grid_blocks), dim3(NTHREADS), args, LDS_BYTES, stream);
    if (e != hipSuccess) fprintf(stderr, "cooperative launch failed: %s (grid %d)\n", hipGetErrorString(e), grid_blocks);
#else
    const int G = 1024;
    static bool attr_done = false;
#define LAUNCH(PH) do { if (!attr_done) (void)hipFuncSetAttribute((const void*)fwd_phase<PH>, hipFuncAttributeMaxDynamicSharedMemorySize, LDS_BYTES); hipLaunchKernelGGL(fwd_phase<PH>, dim3(G), dim3(NTHREADS), LDS_BYTES, stream, p); } while (0)
    LAUNCH(0); LAUNCH(1); LAUNCH(2); LAUNCH(3); LAUNCH(4); LAUNCH(5); LAUNCH(6); LAUNCH(7); LAUNCH(8);
    attr_done = true;
#undef LAUNCH
#endif
}
```

```cpp
#include <hip/hip_runtime.h>
#include <hip/hip_cooperative_groups.h>
#include <cstdio>
#include <cstdint>
namespace cg = cooperative_groups;

#ifndef ONE_LAUNCH
#define ONE_LAUNCH 1
#endif

typedef unsigned short bf16_t;
typedef short bf16x8 __attribute__((ext_vector_type(8)));
typedef float f32x4 __attribute__((ext_vector_type(4)));
typedef unsigned u32x2 __attribute__((ext_vector_type(2)));
typedef unsigned u32x4 __attribute__((ext_vector_type(4)));

constexpr int NBATCH = 4, SEQ = 4096, DM = 1024, MTOK = NBATCH * SEQ;
constexpr int NMEM = 256, MMEM = NBATCH * NMEM;
constexpr int WIN_COLS = 11352;
constexpr float EPS = 1e-6f;
constexpr int NTHREADS = 512, NWAVES = 8;
constexpr int LDU = 6400;
constexpr int C_H = 0, C_GV = 1024, C_DQ = 2048, C_XQ = 3072, C_GQ = 4096, C_GK = 4608, C_DK = 5120, C_DV = 5376, C_IQ = 5632, C_IK = 6144, C_GA = 6208, C_IW = 6224;
constexpr int C_SM = 4096;
constexpr int C_MG = 5120;
constexpr int N1 = 5376;
constexpr int WT_Z = 5376, WT_G = 8448, WT_ROWS = 11520;
constexpr size_t MiB = 1u << 20;
constexpr size_t WS_WTALL = 0, WS_WTMKV = 23 * MiB, WS_WTGO = 27 * MiB, WS_WTDO = 29 * MiB, WS_WTXO = 31 * MiB, WS_WTO = 33 * MiB;
constexpr size_t WS_MKV = 35 * MiB, WS_MASK = 39 * MiB  , WS_U = 48 * MiB, WS_END = 248 * MiB;
static_assert(WS_U + (size_t)MTOK * LDU * 2 == WS_END && WS_END <= 256 * MiB, "ws map");

struct Params {
    const float *x, *mem, *g_pre, *g_post, *g_mem, *w_in, *w_a_up, *b_a, *g_gla, *rel_bias, *w_mem_kv, *w_gla_out, *w_dsa_out, *w_x_out, *w_o;
    float* out; unsigned char* ws;
};

__device__ const unsigned char T5B[128] = {0, 1, 2, 3, 4, 5, 6, 7, 8, 9, 10, 11, 12, 13, 14, 15, 16, 16, 16, 17, 17, 18, 18, 18, 19, 19, 19, 20, 20, 20, 20, 21, 21, 21, 21, 22, 22, 22, 22, 22, 23, 23, 23, 23, 23, 23, 24, 24, 24, 24, 24, 24, 25, 25, 25, 25, 25, 25, 25, 26, 26, 26, 26, 26, 26, 26, 26, 27, 27, 27, 27, 27, 27, 27, 27, 27, 27, 28, 28, 28, 28, 28, 28, 28, 28, 28, 28, 29, 29, 29, 29, 29, 29, 29, 29, 29, 29, 29, 29, 30, 30, 30, 30, 30, 30, 30, 30, 30, 30, 30, 30, 30, 30, 31, 31, 31, 31, 31, 31, 31, 31, 31, 31, 31, 31, 31, 31, 31};

__device__ __forceinline__ float bf2f(bf16_t b) { return __uint_as_float((unsigned)b << 16); }
__device__ __forceinline__ unsigned f2bf(float f) { unsigned u = __float_as_uint(f); return (u + 0x7fffu + ((u >> 16) & 1u)) >> 16; }
typedef float f32x2_t_ __attribute__((ext_vector_type(2))); typedef __bf16 bf16x2_t_ __attribute__((ext_vector_type(2)));
__device__ __forceinline__ unsigned pk2(float lo, float hi) { f32x2_t_ v = {lo, hi}; bf16x2_t_ b = __builtin_convertvector(v, bf16x2_t_); return __builtin_bit_cast(unsigned, b); }
__device__ __forceinline__ float wave_sum(float v) {
#pragma unroll
    for (int o = 1; o < 64; o <<= 1) v += __shfl_xor(v, o);
    return v;
}
__device__ __forceinline__ float wave_max(float v) {
#pragma unroll
    for (int o = 1; o < 64; o <<= 1) v = fmaxf(v, __shfl_xor(v, o));
    return v;
}
__device__ __forceinline__ int opaque_tid() { int t = threadIdx.x; asm volatile("" : "+v"(t)); return t; }
__device__ __forceinline__ bf16_t* Uptr(const Params& p) { return (bf16_t*)(p.ws + WS_U); }

__device__ __forceinline__ int win_src_col(int r) {
    if (r < 1024) return 1024 + r;
    if (r < 2048) return 3088 + (r - 1024);
    if (r < 3072) return 6232 + (r - 2048);
    if (r < 3584) return r - 3072;
    if (r < 4096) return 512 + (r - 3584);
    if (r < 4352) return 4112 + (r - 4096);
    if (r < 4608) return 4368 + (r - 4352);
    if (r < 5120) return 4624 + (r - 4608);
    if (r < 5184) return 5136 + (r - 5120);
    if (r < 5200) return 2048 + (r - 5184);
    if (r < 5208) return 5200 + (r - 5200);
    if (r < 5376) return -1;
    if (r < 6400) return 2064 + (r - 5376);
    if (r < 7424) return 5208 + (r - 6400);
    if (r < 8448) return 7256 + (r - 7424);
    return 8280 + (r - 8448);
}

template <bool MAP>
__device__ __forceinline__ void transpose_item(const float* W, int ldw, int K, bf16_t* WT, float* scr  , int item, int lane) {
    const int nkb = K / 64, nb = item / nkb, kb = item % nkb, k0 = 64 * kb, n0 = 64 * nb;
    const int n4 = n0 + 4 * (lane & 15);
    const int c = MAP ? win_src_col(n4) : n4;
#pragma unroll 8
    for (int i = 0; i < 16; ++i) { const int kk = 4 * i + (lane >> 4);
        const f32x4 v = (c >= 0) ? *(const f32x4*)(W + (size_t)(k0 + kk) * ldw + c) : (f32x4){0.f, 0.f, 0.f, 0.f};
        *(f32x4*)(scr + kk * 68 + 4 * (lane & 15)) = v; }
    asm volatile("s_waitcnt lgkmcnt(0)" ::: "memory");
#pragma unroll
    for (int c8 = 0; c8 < 8; ++c8) { const float* s_ = scr + (8 * c8) * 68 + lane;
        u32x4 o; o.x = pk2(s_[0 * 68], s_[1 * 68]); o.y = pk2(s_[2 * 68], s_[3 * 68]); o.z = pk2(s_[4 * 68], s_[5 * 68]); o.w = pk2(s_[6 * 68], s_[7 * 68]);
        *(u32x4*)(WT + (size_t)(n0 + lane) * K + k0 + 8 * c8) = o; }
    asm volatile("s_waitcnt lgkmcnt(0)" ::: "memory");
}
__device__ __forceinline__ void rms_row_to_bf16(const float* xrow, const float* g, bf16_t* orow, int lane) {
    const f32x4* xr = (const f32x4*)xrow + lane; const f32x4* gr = (const f32x4*)g + lane;
    f32x4 v[4]; float s = 0.f;
#pragma unroll
    for (int j = 0; j < 4; ++j) { v[j] = xr[64 * j]; s += (v[j].x * v[j].x + v[j].y * v[j].y) + (v[j].z * v[j].z + v[j].w * v[j].w); }
    const float rstd = 1.f / sqrtf(wave_sum(s) * (1.f / DM) + EPS);
    unsigned long long* o8 = (unsigned long long*)orow + lane;
#pragma unroll
    for (int j = 0; j < 4; ++j) { const f32x4 gg = gr[64 * j];
        o8[64 * j] = (unsigned long long)pk2(v[j].x * rstd * gg.x, v[j].y * rstd * gg.y) | ((unsigned long long)pk2(v[j].z * rstd * gg.z, v[j].w * rstd * gg.w) << 32); }
}
__device__ void phase_prep(const Params& p, int bid, int nb, unsigned char* lds, int part) {
    const int tid = threadIdx.x, lane = tid & 63, wave = tid >> 6;
    float* scr = (float*)lds + wave * (64 * 68);
    const int gw = bid * NWAVES + wave, NGW = nb * NWAVES;
    constexpr int I_G1 = (N1 / 64) * (DM / 64), I_ALL = (WT_ROWS / 64) * (DM / 64), I_MKV = (2048 / 64) * (DM / 64), I_SQ = (DM / 64) * (DM / 64);
    if (part == 0) {
        for (int it = gw; it < I_G1 + I_MKV; it += NGW) {
            if (it < I_G1) transpose_item<true>(p.w_in, WIN_COLS, DM, (bf16_t*)(p.ws + WS_WTALL), scr, it, lane);
            else transpose_item<false>(p.w_mem_kv, 2048, DM, (bf16_t*)(p.ws + WS_WTMKV), scr, it - I_G1, lane);
        }
        bf16_t* U = Uptr(p);
        for (int m = gw; m < MTOK + MMEM; m += NGW) {
            if (m < MTOK) rms_row_to_bf16(p.x + (size_t)m * DM, p.g_pre, U + (size_t)m * LDU + C_H, lane);
            else rms_row_to_bf16(p.mem + (size_t)(m - MTOK) * DM, p.g_mem, (bf16_t*)p.out + (size_t)(m - MTOK) * LDU, lane);
        }
    } else {
        for (int it = gw; it < (I_ALL - I_G1) + 4 * I_SQ; it += NGW) {
            int r = it;
            if (r < I_ALL - I_G1) { transpose_item<true>(p.w_in, WIN_COLS, DM, (bf16_t*)(p.ws + WS_WTALL), scr, I_G1 + r, lane); continue; } r -= I_ALL - I_G1;
            if (r < I_SQ) { transpose_item<false>(p.w_gla_out, DM, DM, (bf16_t*)(p.ws + WS_WTGO), scr, r, lane); continue; } r -= I_SQ;
            if (r < I_SQ) { transpose_item<false>(p.w_dsa_out, DM, DM, (bf16_t*)(p.ws + WS_WTDO), scr, r, lane); continue; } r -= I_SQ;
            if (r < I_SQ) { transpose_item<false>(p.w_x_out, DM, DM, (bf16_t*)(p.ws + WS_WTXO), scr, r, lane); continue; } r -= I_SQ;
            transpose_item<false>(p.w_o, DM, DM, (bf16_t*)(p.ws + WS_WTO), scr, r, lane);
        }
    }
}

__device__ __forceinline__ void ld8bf(const bf16_t* q, f32x4& a, f32x4& b) { const u32x4 w = *(const u32x4*)q; a[0] = __uint_as_float(w.x << 16); a[1] = __uint_as_float(w.x & 0xffff0000u); a[2] = __uint_as_float(w.y << 16); a[3] = __uint_as_float(w.y & 0xffff0000u);
    b[0] = __uint_as_float(w.z << 16); b[1] = __uint_as_float(w.z & 0xffff0000u); b[2] = __uint_as_float(w.w << 16); b[3] = __uint_as_float(w.w & 0xffff0000u); }
__device__ __forceinline__ void st8bf(bf16_t* q, f32x4 a, f32x4 b) { u32x4 w; w.x = pk2(a[0], a[1]); w.y = pk2(a[2], a[3]); w.z = pk2(b[0], b[1]); w.w = pk2(b[2], b[3]); *(u32x4*)q = w; }
struct OpStoreBf16 { bf16_t* C; int ldc, coff;
    __device__ __forceinline__ void op8(int r, int c, f32x4 a, f32x4 b) const { st8bf(C + (size_t)r * ldc + coff + c, a, b); }
    __device__ __forceinline__ void operator()(int r, int c, f32x4 v) const { u32x2 w; w.x = pk2(v[0], v[1]); w.y = pk2(v[2], v[3]); *(u32x2*)(C + (size_t)r * ldc + coff + c) = w; } };
__device__ __forceinline__ f32x4 ld4bf(const bf16_t* q) { const u32x2 w = *(const u32x2*)q; f32x4 o; o[0] = __uint_as_float(w.x << 16); o[1] = __uint_as_float(w.x & 0xffff0000u); o[2] = __uint_as_float(w.y << 16); o[3] = __uint_as_float(w.y & 0xffff0000u); return o; }
__device__ __forceinline__ void st4bf(bf16_t* q, f32x4 v) { u32x2 w; w.x = pk2(v[0], v[1]); w.y = pk2(v[2], v[3]); *(u32x2*)q = w; }
__device__ __forceinline__ float sigmoidf_(float x) { return __builtin_amdgcn_rcpf(1.f + __builtin_amdgcn_exp2f(-1.4426950408889634f * x)); }
struct OpZGate { bf16_t* U; bool dry;
    __device__ __forceinline__ void op8(int r, int c, f32x4 z0, f32x4 z1) const { bf16_t* q = U + (size_t)r * LDU + 1024 + c; f32x4 o0, o1; ld8bf(q, o0, o1);
#pragma unroll
        for (int i = 0; i < 4; ++i) { o0[i] = o0[i] * z0[i] * sigmoidf_(z0[i]); o1[i] = o1[i] * z1[i] * sigmoidf_(z1[i]); }
        if (!dry) st8bf(q, o0, o1); }
    __device__ __forceinline__ void operator()(int r, int c, f32x4 z) const { bf16_t* q = U + (size_t)r * LDU + 1024 + c; f32x4 o = ld4bf(q);
#pragma unroll
        for (int i = 0; i < 4; ++i) o[i] = o[i] * z[i] * sigmoidf_(z[i]);
        if (!dry) st4bf(q, o); } };
struct OpSig { bf16_t* S2; bf16_t* U;
    __device__ __forceinline__ void op8(int r, int c, f32x4 g0, f32x4 g1) const { f32x4 s0, s1;
#pragma unroll
        for (int i = 0; i < 4; ++i) { s0[i] = sigmoidf_(g0[i]); s1[i] = sigmoidf_(g1[i]); }
        bf16_t* q = (c < 2048) ? S2 + (size_t)r * 2048 + c : U + (size_t)r * LDU + C_SM + (c - 2048);
        st8bf(q, s0, s1); }
    __device__ __forceinline__ void operator()(int r, int c, f32x4 g) const { f32x4 s;
#pragma unroll
        for (int i = 0; i < 4; ++i) s[i] = sigmoidf_(g[i]);
        bf16_t* q = (c < 2048) ? S2 + (size_t)r * 2048 + c : U + (size_t)r * LDU + C_SM + (c - 2048);
        st4bf(q, s); } };
template <int B> struct OpMerge { const bf16_t* S2; bf16_t* U;
    __device__ __forceinline__ void op8(int r, int c, f32x4 v0, f32x4 v1) const {
        const bf16_t* sq = (B == 0) ? S2 + (size_t)r * 2048 + c : (B == 1) ? S2 + (size_t)r * 2048 + 1024 + c : U + (size_t)r * LDU + C_SM + c;
        f32x4 s0, s1; ld8bf(sq, s0, s1); bf16_t* q = U + (size_t)r * LDU + C_MG + c;
        f32x4 o0 = s0 * v0, o1 = s1 * v1; if (B != 0) { f32x4 m0, m1; ld8bf(q, m0, m1); o0 = o0 + m0; o1 = o1 + m1; }
        st8bf(q, o0, o1); }
    __device__ __forceinline__ void operator()(int r, int c, f32x4 v) const {
        const bf16_t* sq = (B == 0) ? S2 + (size_t)r * 2048 + c : (B == 1) ? S2 + (size_t)r * 2048 + 1024 + c : U + (size_t)r * LDU + C_SM + c;
        const f32x4 s = ld4bf(sq); bf16_t* q = U + (size_t)r * LDU + C_MG + c;
        f32x4 o = s * v; if (B != 0) o = o + ld4bf(q);
        st4bf(q, o); } };
struct OpOutF32 { float* O;
    __device__ __forceinline__ void operator()(int r, int c, f32x4 v) const { *(f32x4*)(O + (size_t)r * DM + c) = v; } };

template <class Op>
__device__ void gemm_simple(const bf16_t* A, int lda, const bf16_t* Bt, int M, int N, int K, const Op& op, int bid, int nb) {
    const int tid = threadIdx.x, lane = tid & 63, wave = tid >> 6, fr = lane & 15, fq = lane >> 4;
    const int ntn = N / 64, nitems = (M / 128) * ntn;
    for (int it = bid; it < nitems; it += nb) {
        const int tm = it / ntn, tn = it % ntn;
        const int row = tm * 128 + wave * 16 + fr;
        const bf16_t* ap = A + (size_t)row * lda + fq * 8;
        const bf16_t* bp = Bt + (size_t)(tn * 64 + fr) * K + fq * 8;
        f32x4 acc[4];
#pragma unroll
        for (int n = 0; n < 4; ++n) acc[n] = (f32x4){0.f, 0.f, 0.f, 0.f};
#pragma unroll 2
        for (int k0 = 0; k0 < K; k0 += 32) {
            const bf16x8 a = *(const bf16x8*)(ap + k0);
#pragma unroll
            for (int n = 0; n < 4; ++n) { const bf16x8 b = *(const bf16x8*)(bp + (size_t)n * 16 * K + k0); acc[n] = __builtin_amdgcn_mfma_f32_16x16x32_bf16(b, a, acc[n], 0, 0, 0); }
        }
#pragma unroll
        for (int n = 0; n < 4; ++n) op(row, tn * 64 + n * 16 + fq * 4, acc[n]);
    }
}


namespace pg8 {
#define PG8_LAS __attribute__((address_space(3)))
constexpr int BM = 256, BK = 64, HALF = 128, HTB = HALF * BK * 2  , STAGE_BYTES = 8 * HTB, NXCD = 8, WGM = 8;
__host__ __device__ __forceinline__ int lds_byte(int r, int c) { const int st = (r >> 4) * 2 + (c >> 5), rr = r & 15, cc = c & 31, ob = rr * 64 + cc * 2; return st * 1024 + (ob ^ (((ob >> 9) & 1) << 5)); }
__host__ __device__ __forceinline__ void stage_rc(int b, int& R, int& C) { const int st = b / 1024, sb = b % 1024, swz = sb ^ (((sb >> 9) & 1) << 5); R = (st >> 1) * 16 + swz / 64; C = (st & 1) * 32 + (swz % 64) / 2; }
__host__ __device__ __forceinline__ int perm32(int rho) { const int n = rho >> 4, i = rho & 15; return 8 * (i >> 2) + 4 * n + (i & 3); }
struct Unit { int pm, pn, kind; const char* a; const char* b; };
struct Job { const bf16_t* A; const bf16_t* Bt; int nM, nN; };
struct Sched {
    Job j[2]; int njobs, rep, G, c, lda; long astride, bstride;
    __device__ __forceinline__ bool next(int i, Unit& u) const {
        const int ti = i / rep, v = i - ti * rep; long L = (long)ti * G + c;
#pragma unroll
        for (int q = 0; q < 2; ++q) { if (q < njobs) { const int nwg = j[q].nM * j[q].nN;
            if (L < nwg) { int wgid = (int)L; { const int qq = nwg / NXCD, r = nwg % NXCD, xcd = wgid % NXCD, off = wgid / NXCD; wgid = (xcd < r ? xcd * (qq + 1) : r * (qq + 1) + (xcd - r) * qq) + off; }
                const int nig = WGM * j[q].nN, gid = wgid / nig, fm = gid * WGM, gsz = (j[q].nM - fm) < WGM ? (j[q].nM - fm) : WGM;
                u.pm = fm + ((wgid % nig) % gsz); u.pn = (wgid % nig) / gsz; u.kind = 4 * q + v;
                u.a = (const char*)(j[q].A + (size_t)u.pm * BM * lda + (size_t)v * astride); u.b = (const char*)(j[q].Bt + (size_t)u.pn * BM * DM + (size_t)v * bstride); return true; }
            L -= nwg; } }
        return false;
    }
};
template <class Sel> struct Epi { static constexpr bool PERM = true, CHAIN = Sel::CHAIN; Sel sel;
    __device__ __forceinline__ void operator()(f32x4 (&acc)[2][2][4][2], const Unit& u, int wr, int wc, int fr, int fq) const {
#pragma unroll
        for (int ai = 0; ai < 2; ++ai)
#pragma unroll
            for (int m = 0; m < 4; ++m) { const int row = u.pm * BM + ai * HALF + wr * 64 + m * 16 + fr;
#pragma unroll
                for (int bj = 0; bj < 2; ++bj) { const int col = u.pn * BM + bj * HALF + wc * 32 + 8 * fq; sel(u.kind, row, col, acc[ai][bj][m][0], acc[ai][bj][m][1]); } }
    }
};
template <class EpiT, bool ALIGN_EPI>
__device__ __forceinline__ void gemm_phase(PG8_LAS unsigned char* lds, const Sched& S, const EpiT& E) {
    int tid_ = threadIdx.x; asm volatile("" : "+v"(tid_));
    const int tid = tid_, wid = __builtin_amdgcn_readfirstlane(tid >> 6), lane = tid & 63, wr = wid >> 2, wc = wid & 3, fr = lane & 15, fq = lane >> 4;
    constexpr int K = DM, nt = K / BK; const int lda = S.lda;
    unsigned voffA[2], voffB[2];
#pragma unroll
    for (int i = 0; i < 2; ++i) { int R, C; stage_rc(tid * 16 + i * 8192, R, C); const int Rb = EpiT::PERM ? ((R & ~31) + perm32(R & 31)) : R;
        voffA[i] = (unsigned)(R * lda + C) * 2u; voffB[i] = (unsigned)(Rb * K + C) * 2u; }
    const size_t kstep = (size_t)(BK * 2);
    const size_t hstepA = (size_t)HALF * lda * 2, hstepB = (size_t)HALF * K * 2;
    const unsigned ldsw = (unsigned)wid * 1024u;
    const int aoff = lds_byte(wr * 64 + fr, fq * 8), boff = lds_byte(wc * 32 + fr, fq * 8);
#define PG8_SA(b, h) (((b) * 2 + (h)) * HTB)
#define PG8_SB(b, h) ((4 + (b) * 2 + (h)) * HTB)
#define PG8_STAGE(bufoff, gbase, voff) do { _Pragma("unroll") for (int _i = 0; _i < 2; ++_i) \
        __builtin_amdgcn_global_load_lds((const unsigned*)((const char*)(gbase) + (voff)[_i]), (PG8_LAS unsigned*)(lds + (bufoff) + ldsw + _i * 8192), 16, 0, 0); } while (0)
#define PG8_LDA(dst, b, h) do { _Pragma("unroll") for (int m = 0; m < 4; ++m) _Pragma("unroll") for (int k = 0; k < 2; ++k) dst[m][k] = *(const PG8_LAS bf16x8*)(lds + PG8_SA(b, h) + aoff + m * 2048 + k * 1024); } while (0)
#define PG8_LDB(dst, b, h) do { _Pragma("unroll") for (int n = 0; n < 2; ++n) _Pragma("unroll") for (int k = 0; k < 2; ++k) dst[n][k] = *(const PG8_LAS bf16x8*)(lds + PG8_SB(b, h) + boff + n * 2048 + k * 1024); } while (0)
#define PG8_MMA(ai, bj, At, Bt) do { __builtin_amdgcn_s_setprio(1); _Pragma("unroll") for (int m = 0; m < 4; ++m) _Pragma("unroll") for (int n = 0; n < 2; ++n) _Pragma("unroll") for (int k = 0; k < 2; ++k) \
        acc[ai][bj][m][n] = __builtin_amdgcn_mfma_f32_16x16x32_bf16(Bt[n][k], At[m][k], acc[ai][bj][m][n], 0, 0, 0); __builtin_amdgcn_s_setprio(0); } while (0)
#define PG8_WAIT_V(n) asm volatile("s_waitcnt vmcnt(" #n ")" ::: "memory")
#define PG8_WAIT_L(n) asm volatile("s_waitcnt lgkmcnt(" #n ")" ::: "memory")
#define PG8_BAR __builtin_amdgcn_s_barrier()
#define PG8_SCHED __builtin_amdgcn_sched_barrier(0)
    Unit cur, nxt; int ui = 0;
    if (!S.next(0, cur)) return;
    f32x4 acc[2][2][4][2];
#pragma unroll
    for (int a = 0; a < 2; ++a)
#pragma unroll
        for (int b = 0; b < 2; ++b)
#pragma unroll
            for (int m = 0; m < 4; ++m)
#pragma unroll
                for (int n = 0; n < 2; ++n) acc[a][b][m][n] = (f32x4){0.f, 0.f, 0.f, 0.f};
    bf16x8 At[4][2], B0[2][2], B1[2][2];
    const char* cA = cur.a; const char* cB = cur.b;
    PG8_STAGE(PG8_SB(0, 0), cB, voffB); PG8_STAGE(PG8_SB(0, 1), cB + hstepB, voffB); PG8_STAGE(PG8_SA(0, 0), cA, voffA); PG8_STAGE(PG8_SA(0, 1), cA + hstepA, voffA);
    if (wr == 1) PG8_BAR;
    PG8_WAIT_V(2); PG8_BAR;
    PG8_STAGE(PG8_SB(1, 0), cB + kstep, voffB); PG8_STAGE(PG8_SA(1, 0), cA + kstep, voffA); PG8_STAGE(PG8_SB(1, 1), cB + hstepB + kstep, voffB);
    PG8_WAIT_V(6); PG8_BAR;
    for (;;) {
        const bool has_next = S.next(ui + 1, nxt);
        const char* nA = has_next ? nxt.a : cA; const char* nB = has_next ? nxt.b : cB;
        for (int t = 0; t < nt; t += 2) {
            const bool last = (t == nt - 2);
            const char* a1 = cA + (size_t)(t + 1) * kstep;
            const char* a2 = last ? nA : cA + (size_t)(t + 2) * kstep; const char* b2 = last ? nB : cB + (size_t)(t + 2) * kstep;
            const char* a3 = a2 + kstep; const char* b3 = b2 + kstep;
            PG8_LDB(B0, 0, 0); PG8_LDB(B1, 0, 1); PG8_SCHED; PG8_LDA(At, 0, 0); PG8_STAGE(PG8_SA(1, 1), a1 + hstepA, voffA);
            PG8_WAIT_V(8); PG8_WAIT_L(0); PG8_BAR; PG8_MMA(0, 0, At, B0); PG8_MMA(0, 1, At, B1); PG8_BAR; PG8_SCHED;
            PG8_LDA(At, 0, 1); PG8_STAGE(PG8_SB(0, 0), b2, voffB); PG8_STAGE(PG8_SB(0, 1), b2 + hstepB, voffB); PG8_STAGE(PG8_SA(0, 0), a2, voffA);
            PG8_WAIT_V(8); PG8_WAIT_L(0); PG8_BAR; PG8_MMA(1, 0, At, B0); PG8_MMA(1, 1, At, B1); PG8_BAR; PG8_SCHED;
            PG8_LDB(B0, 1, 0); PG8_LDB(B1, 1, 1); PG8_SCHED; PG8_LDA(At, 1, 0); PG8_STAGE(PG8_SA(0, 1), a2 + hstepA, voffA);
            PG8_WAIT_V(8); PG8_WAIT_L(0); PG8_BAR; PG8_MMA(0, 0, At, B0); PG8_MMA(0, 1, At, B1); PG8_BAR; PG8_SCHED;
            PG8_LDA(At, 1, 1); PG8_STAGE(PG8_SB(1, 0), b3, voffB); PG8_STAGE(PG8_SB(1, 1), b3 + hstepB, voffB); PG8_STAGE(PG8_SA(1, 0), a3, voffA);
            PG8_WAIT_V(8); PG8_WAIT_L(0); PG8_BAR; PG8_MMA(1, 0, At, B0); PG8_MMA(1, 1, At, B1); PG8_BAR; PG8_SCHED;
        }
        if constexpr (ALIGN_EPI) { if (wr == 0) PG8_BAR; }
        E(acc, cur, wr, wc, fr, fq);
        if (!has_next) break;
        if (!(EpiT::CHAIN && (nxt.kind & 3) != 0)) {
#pragma unroll
        for (int a = 0; a < 2; ++a)
#pragma unroll
            for (int b = 0; b < 2; ++b)
#pragma unroll
                for (int m = 0; m < 4; ++m)
#pragma unroll
                    for (int n = 0; n < 2; ++n) acc[a][b][m][n] = (f32x4){0.f, 0.f, 0.f, 0.f};
        }
        cur = nxt; cA = nA; cB = nB; ++ui;
        if constexpr (ALIGN_EPI) { if (wr == 1) PG8_BAR; }
    }
    PG8_WAIT_V(0);
    if constexpr (!ALIGN_EPI) { if (wr == 0) PG8_BAR; }
    PG8_BAR;
#undef PG8_SA
#undef PG8_SB
#undef PG8_STAGE
#undef PG8_LDA
#undef PG8_LDB
#undef PG8_MMA
#undef PG8_WAIT_V
#undef PG8_WAIT_L
#undef PG8_BAR
#undef PG8_SCHED
}
}
struct SelP1 { static constexpr bool CHAIN = false; OpStoreBf16 o1, o2; __device__ __forceinline__ void operator()(int kind, int r, int c, f32x4& v0, f32x4& v1) const { if (kind == 0) o1.op8(r, c, v0, v1); else o2.op8(r, c, v0, v1); } };
struct SelP5 { static constexpr bool CHAIN = false; OpZGate oz; OpSig os; __device__ __forceinline__ void operator()(int kind, int r, int c, f32x4& v0, f32x4& v1) const { if (kind == 0) oz.op8(r, c, v0, v1); else os.op8(r, c, v0, v1); } };
struct SelP6 { static constexpr bool CHAIN = true; const bf16_t* S2; bf16_t* U;
    __device__ __forceinline__ const bf16_t* sp(int b, int r, int c) const { return (b == 0) ? S2 + (size_t)r * 2048 + c : (b == 1) ? S2 + (size_t)r * 2048 + 1024 + c : U + (size_t)r * LDU + C_SM + c; }
    __device__ __forceinline__ void operator()(int kind, int r, int c, f32x4& v0, f32x4& v1) const {
        if (kind < 2) { f32x4 a0, a1, b0, b1; ld8bf(sp(kind, r, c), a0, a1); ld8bf(sp(kind + 1, r, c), b0, b1);
#pragma unroll
            for (int i = 0; i < 4; ++i) { v0[i] *= fmaxf(a0[i], 1e-30f) * __builtin_amdgcn_rcpf(fmaxf(b0[i], 1e-30f)); v1[i] *= fmaxf(a1[i], 1e-30f) * __builtin_amdgcn_rcpf(fmaxf(b1[i], 1e-30f)); }
        } else { f32x4 a0, a1; ld8bf(sp(2, r, c), a0, a1);
#pragma unroll
            for (int i = 0; i < 4; ++i) { a0[i] = v0[i] * fmaxf(a0[i], 1e-30f); a1[i] = v1[i] * fmaxf(a1[i], 1e-30f); }
            st8bf(U + (size_t)r * LDU + C_MG + c, a0, a1); } } };
struct SelP7 { static constexpr bool CHAIN = false; OpStoreBf16 oo; __device__ __forceinline__ void operator()(int kind, int r, int c, f32x4& v0, f32x4& v1) const { oo.op8(r, c, v0, v1); } };

__device__ void phase_gla_rec(const Params& p, float* oraw, int bid, int nb, unsigned char* lds) {
    constexpr int CH = 32, RS = 136;
    float* As = (float*)lds; float* Ks = As + CH * RS; float* Qs = Ks + CH * RS; float* Vs = Qs + CH * RS;
    const bf16_t* U = Uptr(p);
    const int tid = threadIdx.x, cl = tid >> 3, ds = tid & 7;
    for (int it = bid; it < 64; it += nb) {
        const int b = it >> 4, h = (it >> 2) & 3, q4 = it & 3;
        float s[16];
#pragma unroll
        for (int i = 0; i < 16; ++i) s[i] = 0.f;
        for (int t0 = 0; t0 < SEQ; t0 += CH) {
            __syncthreads();
            for (int e = tid; e < CH * 128; e += NTHREADS) {
                const int i = e >> 7, d = e & 127; const size_t m = (size_t)b * SEQ + t0 + i; const bf16_t* ur = U + m * LDU;
                float x = p.b_a[h * 128 + d];
#pragma unroll
                for (int r = 0; r < 16; ++r) x += bf2f(ur[C_GA + r]) * p.w_a_up[r * 512 + h * 128 + d];
                const float ls = fminf(x, 0.f) - log1pf(__expf(-fabsf(x)));
                const int o = i * RS + (d >> 4) * 17 + (d & 15);
                As[o] = __expf(ls * (1.f / 16.f));
                Ks[o] = bf2f(ur[C_GK + h * 128 + d]);
                Qs[o] = bf2f(ur[C_GQ + h * 128 + d]) * 0.08838834764831845f;
            }
            for (int e = tid; e < CH * 64; e += NTHREADS) { const int i = e >> 6, c = e & 63; Vs[e] = bf2f(U[((size_t)b * SEQ + t0 + i) * LDU + C_GV + h * 256 + q4 * 64 + c]); }
            __syncthreads();
            for (int i = 0; i < CH; ++i) {
                const float v = Vs[i * 64 + cl]; const float* a = As + i * RS + ds * 17; const float* k = Ks + i * RS + ds * 17; const float* q = Qs + i * RS + ds * 17;
                float o = 0.f;
#pragma unroll
                for (int dd = 0; dd < 16; ++dd) { s[dd] = a[dd] * s[dd] + k[dd] * v; o += q[dd] * s[dd]; }
                o += __shfl_xor(o, 1); o += __shfl_xor(o, 2); o += __shfl_xor(o, 4);
                if (ds == 0) oraw[((size_t)b * SEQ + t0 + i) * DM + h * 256 + q4 * 64 + cl] = o;
            }
        }
    }
}
__device__ void phase_gla_norm(const Params& p, const float* oraw, int bid, int nb) {
    bf16_t* U = Uptr(p);
    const int lane = threadIdx.x & 63, wave = threadIdx.x >> 6;
    for (int it = bid * NWAVES + wave; it < MTOK * 4; it += nb * NWAVES) {
        const int m = it >> 2, h = it & 3;
        const f32x4 v = *(const f32x4*)(oraw + (size_t)m * DM + h * 256 + lane * 4);
        const float ss = wave_sum((v[0] * v[0] + v[1] * v[1]) + (v[2] * v[2] + v[3] * v[3]));
        const float rstd = 1.f / sqrtf(ss * (1.f / 256.f) + EPS);
        const f32x4 g = *(const f32x4*)(p.g_gla + lane * 4);
        st4bf(U + (size_t)m * LDU + C_GV + h * 256 + lane * 4, v * g * rstd);
    }
}

__device__ __forceinline__ unsigned fkey(float f) { const unsigned u = __float_as_uint(f); return (u & 0x80000000u) ? ~u : (u | 0x80000000u); }
__device__ void phase_dsa_ref(const Params& p, int bid, int nb, unsigned char* lds) {
    float* sc = (float*)lds;
    float* iqs = sc + 4096;
    float* qs = iqs + 512;
    float* lg = qs + 1024;
    int* sel = (int*)(lg + 2048);
    unsigned* hist = (unsigned*)(sel + 256);
    unsigned* cnt = hist + 256;
    int* misc = (int*)(cnt + 512);
    float* ws8 = (float*)(misc + 8);
    bf16_t* U = Uptr(p);
    const int tid = threadIdx.x, lane = tid & 63, wave = tid >> 6;
    for (int it = bid; it < MTOK; it += nb) {
        const int b = it / SEQ, t = it % SEQ; const size_t m = (size_t)it; const bf16_t* ur = U + m * LDU; const bf16_t* ub = U + (size_t)b * SEQ * LDU;
        __syncthreads();
        iqs[tid] = bf2f(ur[C_IQ + tid]);
        qs[tid] = bf2f(ur[C_DQ + tid]) * 0.08838834764831845f; qs[tid + 512] = bf2f(ur[C_DQ + 512 + tid]) * 0.08838834764831845f;
        if (tid < 8) ws8[tid] = bf2f(ur[C_IW + tid]);
        if (tid == 0) misc[0] = 0;
        __syncthreads();
        const int n = t + 1, ksel = n < 256 ? n : 256;
#pragma unroll 1
        for (int j = 0; j < 8; ++j) {
            const int s = tid * 8 + j;
            if (s < n) {
                const bf16_t* kr = ub + (size_t)s * LDU + C_IK;
                float acc[8];
#pragma unroll
                for (int h = 0; h < 8; ++h) acc[h] = 0.f;
#pragma unroll 1
                for (int d0 = 0; d0 < 64; d0 += 8) {
                    const bf16x8 kv = *(const bf16x8*)(kr + d0);
#pragma unroll
                    for (int dd = 0; dd < 8; ++dd) { const float kd = bf2f((bf16_t)kv[dd]);
#pragma unroll
                        for (int h = 0; h < 8; ++h) acc[h] += iqs[h * 64 + d0 + dd] * kd; }
                }
                float score = 0.f;
#pragma unroll
                for (int h = 0; h < 8; ++h) score += ws8[h] * fmaxf(acc[h], 0.f);
                sc[s] = score;
            }
        }
        __syncthreads();
        if (n <= 256) { if (tid < n) sel[tid] = tid; }
        else {
            unsigned prefix = 0u, mask = 0u; int need = ksel;
            for (int pass = 3; pass >= 0; --pass) {
                const int shift = 8 * pass;
                if (tid < 256) hist[tid] = 0u;
                __syncthreads();
#pragma unroll 1
                for (int j = 0; j < 8; ++j) { const int s = tid * 8 + j; if (s < n) { const unsigned u = fkey(sc[s]); if ((u & mask) == prefix) atomicAdd(&hist[(u >> shift) & 255u], 1u); } }
                __syncthreads();
                if (tid == 0) { int cum = 0, d = 255; for (; d > 0; --d) { const int c = (int)hist[d]; if (cum + c >= need) break; cum += c; } misc[1] = d; misc[2] = need - cum; }
                __syncthreads();
                prefix |= (unsigned)misc[1] << shift; mask |= 0xFFu << shift; need = misc[2];
                __syncthreads();
            }
            unsigned myeq = 0u;
#pragma unroll 1
            for (int j = 0; j < 8; ++j) { const int s = tid * 8 + j; if (s < n && fkey(sc[s]) == prefix) ++myeq; }
            cnt[tid] = myeq;
            __syncthreads();
            int rank = 0; for (int i = 0; i < tid; ++i) rank += (int)cnt[i];
#pragma unroll 1
            for (int j = 0; j < 8; ++j) { const int s = tid * 8 + j; if (s < n) { const unsigned u = fkey(sc[s]);
                bool take = u > prefix; if (u == prefix) { take = rank < need; ++rank; }
                if (take) { const int pos = atomicAdd(&misc[0], 1); if (pos < 256) sel[pos] = s; } } }
        }
        __syncthreads();
        { const int j = tid & 255, c = tid >> 8;
          float l4[4];
          if (j < ksel) { const int s = sel[j]; const bf16_t* kr = ub + (size_t)s * LDU + C_DK + c * 128;
              float a0 = 0.f, a1 = 0.f, a2 = 0.f, a3 = 0.f;
#pragma unroll 1
              for (int d0 = 0; d0 < 128; d0 += 8) { const bf16x8 kv = *(const bf16x8*)(kr + d0);
#pragma unroll
                  for (int dd = 0; dd < 8; ++dd) { const float kd = bf2f((bf16_t)kv[dd]); const float* qq = qs + c * 512 + d0 + dd; a0 += qq[0] * kd; a1 += qq[128] * kd; a2 += qq[256] * kd; a3 += qq[384] * kd; } }
              int dist = t - s; if (dist < 0) dist = 0; const int bk = dist < 128 ? (int)T5B[dist] : 31; const float* rb = p.rel_bias + bk * 8 + c * 4;
              l4[0] = a0 + rb[0]; l4[1] = a1 + rb[1]; l4[2] = a2 + rb[2]; l4[3] = a3 + rb[3];
          } else { l4[0] = l4[1] = l4[2] = l4[3] = -1e30f; }
#pragma unroll
          for (int g = 0; g < 4; ++g) lg[(c * 4 + g) * 256 + j] = l4[g]; }
        __syncthreads();
        { float v[4]; float mx = -3e38f;
#pragma unroll
          for (int i = 0; i < 4; ++i) { v[i] = lg[wave * 256 + lane + 64 * i]; mx = fmaxf(mx, v[i]); }
          mx = wave_max(mx); float sm = 0.f;
#pragma unroll
          for (int i = 0; i < 4; ++i) { v[i] = __expf(v[i] - mx); sm += v[i]; }
          sm = wave_sum(sm); const float inv = 1.f / sm;
#pragma unroll
          for (int i = 0; i < 4; ++i) lg[wave * 256 + lane + 64 * i] = v[i] * inv; }
        __syncthreads();
        { const int h = wave, c = h >> 2; float o0 = 0.f, o1 = 0.f;
#pragma unroll 4
          for (int j = 0; j < ksel; ++j) { const float pj = lg[h * 256 + j]; const unsigned w = *(const unsigned*)(ub + (size_t)sel[j] * LDU + C_DV + c * 128 + lane * 2);
              o0 += pj * __uint_as_float(w << 16); o1 += pj * __uint_as_float(w & 0xffff0000u); }
          *(unsigned*)(U + m * LDU + C_DQ + h * 128 + lane * 2) = pk2(o0, o1); }
    }
}


typedef float f32x16 __attribute__((ext_vector_type(16)));
typedef short s16x4 __attribute__((ext_vector_type(4)));
#define LAS __attribute__((address_space(3)))
#define MFMA32(a, b, c) __builtin_amdgcn_mfma_f32_32x32x16_bf16((a), (b), (c), 0, 0, 0)
__device__ __forceinline__ int crow(int r, int h) { return (r & 3) + 8 * (r >> 2) + 4 * h; }
constexpr int TRI = 8256;
__device__ __forceinline__ size_t mask_index(int b, int j, int kt, int lane) { return ((size_t)(b * TRI + j * (j + 1) / 2 + kt)) * 64 + lane; }

__device__ __forceinline__ void idx_tile(f32x16& sc, const bf16x8 (&aik)[4], LAS const bf16x8* biq  , const float (&wq)[8]) {
#pragma unroll
    for (int r = 0; r < 16; ++r) sc[r] = 0.f;
#pragma unroll
    for (int h = 0; h < 8; ++h) {
        f32x16 d;
#pragma unroll
        for (int r = 0; r < 16; ++r) d[r] = 0.f;
#pragma unroll
        for (int kk = 0; kk < 4; ++kk) d = MFMA32(aik[kk], biq[(h * 4 + kk) * 64], d);
#pragma unroll
        for (int r = 0; r < 16; ++r) sc[r] = __builtin_fmaf(wq[h], __builtin_fmaxf(d[r], 0.f), sc[r]);
    }
}

__device__ __forceinline__ void dsa_select_item(const Params& p, int idx, unsigned char* lds) {
    unsigned* hist = (unsigned*)lds;
    unsigned* qpref = hist + 32 * 256;
    int* qneed = (int*)(qpref + 32);
    int* qcut = qneed + 32;
    int* qflag = qcut + 32;
    int* anyflag = qflag + 32;
    unsigned* tb = (unsigned*)(anyflag + 8);
    LAS bf16x8* iqf = (LAS bf16x8*)((LAS unsigned char*)lds + 65536);
    const bf16_t* U = Uptr(p); unsigned short* maskbuf = (unsigned short*)(p.ws + WS_MASK);
    const int tid = opaque_tid(), lane = tid & 63, wave = __builtin_amdgcn_readfirstlane(tid >> 6), q = lane & 31, half = lane >> 5;
    const int b = idx & 3, j = idx >> 2, t0 = 32 * j; const size_t mb = (size_t)b * SEQ;
    __syncthreads();
    for (int e = tid; e < 32 * 256; e += NTHREADS) hist[e] = 0u;
    if (tid < 32) { qpref[tid] = 0u; qneed[tid] = 256; qcut[tid] = 0x7fffffff; qflag[tid] = 0; }
    if (tid < 8) anyflag[tid] = 0;
    float wq[8];
    { const bf16_t* ur = U + (mb + t0 + q) * LDU;
#pragma unroll
      for (int i = 0; i < 4; ++i) { const int f = wave + 8 * i; iqf[f * 64 + lane] = *(const bf16x8*)(ur + C_IQ + f * 16 + 8 * half); }
#pragma unroll
      for (int h = 0; h < 8; ++h) wq[h] = bf2f(ur[C_IW + h]); }
    LAS const bf16x8* biq = iqf + lane;
    __syncthreads();
#pragma unroll 1
    for (int ps = 0; ps < 6; ++ps) {
        if (ps == 4) { if (anyflag[0] == 0) continue; }
        const unsigned myT = qpref[q]; const int mycut = qcut[q];
        const int shift = 24 - 8 * ps; const unsigned mhi = (ps == 0 || ps > 3) ? 0u : (0xFFFFFFFFu << (32 - 8 * ps));
#pragma unroll 1
        for (int kt = wave; kt <= j; kt += NWAVES) {
            bf16x8 aik[4];
            { const bf16_t* kr = U + (mb + 32 * kt + q) * LDU + C_IK + 8 * half;
#pragma unroll
              for (int kk = 0; kk < 4; ++kk) aik[kk] = *(const bf16x8*)(kr + kk * 16); }
            f32x16 sc; idx_tile(sc, aik, biq, wq);
            unsigned word = 0u;
#pragma unroll
            for (int r = 0; r < 16; ++r) {
                const int kin = crow(r, half); const bool valid = (kt < j) || (kin <= q);
                const unsigned key = fkey(sc[r]);
                if (ps < 4) { if (valid && (key & mhi) == myT) atomicAdd(&hist[q * 256 + ((key >> shift) & 255u)], 1u); }
                else if (ps == 4) { if (valid && key == myT) word |= 1u << kin; }
                else { const bool sel = valid && (key > myT || (key == myT && (32 * kt + kin) <= mycut)); word |= sel ? (1u << r) : 0u; }
            }
            if (ps == 4) { if (word) atomicOr(&tb[kt * 32 + q], word); }
            if (ps == 5) maskbuf[mask_index(b, j, kt, lane)] = (unsigned short)word;
        }
        __syncthreads();
        if (ps < 4) {
            for (int qi = 0; qi < 4; ++qi) {
                const int qq = 4 * wave + qi; const int need = qneed[qq];
                u32x4 c = *(u32x4*)&hist[qq * 256 + 4 * lane];
                const int tot = (int)(c.x + c.y + c.z + c.w);
                int suf = tot;
#pragma unroll
                for (int o = 1; o < 64; o <<= 1) { const int tv = __shfl_down(suf, o); if (lane + o < 64) suf += tv; }
                const int above = suf - tot;
                if (above < need && need <= suf) {
                    int cum = above, digit, eq;
                    if (cum + (int)c.w >= need) { digit = 3; eq = (int)c.w; }
                    else { cum += (int)c.w; if (cum + (int)c.z >= need) { digit = 2; eq = (int)c.z; }
                        else { cum += (int)c.z; if (cum + (int)c.y >= need) { digit = 1; eq = (int)c.y; } else { cum += (int)c.y; digit = 0; eq = (int)c.x; } } }
                    qpref[qq] |= (unsigned)(4 * lane + digit) << shift; qneed[qq] = need - cum;
                    if (ps == 3 && eq > need - cum) { qflag[qq] = 1; anyflag[0] = 1; }
                }
                *(u32x4*)&hist[qq * 256 + 4 * lane] = (u32x4){0u, 0u, 0u, 0u};
            }
            if (ps == 3) { for (int e = tid; e < (j + 1) * 32; e += NTHREADS) tb[e] = 0u; }
        }
        if (ps == 4) {
            if (tid < 32 && qflag[tid]) { const int need = qneed[tid]; int cnt = 0, cut = 0x7fffffff;
                for (int kt = 0; kt <= j; ++kt) { unsigned w = tb[kt * 32 + tid]; const int pc = __popc(w);
                    if (cnt + pc >= need) { int left = need - cnt, pos = 0; for (;;) { pos = __ffs(w) - 1; if (--left == 0) break; w &= w - 1; } cut = 32 * kt + pos; break; }
                    cnt += pc; }
                qcut[tid] = cut; }
        }
        __syncthreads();
    }
}
__device__ void phase_dsa_select(const Params& p, int bid, int nb, unsigned char* lds) {
    for (int k2 = 2 * bid; k2 < 512; k2 += (k2 & 1) ? 2 * nb - 1 : 1) { const int k = k2 >> 1; dsa_select_item(p, (k2 & 1) ? 511 - k : k, lds); }
}


typedef float f32x4_ __attribute__((ext_vector_type(4)));
#define MFMA16(a, b, c) __builtin_amdgcn_mfma_f32_16x16x32_bf16((a), (b), (c), 0, 0, 0)
constexpr int S2_PITCH = 8192 + 16;
constexpr int S2_KEYS = 0, S2_HIST = 16 * S2_PITCH, S2_MISC = S2_HIST + 16 * 128 * 4;
__device__ __forceinline__ unsigned key16x2(float a, float b) {
    const unsigned x = __builtin_bit_cast(unsigned, __builtin_amdgcn_cvt_pkrtz(a, b));
    const unsigned neg = (x >> 15) & 0x00010001u;
    return x ^ ((neg * 0xFFFFu) | 0x80008000u);
}
__device__ __forceinline__ float relu_(float x) { return __builtin_amdgcn_fmed3f(x, 0.f, __builtin_inff()); }
__device__ __forceinline__ void dsa_select16_item(const Params& p, int idx, int a, unsigned char* lds_) {
    LAS char* lds = (LAS char*)lds_;
    LAS unsigned* hist = (LAS unsigned*)(lds + S2_HIST);
    LAS unsigned* qT = (LAS unsigned*)(lds + S2_MISC);
    LAS int* qneed = (LAS int*)(qT + 16);
    LAS int* qcut = qneed + 16;
    LAS int* qflag = qcut + 16;
    const bf16_t* U = Uptr(p); unsigned short* maskbuf = (unsigned short*)(p.ws + WS_MASK);
    const int tid = opaque_tid(), lane = tid & 63, wave = __builtin_amdgcn_readfirstlane(tid >> 6), qn = lane & 15, quad = lane >> 4;
    const int b = idx & 3, j = idx >> 2, t0 = 32 * j + 16 * a; const size_t mb = (size_t)b * SEQ;
    const int ntile16 = 2 * j + a + 1;
    bf16x8 biq[8][2]; float wq[8];
    { const bf16_t* ur = U + (mb + t0 + qn) * LDU;
#pragma unroll
      for (int h = 0; h < 8; ++h) { biq[h][0] = *(const bf16x8*)(ur + C_IQ + h * 64 + 8 * quad); biq[h][1] = *(const bf16x8*)(ur + C_IQ + h * 64 + 32 + 8 * quad); wq[h] = bf2f(ur[C_IW + h]); } }
    bf16x8 blin[2];
#pragma unroll
    for (int ks = 0; ks < 2; ++ks) { unsigned pw_[4];
#pragma unroll
        for (int e2 = 0; e2 < 4; ++e2) { float a0 = 0.f, a1 = 0.f;
#pragma unroll
            for (int h = 0; h < 8; ++h) { a0 = __builtin_fmaf(wq[h], bf2f((bf16_t)biq[h][ks][2 * e2]), a0); a1 = __builtin_fmaf(wq[h], bf2f((bf16_t)biq[h][ks][2 * e2 + 1]), a1); }
            pw_[e2] = pk2(a0, a1); }
        blin[ks] = __builtin_bit_cast(bf16x8, (u32x4){pw_[0], pw_[1], pw_[2], pw_[3]}); }
    __syncthreads();
    for (int e = tid; e < 16 * 128; e += NTHREADS) hist[e] = 0u;
    if (tid < 16) { qT[tid] = 0u; qneed[tid] = 256; qcut[tid] = 0x7fffffff; qflag[tid] = 0; }
    __syncthreads();
    {
        const bf16_t* kb = U + (mb + qn) * LDU + C_IK + 8 * quad; const int nq_ = t0 + qn + 1;
        bf16x8 a00, a01, a10, a11;
        { const bool two = wave + NWAVES < ntile16; const bf16_t* k0 = kb + (size_t)16 * wave * LDU; const bf16_t* k1 = kb + (size_t)16 * (two ? wave + NWAVES : wave) * LDU;
          if (wave < ntile16) { a00 = *(const bf16x8*)k0; a01 = *(const bf16x8*)(k0 + 32); a10 = *(const bf16x8*)k1; a11 = *(const bf16x8*)(k1 + 32); } }
#pragma unroll 1
        for (int tile = wave; tile < ntile16; tile += 2 * NWAVES) {
            const bool two = tile + NWAVES < ntile16;
            const int nt = tile + 2 * NWAVES; const bool hn = nt < ntile16, hn2 = nt + NWAVES < ntile16;
            bf16x8 n00 = a00, n01 = a01, n10 = a10, n11 = a11;
            if (hn) { const bf16_t* k0 = kb + (size_t)16 * nt * LDU; const bf16_t* k1 = kb + (size_t)16 * (hn2 ? nt + NWAVES : nt) * LDU;
                n00 = *(const bf16x8*)k0; n01 = *(const bf16x8*)(k0 + 32); n10 = *(const bf16x8*)k1; n11 = *(const bf16x8*)(k1 + 32); }
            f32x4_ s0 = (f32x4_){0.f, 0.f, 0.f, 0.f}, s1 = s0;
            s0 = MFMA16(a00, blin[0], s0); s1 = MFMA16(a10, blin[0], s1); s0 = MFMA16(a01, blin[1], s0); s1 = MFMA16(a11, blin[1], s1);
#pragma unroll
            for (int h = 0; h < 8; ++h) {
                f32x4_ d0 = (f32x4_){0.f, 0.f, 0.f, 0.f}, d1 = d0;
                d0 = MFMA16(a00, biq[h][0], d0); d1 = MFMA16(a10, biq[h][0], d1);
                d0 = MFMA16(a01, biq[h][1], d0); d1 = MFMA16(a11, biq[h][1], d1);
#pragma unroll
                for (int r = 0; r < 4; ++r) { s0[r] = __builtin_fmaf(wq[h], __builtin_fabsf(d0[r]), s0[r]); s1[r] = __builtin_fmaf(wq[h], __builtin_fabsf(d1[r]), s1[r]); }
            }
            u32x2 w0; w0.x = key16x2(s0[0], s0[1]); w0.y = key16x2(s0[2], s0[3]);
            *(LAS u32x2*)(lds + S2_KEYS + qn * S2_PITCH + (16 * tile + 4 * quad) * 2) = w0;
            { const int k0i = 16 * tile + 4 * quad;
#pragma unroll
              for (int r = 0; r < 4; ++r) { const unsigned key = ((r & 2) ? w0.y : w0.x) >> (16 * (r & 1)) & 0xffffu; const unsigned bin = key >> 8;
                  if (k0i + r < nq_) __hip_atomic_fetch_add(hist + qn * 128 + (bin >> 1), 1u << (16 * (bin & 1u)), __ATOMIC_RELAXED, __HIP_MEMORY_SCOPE_WORKGROUP); } }
            if (two) { u32x2 w1; w1.x = key16x2(s1[0], s1[1]); w1.y = key16x2(s1[2], s1[3]);
                *(LAS u32x2*)(lds + S2_KEYS + qn * S2_PITCH + (16 * (tile + NWAVES) + 4 * quad) * 2) = w1;
                const int k1i = 16 * (tile + NWAVES) + 4 * quad;
#pragma unroll
                for (int r = 0; r < 4; ++r) { const unsigned key = ((r & 2) ? w1.y : w1.x) >> (16 * (r & 1)) & 0xffffu; const unsigned bin = key >> 8;
                    if (k1i + r < nq_) __hip_atomic_fetch_add(hist + qn * 128 + (bin >> 1), 1u << (16 * (bin & 1u)), __ATOMIC_RELAXED, __HIP_MEMORY_SCOPE_WORKGROUP); } }
            a00 = n00; a01 = n01; a10 = n10; a11 = n11;
        }
    }
    __syncthreads();
    const int rq = tid & 15, part = tid >> 4, nq = t0 + rq + 1;
#pragma unroll 1
    for (int ps = 0; ps < 2; ++ps) {
        const unsigned hiT = qT[rq] >> 8;
        LAS const char* krow = lds + S2_KEYS + rq * S2_PITCH;
        if (ps == 1) for (int base = part * 8; base < nq; base += 256) {
            const u32x4 kv = *(LAS const u32x4*)(krow + base * 2);
#pragma unroll
            for (int e = 0; e < 8; ++e) { const unsigned w = e < 2 ? kv.x : e < 4 ? kv.y : e < 6 ? kv.z : kv.w; const unsigned key = (e & 1) ? (w >> 16) : (w & 0xffffu);
                const bool ok = (base + e < nq) && (key >> 8) == hiT;
                const unsigned bin = key & 255u;
                if (ok) __hip_atomic_fetch_add(hist + rq * 128 + (bin >> 1), 1u << (16 * (bin & 1u)), __ATOMIC_RELAXED, __HIP_MEMORY_SCOPE_WORKGROUP); }
        }
        __syncthreads();
#pragma unroll
        for (int qi = 0; qi < 2; ++qi) {
            const int qq = 2 * wave + qi; const int need = qneed[qq];
            const u32x2 hw = *(LAS u32x2*)(hist + qq * 128 + 2 * lane);
            const int c0 = (int)(hw.x & 0xffffu), c1 = (int)(hw.x >> 16), c2 = (int)(hw.y & 0xffffu), c3 = (int)(hw.y >> 16);
            const int tot = c0 + c1 + c2 + c3;
            int suf = tot;
#pragma unroll
            for (int o = 1; o < 64; o <<= 1) { const int tv = __shfl_down(suf, o); if (lane + o < 64) suf += tv; }
            const int above = suf - tot;
            if (above < need && need <= suf) {
                int cum = above, digit, eq;
                if (cum + c3 >= need) { digit = 3; eq = c3; }
                else { cum += c3; if (cum + c2 >= need) { digit = 2; eq = c2; }
                    else { cum += c2; if (cum + c1 >= need) { digit = 1; eq = c1; } else { cum += c1; digit = 0; eq = c0; } } }
                qT[qq] |= (unsigned)(4 * lane + digit) << (ps == 0 ? 8 : 0); qneed[qq] = need - cum;
                if (ps == 1 && eq > need - cum) qflag[qq] = 1;
            }
            *(LAS u32x2*)(hist + qq * 128 + 2 * lane) = (u32x2){0u, 0u};
        }
        __syncthreads();
    }
#pragma unroll 1
    for (int qi = 0; qi < 2; ++qi) {
        const int qq = 2 * wave + qi;
        if (qflag[qq]) { const int nqq = t0 + qq + 1, need = qneed[qq]; const unsigned T = qT[qq]; int acc = 0, cut = 0x7fffffff;
            for (int base = 0; base < nqq; base += 64) { const int s = base + lane;
                const unsigned key = *(LAS const unsigned short*)(lds + S2_KEYS + qq * S2_PITCH + s * 2);
                unsigned long long em = __ballot(s < nqq && key == T); const int pc = __popcll(em);
                if (acc + pc >= need) { int left = need - acc; while (--left > 0) em &= em - 1; cut = base + (int)__ffsll((long long)em) - 1; break; }
                acc += pc; }
            if (lane == 0) qcut[qq] = cut; }
    }
    __syncthreads();
    for (int pi = tid; pi < 16 * (j + 1); pi += NTHREADS) {
        const int eq_ = pi & 15, kt = pi >> 4; const int nqq = t0 + eq_ + 1, cut = qcut[eq_]; const unsigned T = (nqq <= 256) ? 0u : qT[eq_];
        LAS const char* kp = lds + S2_KEYS + eq_ * S2_PITCH + kt * 64;
        unsigned ge = 0u, eqm = 0u;
#pragma unroll
        for (int v4 = 0; v4 < 4; ++v4) { const u32x4 kv = *(LAS const u32x4*)(kp + v4 * 16);
#pragma unroll
            for (int e = 0; e < 8; ++e) { const unsigned w = e < 2 ? kv.x : e < 4 ? kv.y : e < 6 ? kv.z : kv.w; const unsigned key = (e & 1) ? (w >> 16) : (w & 0xffffu);
                ge |= (unsigned)(key >= T) << (8 * v4 + e); eqm |= (unsigned)(key == T) << (8 * v4 + e); } }
        const int nv = nqq - 32 * kt; const unsigned vmask = nv >= 32 ? 0xffffffffu : (nv <= 0 ? 0u : ((1u << nv) - 1u));
        const int nc = cut - 32 * kt; const unsigned cmask = nc >= 31 ? 0xffffffffu : (nc < 0 ? 0u : ((2u << nc) - 1u));
        const unsigned w32 = vmask & ge & (~eqm | cmask);
#pragma unroll
        for (int hf = 0; hf < 2; ++hf) { const unsigned x = w32 >> (4 * hf); const unsigned wd = (x & 0xFu) | ((x >> 4) & 0xF0u) | ((x >> 8) & 0xF00u) | ((x >> 12) & 0xF000u);
            maskbuf[mask_index(b, j, kt, 16 * a + eq_ + 32 * hf)] = (unsigned short)wd; }
    }
}
__device__ void phase_dsa_select2(const Params& p, int bid, int nb, unsigned char* lds) {
    for (int k4 = 4 * bid; k4 < 1024; k4 += ((k4 & 3) == 3) ? 4 * nb - 3 : 1) { const int k = k4 >> 2, r = k4 & 3; dsa_select16_item(p, (r & 2) ? (((127 - (k >> 2)) << 2) | (k & 3)) : k, r & 1, lds); }
}

constexpr int DA_K = 0, DA_V = 32768, DA_BUF = 65536  , DA_TB = 131072, DA_WS = DA_TB + 8 * 132 * 4, DA_END = DA_WS + 8 * 64 * 4;
__device__ __forceinline__ s16x4 ds_tr(LAS const char* pp) { typedef short v4i16_t __attribute__((ext_vector_type(4))); return __builtin_bit_cast(s16x4, __builtin_amdgcn_ds_read_tr16_b64_v4i16((LAS v4i16_t*)pp)); }
template <int MODE>
__device__ __forceinline__ void attend_item(const Params& p, int idx, unsigned char* lds_, bool dry) {
    LAS char* lds = (LAS char*)lds_;
    bf16_t* U = Uptr(p); const unsigned short* maskbuf = (const unsigned short*)(p.ws + WS_MASK);
    const int tid = opaque_tid(), lane = tid & 63, wv = __builtin_amdgcn_readfirstlane(tid >> 6), q = lane & 31, half = lane >> 5;
    constexpr int NKK = MODE == 0 ? 8 : 16;
    const int h = MODE == 0 ? wv : (idx & 3); const int c = wv >> 2;
    const int b = MODE == 0 ? (idx & 3) : ((idx >> 2) >> 5); const int j = idx >> 2;
    const size_t mb = (size_t)b * SEQ;
    const size_t mq = MODE == 0 ? mb + 32 * j : (size_t)128 * j + 32 * (wv & 3);
    const int t0 = 32 * j;
    LAS const float* tbh = (LAS const float*)(lds + DA_TB) + h * 132; LAS float* wsc = (LAS float*)(lds + DA_WS) + wv * 64;
    constexpr float C1 = (MODE == 0 ? 0.08838834764831845f : 0.0625f) * 1.4426950408889634f;
    const float b31 = MODE == 0 ? tbh[128] : 0.f, bmaxh = MODE == 0 ? tbh[129] : 0.f;
    const int nsteps = MODE == 0 ? (j >> 1) + 1 : 4;
    const int srow = 2 * wv + half, spc = lane & 31;
    const bf16_t* gk; const bf16_t* gv; size_t gpitch;
    if (MODE == 0) { gk = U + (mb + srow) * LDU + C_DK + ((spc ^ (srow & 15)) << 3); gv = U + (mb + srow) * LDU + C_DV + ((spc ^ ((srow & 3) << 2)) << 3); gpitch = LDU; }
    else { const bf16_t* MKV = (const bf16_t*)(p.ws + WS_MKV) + ((size_t)b * NMEM + srow) * 2048 + h * 256; gk = MKV + ((spc ^ (srow & 15)) << 3); gv = MKV + 1024 + ((spc ^ ((srow & 3) << 2)) << 3); gpitch = 2048; }
#define DA_STAGE(st_, bufoff_) do { const size_t go_ = (size_t)(64 * (st_)) * gpitch; _Pragma("unroll") for (int i_ = 0; i_ < 4; ++i_) { \
        __builtin_amdgcn_global_load_lds((const unsigned*)(gk + go_ + (size_t)16 * i_ * gpitch), (LAS unsigned*)(lds + (bufoff_) + DA_K + (wv + 8 * i_) * 1024), 16, 0, 0); \
        __builtin_amdgcn_global_load_lds((const unsigned*)(gv + go_ + (size_t)16 * i_ * gpitch), (LAS unsigned*)(lds + (bufoff_) + DA_V + (wv + 8 * i_) * 1024), 16, 0, 0); } } while (0)
    __syncthreads();
    DA_STAGE(0, 0);
    bf16x8 qf[NKK];
    { const bf16_t* ur = U + (mq + q) * LDU + (MODE == 0 ? C_DQ + h * 128 : C_XQ + h * 256) + 8 * half;
#pragma unroll
      for (int kk = 0; kk < NKK; ++kk) qf[kk] = *(const bf16x8*)(ur + kk * 16); }
    f32x16 o[4];
#pragma unroll
    for (int dt = 0; dt < 4; ++dt)
#pragma unroll
        for (int r = 0; r < 16; ++r) o[dt][r] = 0.f;
    float m = -1e20f, l = 0.f;
    unsigned kA0, vA0;
    { const int q4 = (lane & 15) >> 2, p4 = lane & 3, g1 = (lane >> 4) & 1;
      kA0 = DA_K + q * 512 + ((((MODE == 0 ? c * 16 : 0) + half) ^ (q & 15)) << 4);
      vA0 = DA_V + (4 * half + q4) * 512 + (((c * 16 + 2 * g1 + (p4 >> 1)) ^ (q4 << 2)) << 4) + (p4 & 1) * 8; }
    unsigned mw0 = 0xffffu, mw1 = 0xffffu;
    if (MODE == 0) { mw0 = maskbuf[mask_index(b, j, 0, lane)]; mw1 = (1 <= j) ? maskbuf[mask_index(b, j, 1, lane)] : 0u; }
#pragma unroll 1
    for (int st = 0; st < nsteps; ++st) {
        const int kbase = 64 * st;
        asm volatile("s_waitcnt vmcnt(0)" ::: "memory");
        __syncthreads();
        const unsigned cw0 = mw0, cw1 = mw1;
        if (st + 1 < nsteps) { DA_STAGE(st + 1, ((st + 1) & 1) * DA_BUF);
            if (MODE == 0) { const int kt = 2 * st + 2; mw0 = maskbuf[mask_index(b, j, kt, lane)]; mw1 = (kt + 1 <= j) ? maskbuf[mask_index(b, j, kt + 1, lane)] : 0u; } }
        f32x16 s0, s1;
#pragma unroll
        for (int r = 0; r < 16; ++r) { s0[r] = 0.f; s1[r] = 0.f; }
#pragma unroll
        for (int kk = 0; kk < NKK; ++kk) {
            const bf16x8 a0 = *(LAS const bf16x8*)(lds + (kA0 ^ (unsigned)(kk << 5)));
            const bf16x8 a1 = *(LAS const bf16x8*)(lds + (kA0 ^ (unsigned)(kk << 5)) + 32 * 512);
            s0 = MFMA32(a0, qf[kk], s0); s1 = MFMA32(a1, qf[kk], s1); }
        const bool far_ = MODE == 0 && (t0 - (kbase + 63)) >= 128;
        float sm = fmaxf(s0[0], s1[0]);
#pragma unroll
        for (int r = 1; r < 16; ++r) sm = fmaxf(sm, fmaxf(s0[r], s1[r]));
        sm = fmaxf(sm, __shfl_xor(sm, 32));
        const float mc = __builtin_fmaf(sm, C1, MODE == 0 ? (far_ ? b31 : bmaxh) : 0.f);
        if (__any(mc > m + 16.f)) {
            const float mnew = fmaxf(m, mc);
            const float alpha = __builtin_amdgcn_exp2f(m - mnew); l *= alpha;
            if (half == 0) wsc[q] = alpha;
            asm volatile("s_waitcnt lgkmcnt(0)" ::: "memory");
#pragma unroll
            for (int r = 0; r < 16; ++r) { const float a = wsc[crow(r, half)];
#pragma unroll
                for (int dt = 0; dt < 4; ++dt) o[dt][r] *= a; }
            m = mnew;
        }
        float ls = 0.f;
        if (MODE == 1) {
            const float nm = -m;
#pragma unroll
            for (int r = 0; r < 16; ++r) { s0[r] = __builtin_amdgcn_exp2f(__builtin_fmaf(s0[r], C1, nm)); s1[r] = __builtin_amdgcn_exp2f(__builtin_fmaf(s1[r], C1, nm)); ls += s0[r] + s1[r]; }
        } else if (far_) {
            const int bm = __float_as_int(b31 - m), NEGI = __float_as_int(-1e30f);
#pragma unroll
            for (int r = 0; r < 16; ++r) {
                const int k0 = __builtin_amdgcn_sbfe((int)cw0, r, 1), k1 = __builtin_amdgcn_sbfe((int)cw1, r, 1);
                const float a0 = __int_as_float((k0 & bm) | (~k0 & NEGI)), a1 = __int_as_float((k1 & bm) | (~k1 & NEGI));
                s0[r] = __builtin_amdgcn_exp2f(__builtin_fmaf(s0[r], C1, a0)); s1[r] = __builtin_amdgcn_exp2f(__builtin_fmaf(s1[r], C1, a1)); ls += s0[r] + s1[r]; }
        } else {
            const int NEGI = __float_as_int(-1e30f);
#pragma unroll
            for (int r = 0; r < 16; ++r) {
                int d0 = t0 + q - (kbase + crow(r, half)); int d1 = d0 - 32; d0 = d0 < 0 ? 0 : (d0 > 128 ? 128 : d0); d1 = d1 < 0 ? 0 : (d1 > 128 ? 128 : d1);
                const int b0 = __float_as_int(tbh[d0] - m), b1 = __float_as_int(tbh[d1] - m);
                const int k0 = __builtin_amdgcn_sbfe((int)cw0, r, 1), k1 = __builtin_amdgcn_sbfe((int)cw1, r, 1);
                const float a0 = __int_as_float((k0 & b0) | (~k0 & NEGI)), a1 = __int_as_float((k1 & b1) | (~k1 & NEGI));
                s0[r] = __builtin_amdgcn_exp2f(__builtin_fmaf(s0[r], C1, a0)); s1[r] = __builtin_amdgcn_exp2f(__builtin_fmaf(s1[r], C1, a1)); ls += s0[r] + s1[r]; }
        }
        l += ls;
#pragma unroll
        for (int u = 0; u < 2; ++u) {
#pragma unroll
            for (int ss = 0; ss < 2; ++ss) {
                u32x4 pw;
                if (u == 0) { pw.x = pk2(s0[8 * ss], s0[8 * ss + 1]); pw.y = pk2(s0[8 * ss + 2], s0[8 * ss + 3]); pw.z = pk2(s0[8 * ss + 4], s0[8 * ss + 5]); pw.w = pk2(s0[8 * ss + 6], s0[8 * ss + 7]); }
                else { pw.x = pk2(s1[8 * ss], s1[8 * ss + 1]); pw.y = pk2(s1[8 * ss + 2], s1[8 * ss + 3]); pw.z = pk2(s1[8 * ss + 4], s1[8 * ss + 5]); pw.w = pk2(s1[8 * ss + 6], s1[8 * ss + 7]); }
                const bf16x8 pa = __builtin_bit_cast(bf16x8, pw);
#pragma unroll
                for (int dt = 0; dt < 4; ++dt) {
                    const s16x4 lo = ds_tr(lds + (vA0 ^ (unsigned)(dt << 6)) + (32 * u + 16 * ss) * 512);
                    const s16x4 hi = ds_tr(lds + (vA0 ^ (unsigned)(dt << 6)) + (32 * u + 16 * ss + 8) * 512);
                    const bf16x8 vb = (bf16x8){lo[0], lo[1], lo[2], lo[3], hi[0], hi[1], hi[2], hi[3]};
                    o[dt] = MFMA32(pa, vb, o[dt]);
                }
            }
        }
        kA0 ^= DA_BUF; vA0 ^= DA_BUF;
    }
#undef DA_STAGE
    l += __shfl_xor(l, 32);
    if (half == 0) wsc[q] = 1.f / l;
    asm volatile("s_waitcnt lgkmcnt(0)" ::: "memory");
#pragma unroll
    for (int r = 0; r < 16; ++r) { const int qq = crow(r, half); const float a = wsc[qq];
        bf16_t* orow = U + (mq + qq) * LDU + (MODE == 0 ? C_DQ + h * 128 : C_XQ + h * 256 + c * 128) + q;
#pragma unroll
        for (int dt = 0; dt < 4; ++dt) { const bf16_t ov = (bf16_t)f2bf(o[dt][r] * a); if (!dry) orow[dt * 32] = ov; } }
}

constexpr int D4_GRP = 65536, D4_K = 0, D4_V = 16384, D4_BUF = 32768, D4_CNT = DA_END;
__device__ __forceinline__ void group_barrier(LAS unsigned* cnt, int lane) {
    asm volatile("s_waitcnt vmcnt(0) lgkmcnt(0)" ::: "memory");
    if (lane == 0) { const unsigned old = __hip_atomic_fetch_add(cnt, 1u, __ATOMIC_RELAXED, __HIP_MEMORY_SCOPE_WORKGROUP); const unsigned target = (old & ~3u) + 4u;
        while (__hip_atomic_load(cnt, __ATOMIC_RELAXED, __HIP_MEMORY_SCOPE_WORKGROUP) < target) __builtin_amdgcn_s_sleep(1); }
    asm volatile("" ::: "memory");
}
__device__ __forceinline__ float max3f_(float a, float b, float c) { return __builtin_fmaxf(__builtin_fmaxf(a, b), c); }
__device__ __forceinline__ void dsa_attend4_item(const Params& p, int idx, unsigned char* lds_, bool dry) {
    LAS char* lds = (LAS char*)lds_;
    bf16_t* U = Uptr(p); const unsigned short* maskbuf = (const unsigned short*)(p.ws + WS_MASK);
    const int tid = opaque_tid(), lane = tid & 63, wv = __builtin_amdgcn_readfirstlane(tid >> 6), q = lane & 31, half = lane >> 5;
    const int grp = wv >> 2, w4 = wv & 3, h = wv;
    const int b = idx & 3, j = idx >> 2, t0 = 32 * j; const size_t mb = (size_t)b * SEQ;
    LAS const float* tbh = (LAS const float*)(lds + DA_TB) + h * 132; LAS float* wsc = (LAS float*)(lds + DA_WS) + wv * 64;
    LAS unsigned* gcnt = (LAS unsigned*)(lds + D4_CNT) + grp * 16;
    constexpr float C1 = 0.08838834764831845f * 1.4426950408889634f;
    const float b31 = tbh[128], bmaxh = tbh[129];
    const int nsteps = (j >> 1) + 1;
    const unsigned gb = grp * D4_GRP;
    const int sr = 4 * w4 + (lane >> 4), spc = lane & 15;
    const bf16_t* gk = U + (mb + sr) * LDU + C_DK + grp * 128 + ((spc ^ (sr & 15)) << 3);
    const bf16_t* gv = U + (mb + sr) * LDU + C_DV + grp * 128 + ((spc ^ ((sr & 3) << 2)) << 3);
#define D4_STAGE(st_, bufoff_) do { const size_t go_ = (size_t)(64 * (st_)) * LDU; _Pragma("unroll") for (int i_ = 0; i_ < 4; ++i_) { \
        __builtin_amdgcn_global_load_lds((const unsigned*)(gk + go_ + (size_t)16 * i_ * LDU), (LAS unsigned*)(lds + gb + (bufoff_) + D4_K + (w4 + 4 * i_) * 1024), 16, 0, 0); \
        __builtin_amdgcn_global_load_lds((const unsigned*)(gv + go_ + (size_t)16 * i_ * LDU), (LAS unsigned*)(lds + gb + (bufoff_) + D4_V + (w4 + 4 * i_) * 1024), 16, 0, 0); } } while (0)
    group_barrier(gcnt, lane);
    D4_STAGE(0, 0);
    bf16x8 qf[8];
    { const bf16_t* ur = U + (mb + t0 + q) * LDU + C_DQ + h * 128 + 8 * half;
#pragma unroll
      for (int kk = 0; kk < 8; ++kk) qf[kk] = *(const bf16x8*)(ur + kk * 16); }
    f32x16 o[4];
#pragma unroll
    for (int dt = 0; dt < 4; ++dt)
#pragma unroll
        for (int r = 0; r < 16; ++r) o[dt][r] = 0.f;
    float m = -1e20f, l = 0.f;
    unsigned kA0, vA0;
    { const int q4 = (lane & 15) >> 2, p4 = lane & 3, g1 = (lane >> 4) & 1;
      kA0 = gb + D4_K + q * 256 + ((half ^ (q & 15)) << 4);
      vA0 = gb + D4_V + (4 * half + q4) * 256 + (((2 * g1 + (p4 >> 1)) ^ (q4 << 2)) << 4) + (p4 & 1) * 8; }
    unsigned mw0 = maskbuf[mask_index(b, j, 0, lane)], mw1 = (1 <= j) ? maskbuf[mask_index(b, j, 1, lane)] : 0u;
#pragma unroll 1
    for (int st = 0; st < nsteps; ++st) {
        const int kbase = 64 * st;
        group_barrier(gcnt, lane);
        const unsigned cw0 = mw0, cw1 = mw1;
        const bool nxt = st + 1 < nsteps;
        if (nxt) { const int kt = 2 * st + 2; mw0 = maskbuf[mask_index(b, j, kt, lane)]; mw1 = (kt + 1 <= j) ? maskbuf[mask_index(b, j, kt + 1, lane)] : 0u; }
        f32x16 s0, s1;
#pragma unroll
        for (int r = 0; r < 16; ++r) { s0[r] = 0.f; s1[r] = 0.f; }
        { bf16x8 ka[8], kb[8];
#pragma unroll
          for (int kk = 0; kk < 8; ++kk) ka[kk] = *(LAS const bf16x8*)(lds + (kA0 ^ (unsigned)(kk << 5)));
#pragma unroll
          for (int kk = 0; kk < 8; ++kk) kb[kk] = *(LAS const bf16x8*)(lds + (kA0 ^ (unsigned)(kk << 5)) + 32 * 256);
          __builtin_amdgcn_sched_barrier(0);
          const size_t go_ = (size_t)(64 * (st + 1)) * LDU; const unsigned bo_ = ((st + 1) & 1) * D4_BUF;
#pragma unroll
          for (int kk = 0; kk < 8; ++kk) { s0 = MFMA32(ka[kk], qf[kk], s0); s1 = MFMA32(kb[kk], qf[kk], s1);
              if (nxt) { const int i_ = kk >> 1;
                  if ((kk & 1) == 0) __builtin_amdgcn_global_load_lds((const unsigned*)(gk + go_ + (size_t)16 * i_ * LDU), (LAS unsigned*)(lds + gb + bo_ + D4_K + (w4 + 4 * i_) * 1024), 16, 0, 0);
                  else __builtin_amdgcn_global_load_lds((const unsigned*)(gv + go_ + (size_t)16 * i_ * LDU), (LAS unsigned*)(lds + gb + bo_ + D4_V + (w4 + 4 * i_) * 1024), 16, 0, 0); }
              __builtin_amdgcn_sched_barrier(0); }
          __builtin_amdgcn_sched_barrier(0); }
        const bool far_ = (t0 - (kbase + 63)) >= 128;
        float sm = max3f_(s0[0], s1[0], s0[1]);
#pragma unroll
        for (int r = 1; r < 16; ++r) sm = (r < 15) ? max3f_(sm, s1[r], s0[r + 1]) : fmaxf(sm, s1[r]);
        sm = fmaxf(sm, __shfl_xor(sm, 32));
        const float mc = __builtin_fmaf(sm, C1, far_ ? b31 : bmaxh);
        if (__any(mc > m + 16.f)) {
            const float mnew = fmaxf(m, mc);
            const float alpha = __builtin_amdgcn_exp2f(m - mnew); l *= alpha;
            if (half == 0) wsc[q] = alpha;
            asm volatile("s_waitcnt lgkmcnt(0)" ::: "memory");
#pragma unroll
            for (int r = 0; r < 16; ++r) { const float a = wsc[crow(r, half)];
#pragma unroll
                for (int dt = 0; dt < 4; ++dt) o[dt][r] *= a; }
            m = mnew;
        }
        float ls = 0.f;
        if (far_) {
            const int bm = __float_as_int(b31 - m), NEGI = __float_as_int(-1e30f);
#pragma unroll
            for (int r = 0; r < 16; ++r) {
                const int k0 = __builtin_amdgcn_sbfe((int)cw0, r, 1), k1 = __builtin_amdgcn_sbfe((int)cw1, r, 1);
                const float a0 = __int_as_float((k0 & bm) | (~k0 & NEGI)), a1 = __int_as_float((k1 & bm) | (~k1 & NEGI));
                s0[r] = __builtin_amdgcn_exp2f(__builtin_fmaf(s0[r], C1, a0)); s1[r] = __builtin_amdgcn_exp2f(__builtin_fmaf(s1[r], C1, a1)); ls += s0[r] + s1[r]; }
        } else {
            const int NEGI = __float_as_int(-1e30f);
#pragma unroll
            for (int r = 0; r < 16; ++r) {
                int d0 = t0 + q - (kbase + crow(r, half)); int d1 = d0 - 32; d0 = d0 < 0 ? 0 : (d0 > 128 ? 128 : d0); d1 = d1 < 0 ? 0 : (d1 > 128 ? 128 : d1);
                const int b0 = __float_as_int(tbh[d0] - m), b1 = __float_as_int(tbh[d1] - m);
                const int k0 = __builtin_amdgcn_sbfe((int)cw0, r, 1), k1 = __builtin_amdgcn_sbfe((int)cw1, r, 1);
                const float a0 = __int_as_float((k0 & b0) | (~k0 & NEGI)), a1 = __int_as_float((k1 & b1) | (~k1 & NEGI));
                s0[r] = __builtin_amdgcn_exp2f(__builtin_fmaf(s0[r], C1, a0)); s1[r] = __builtin_amdgcn_exp2f(__builtin_fmaf(s1[r], C1, a1)); ls += s0[r] + s1[r]; }
        }
        l += ls;
        { s16x4 vl[2][4], vh[2][4];
#pragma unroll
          for (int dt = 0; dt < 4; ++dt) { vl[0][dt] = ds_tr(lds + (vA0 ^ (unsigned)(dt << 6))); vh[0][dt] = ds_tr(lds + (vA0 ^ (unsigned)(dt << 6)) + 8 * 256); }
#pragma unroll
          for (int g = 0; g < 4; ++g) { const int u = g >> 1, ss = g & 1;
              if (g < 3) { const int gn = g + 1, un = gn >> 1, sn = gn & 1;
#pragma unroll
                  for (int dt = 0; dt < 4; ++dt) { vl[gn & 1][dt] = ds_tr(lds + (vA0 ^ (unsigned)(dt << 6)) + (32 * un + 16 * sn) * 256); vh[gn & 1][dt] = ds_tr(lds + (vA0 ^ (unsigned)(dt << 6)) + (32 * un + 16 * sn + 8) * 256); } }
              u32x4 pw;
              if (u == 0) { pw.x = pk2(s0[8 * ss], s0[8 * ss + 1]); pw.y = pk2(s0[8 * ss + 2], s0[8 * ss + 3]); pw.z = pk2(s0[8 * ss + 4], s0[8 * ss + 5]); pw.w = pk2(s0[8 * ss + 6], s0[8 * ss + 7]); }
              else { pw.x = pk2(s1[8 * ss], s1[8 * ss + 1]); pw.y = pk2(s1[8 * ss + 2], s1[8 * ss + 3]); pw.z = pk2(s1[8 * ss + 4], s1[8 * ss + 5]); pw.w = pk2(s1[8 * ss + 6], s1[8 * ss + 7]); }
              const bf16x8 pa = __builtin_bit_cast(bf16x8, pw);
              __builtin_amdgcn_sched_barrier(0);
#pragma unroll
              for (int dt = 0; dt < 4; ++dt) { const s16x4 lo = vl[g & 1][dt], hi = vh[g & 1][dt];
                  const bf16x8 vb = (bf16x8){lo[0], lo[1], lo[2], lo[3], hi[0], hi[1], hi[2], hi[3]};
                  o[dt] = MFMA32(pa, vb, o[dt]); }
              __builtin_amdgcn_sched_barrier(0); } }
        kA0 ^= D4_BUF; vA0 ^= D4_BUF;
    }
#undef D4_STAGE
    l += __shfl_xor(l, 32);
    if (half == 0) wsc[q] = 1.f / l;
    asm volatile("s_waitcnt lgkmcnt(0)" ::: "memory");
#pragma unroll
    for (int r = 0; r < 16; ++r) { const int qq = crow(r, half); const float a = wsc[qq];
        bf16_t* orow = U + (mb + t0 + qq) * LDU + C_DQ + h * 128 + q;
#pragma unroll
        for (int dt = 0; dt < 4; ++dt) { const bf16_t ov = (bf16_t)f2bf(o[dt][r] * a); if (!dry) orow[dt * 32] = ov; } }
}
__device__ void phase_dsa_attend4(const Params& p, int bid, int nb, unsigned char* lds, bool dry) {
    { float* tb = (float*)(lds + DA_TB);
      for (int e = threadIdx.x; e < 8 * 129; e += NTHREADS) { const int hh = e / 129, d = e % 129; tb[hh * 132 + d] = p.rel_bias[(d < 128 ? (int)T5B[d] : 31) * 8 + hh] * 1.4426950408889634f; }
      if (threadIdx.x < 8) { float mx = -1e30f; for (int bk = 0; bk < 32; ++bk) mx = fmaxf(mx, p.rel_bias[bk * 8 + threadIdx.x]); tb[threadIdx.x * 132 + 129] = mx * 1.4426950408889634f; }
      if (threadIdx.x < 32) ((unsigned*)(lds + D4_CNT))[threadIdx.x] = 0u; }
    __syncthreads();
    const int grp = __builtin_amdgcn_readfirstlane(threadIdx.x >> 8);
    for (int k = bid; k < 256; k += nb) {
        const int ia = k, ib = ((127 - (k >> 2)) << 2) | (k & 3);
#pragma unroll 1
        for (int r = 0; r < 2; ++r) dsa_attend4_item(p, (r ^ grp) ? ib : ia, lds, dry);
    }
    __syncthreads();
}

__device__ void phase_cross_attend(const Params& p, int bid, int nb, unsigned char* lds, bool dry) {
    for (int k = bid; k < 512; k += nb) attend_item<1>(p, k, lds, dry);
}
__device__ void phase_dsa_attend(const Params& p, int bid, int nb, unsigned char* lds, bool dry) {
    { float* tb = (float*)(lds + DA_TB);
      for (int e = threadIdx.x; e < 8 * 129; e += NTHREADS) { const int hh = e / 129, d = e % 129; tb[hh * 132 + d] = p.rel_bias[(d < 128 ? (int)T5B[d] : 31) * 8 + hh] * 1.4426950408889634f; }
      if (threadIdx.x < 8) { float mx = -1e30f; for (int bk = 0; bk < 32; ++bk) mx = fmaxf(mx, p.rel_bias[bk * 8 + threadIdx.x]); tb[threadIdx.x * 132 + 129] = mx * 1.4426950408889634f; } }
    __syncthreads();
    for (int k2 = 2 * bid; k2 < 512; k2 += (k2 & 1) ? 2 * nb - 1 : 1) { const int k = k2 >> 1; attend_item<0>(p, (k2 & 1) ? (((127 - (k >> 2)) << 2) | (k & 3)) : k, lds, dry); }
}


constexpr size_t WS_GD = 44 * MiB;
static_assert(WS_MASK + (size_t)4 * TRI * 128 <= WS_GD && WS_GD + 1024 * 128 * 4 <= WS_U, "ws map (mask, gla decay)");
__device__ __forceinline__ void gla_stage_v(LAS char* vdst, const bf16_t* Uc, int h, int tid) {
    const int lane = tid & 63, wv = __builtin_amdgcn_readfirstlane(tid >> 6), half = lane >> 5, srow = 2 * wv + half, spc = lane & 31;
    const bf16_t* gv = Uc + (size_t)srow * LDU + C_GV + h * 256 + ((spc ^ ((srow & 3) << 2)) << 3);
#pragma unroll
    for (int i = 0; i < 4; ++i) __builtin_amdgcn_global_load_lds((const unsigned*)(gv + (size_t)16 * i * LDU), (LAS unsigned*)(vdst + (wv + 8 * i) * 1024), 16, 0, 0);
}
constexpr int G1_KT = 0, G1_V = 16384, G1_B = 49152, G1_GA = 81920, G1_SEG = 83968, G1_BT = 86016;
__device__ __forceinline__ void gla_g1_item(const Params& p, int item, unsigned char* lds_, bool dry) {
    LAS char* lds = (LAS char*)lds_;
    bf16_t* U = Uptr(p); bf16_t* GS = (bf16_t*)p.out; float* GD = (float*)(p.ws + WS_GD);
    const int tid = opaque_tid(), lane = tid & 63, wv = __builtin_amdgcn_readfirstlane(tid >> 6), half = lane >> 5;
    const int bh = item >> 6, n = item & 63, b = bh >> 2, h = bh & 3;
    bf16_t* Uc = U + ((size_t)b * SEQ + 64 * n) * LDU;
    const int d8 = tid & 15, tg = tid >> 4;
    const u32x4 qa = *(const u32x4*)(Uc + (size_t)(2 * tg) * LDU + C_GQ + h * 128 + 8 * d8), qb = *(const u32x4*)(Uc + (size_t)(2 * tg + 1) * LDU + C_GQ + h * 128 + 8 * d8);
    const u32x4 ka = *(const u32x4*)(Uc + (size_t)(2 * tg) * LDU + C_GK + h * 128 + 8 * d8), kb = *(const u32x4*)(Uc + (size_t)(2 * tg + 1) * LDU + C_GK + h * 128 + 8 * d8);
    u32x4 gav = (u32x4){0u, 0u, 0u, 0u}; if (tid < 128) gav = *(const u32x4*)(Uc + (size_t)(tid >> 1) * LDU + C_GA + 8 * (tid & 1));
    __syncthreads();
    if (tid < 128) *(LAS u32x4*)(lds + G1_GA + tid * 16) = gav;
    gla_stage_v(lds + G1_V, Uc, h, tid);
    __syncthreads();
    { const int d = tid & 127, seg = tid >> 7;
      float w[16];
#pragma unroll
      for (int r = 0; r < 16; ++r) w[r] = p.w_a_up[r * 512 + h * 128 + d];
      const float ba = p.b_a[h * 128 + d];
      float bl[16]; float cum = 0.f;
#pragma unroll
      for (int i = 0; i < 16; ++i) {
          const u32x4 g0 = *(LAS const u32x4*)(lds + G1_GA + (16 * seg + i) * 32), g1 = *(LAS const u32x4*)(lds + G1_GA + (16 * seg + i) * 32 + 16);
          float x = ba;
          x += __uint_as_float(g0.x << 16) * w[0] + __uint_as_float(g0.x & 0xffff0000u) * w[1] + __uint_as_float(g0.y << 16) * w[2] + __uint_as_float(g0.y & 0xffff0000u) * w[3];
          x += __uint_as_float(g0.z << 16) * w[4] + __uint_as_float(g0.z & 0xffff0000u) * w[5] + __uint_as_float(g0.w << 16) * w[6] + __uint_as_float(g0.w & 0xffff0000u) * w[7];
          x += __uint_as_float(g1.x << 16) * w[8] + __uint_as_float(g1.x & 0xffff0000u) * w[9] + __uint_as_float(g1.y << 16) * w[10] + __uint_as_float(g1.y & 0xffff0000u) * w[11];
          x += __uint_as_float(g1.z << 16) * w[12] + __uint_as_float(g1.z & 0xffff0000u) * w[13] + __uint_as_float(g1.w << 16) * w[14] + __uint_as_float(g1.w & 0xffff0000u) * w[15];
          const float sp = __builtin_amdgcn_logf(1.f + __builtin_amdgcn_exp2f(-1.4426950408889634f * fmaxf(x, -80.f)));
          cum += -0.04332169878499658f * sp; bl[i] = cum;
      }
      LAS float* segsum = (LAS float*)(lds + G1_SEG);
      segsum[seg * 128 + d] = cum;
      __syncthreads();
      float off = 0.f, tot = 0.f;
#pragma unroll
      for (int s2 = 0; s2 < 4; ++s2) { const float v = segsum[s2 * 128 + d]; tot += v; if (s2 < seg) off += v; }
#pragma unroll
      for (int i = 0; i < 16; ++i) *(LAS float*)(lds + G1_B + ((16 * seg + i) * 128 + d) * 4) = bl[i] + off;
      if (seg == 0) { *(LAS float*)(lds + G1_BT + d * 4) = tot; GD[(size_t)item * 128 + d] = __builtin_amdgcn_exp2f(1.4426950408889634f * tot); } }
    __syncthreads();
    { unsigned qo[2][4], ko[2][4]; float kt_[2][8];
#pragma unroll
      for (int tt = 0; tt < 2; ++tt) { const int t = 2 * tg + tt; const u32x4 qv = tt ? qb : qa, kv = tt ? kb : ka;
          const f32x4 b0 = *(LAS const f32x4*)(lds + G1_B + (t * 128 + 8 * d8) * 4), b1 = *(LAS const f32x4*)(lds + G1_B + (t * 128 + 8 * d8 + 4) * 4);
          const f32x4 t0 = *(LAS const f32x4*)(lds + G1_BT + (8 * d8) * 4), t1 = *(LAS const f32x4*)(lds + G1_BT + (8 * d8 + 4) * 4);
          float qd[8], kd[8];
#pragma unroll
          for (int e = 0; e < 8; ++e) { const unsigned qw = e < 2 ? qv.x : e < 4 ? qv.y : e < 6 ? qv.z : qv.w, kw = e < 2 ? kv.x : e < 4 ? kv.y : e < 6 ? kv.z : kv.w;
              const float qf = (e & 1) ? __uint_as_float(qw & 0xffff0000u) : __uint_as_float(qw << 16), kf = (e & 1) ? __uint_as_float(kw & 0xffff0000u) : __uint_as_float(kw << 16);
              const float bb = e < 4 ? b0[e & 3] : b1[e & 3], bt = e < 4 ? t0[e & 3] : t1[e & 3];
              const float ep = __builtin_amdgcn_exp2f(1.4426950408889634f * bb), em = __builtin_amdgcn_exp2f(-1.4426950408889634f * bb);
              qd[e] = qf * 0.08838834764831845f * ep; kd[e] = kf * em; kt_[tt][e] = kf * __builtin_amdgcn_exp2f(1.4426950408889634f * (bt - bb)); }
#pragma unroll
          for (int e = 0; e < 4; ++e) { qo[tt][e] = pk2(qd[2 * e], qd[2 * e + 1]); ko[tt][e] = pk2(kd[2 * e], kd[2 * e + 1]); } }
      if (!dry) {
      if (!dry) {
      *(u32x4*)(Uc + (size_t)(2 * tg) * LDU + C_GQ + h * 128 + 8 * d8) = (u32x4){qo[0][0], qo[0][1], qo[0][2], qo[0][3]};
      *(u32x4*)(Uc + (size_t)(2 * tg + 1) * LDU + C_GQ + h * 128 + 8 * d8) = (u32x4){qo[1][0], qo[1][1], qo[1][2], qo[1][3]};
      *(u32x4*)(Uc + (size_t)(2 * tg) * LDU + C_GK + h * 128 + 8 * d8) = (u32x4){ko[0][0], ko[0][1], ko[0][2], ko[0][3]};
      *(u32x4*)(Uc + (size_t)(2 * tg + 1) * LDU + C_GK + h * 128 + 8 * d8) = (u32x4){ko[1][0], ko[1][1], ko[1][2], ko[1][3]}; } }
#pragma unroll
      for (int e = 0; e < 8; ++e) { const int d = 8 * d8 + e; const int ch = (tg >> 2) ^ ((d >> 1) & 7);
          *(LAS unsigned*)(lds + G1_KT + d * 128 + (ch << 4) + (tg & 3) * 4) = pk2(kt_[0][e], kt_[1][e]); } }
    asm volatile("s_waitcnt vmcnt(0)" ::: "memory");
    __syncthreads();
    f32x16 acc[4];
#pragma unroll
    for (int i = 0; i < 4; ++i)
#pragma unroll
        for (int r = 0; r < 16; ++r) acc[i][r] = 0.f;
    const int dk = 32 * (wv & 3) + (lane & 31), q4 = (lane & 15) >> 2, p4 = lane & 3, g1 = (lane >> 4) & 1;
#pragma unroll
    for (int s_ = 0; s_ < 4; ++s_) {
        const bf16x8 a = *(LAS const bf16x8*)(lds + G1_KT + dk * 128 + (((2 * s_ + half) ^ ((dk >> 1) & 7)) << 4));
#pragma unroll
        for (int i = 0; i < 4; ++i) { const int dtile = 4 * (wv >> 2) + i; const int ch = (dtile * 4 + 2 * g1 + (p4 >> 1)) ^ (q4 << 2);
            const s16x4 lo = ds_tr(lds + G1_V + (16 * s_ + 8 * half + q4) * 512 + (ch << 4) + (p4 & 1) * 8);
            const s16x4 hi = ds_tr(lds + G1_V + (16 * s_ + 8 * half + 4 + q4) * 512 + (ch << 4) + (p4 & 1) * 8);
            const bf16x8 vb = (bf16x8){lo[0], lo[1], lo[2], lo[3], hi[0], hi[1], hi[2], hi[3]};
            acc[i] = MFMA32(a, vb, acc[i]); }
    }
    bf16_t* gs = GS + (size_t)item * 32768;
#pragma unroll
    for (int i = 0; i < 4; ++i) { const int dv = 32 * (4 * (wv >> 2) + i) + (lane & 31);
#pragma unroll
        for (int r4 = 0; r4 < 4; ++r4) { u32x2 w2; w2.x = pk2(acc[i][4 * r4], acc[i][4 * r4 + 1]); w2.y = pk2(acc[i][4 * r4 + 2], acc[i][4 * r4 + 3]);
            *(u32x2*)(gs + (size_t)dv * 128 + 32 * (wv & 3) + 8 * r4 + 4 * half) = w2; } }
}
__device__ void phase_gla_g1(const Params& p, int bid, int nb, unsigned char* lds, bool dry) { for (int it = bid; it < 1024; it += nb) gla_g1_item(p, it, lds, dry); }
__device__ void phase_gla_g2(const Params& p, int bid, int nb, bool dry) {
    bf16_t* GS = (bf16_t*)p.out; const float* GD = (const float*)(p.ws + WS_GD);
    for (int e = bid * NTHREADS + threadIdx.x; e < 16 * 8192; e += nb * NTHREADS) {
        const int bh = e >> 13, w = e & 8191, dk4 = (w & 31) * 4;
        bf16_t* gp = GS + (size_t)bh * 64 * 32768 + (size_t)w * 4; const float* dp = GD + (size_t)bh * 64 * 128 + dk4;
        f32x4 S = (f32x4){0.f, 0.f, 0.f, 0.f};
#pragma unroll 8
        for (int n = 0; n < 64; ++n) {
            const u32x2 t2 = *(const u32x2*)(gp + (size_t)n * 32768); const f32x4 dc = *(const f32x4*)(dp + n * 128);
            u32x2 o2; o2.x = pk2(S[0], S[1]); o2.y = pk2(S[2], S[3]); if (!dry) *(u32x2*)(gp + (size_t)n * 32768) = o2;
            S[0] = dc[0] * S[0] + __uint_as_float(t2.x << 16); S[1] = dc[1] * S[1] + __uint_as_float(t2.x & 0xffff0000u);
            S[2] = dc[2] * S[2] + __uint_as_float(t2.y << 16); S[3] = dc[3] * S[3] + __uint_as_float(t2.y & 0xffff0000u);
        }
    }
}
constexpr int G3_QD = 0, G3_KD = 16384, G3_V = 32768, G3_SSQ = 65536;
__device__ __forceinline__ void gla_g3_item(const Params& p, int item, unsigned char* lds_, bool dry) {
    LAS char* lds = (LAS char*)lds_;
    bf16_t* U = Uptr(p); const bf16_t* GS = (const bf16_t*)p.out;
    const int tid = opaque_tid(), lane = tid & 63, wv = __builtin_amdgcn_readfirstlane(tid >> 6), half = lane >> 5, q = lane & 31;
    const int bh = item >> 6, n = item & 63, b = bh >> 2, h = bh & 3;
    bf16_t* Uc = U + ((size_t)b * SEQ + 64 * n) * LDU;
    LAS float* ssq = (LAS float*)(lds + G3_SSQ);
    __syncthreads();
    { const int r4 = lane >> 4, pc = lane & 15;
#pragma unroll
      for (int i = 0; i < 2; ++i) { const int row = 4 * (wv + 8 * i) + r4; const bf16_t* src = Uc + (size_t)row * LDU + h * 128 + ((pc ^ (row & 15)) << 3);
          __builtin_amdgcn_global_load_lds((const unsigned*)(src + C_GQ), (LAS unsigned*)(lds + G3_QD + (wv + 8 * i) * 1024), 16, 0, 0);
          __builtin_amdgcn_global_load_lds((const unsigned*)(src + C_GK), (LAS unsigned*)(lds + G3_KD + (wv + 8 * i) * 1024), 16, 0, 0); } }
    gla_stage_v(lds + G3_V, Uc, h, tid);
    if (tid < 64) ssq[tid] = 0.f;
    bf16x8 sf[8];
    { const bf16_t* sp = GS + (size_t)item * 32768 + (size_t)(32 * wv + q) * 128 + 8 * half;
#pragma unroll
      for (int kk = 0; kk < 8; ++kk) sf[kk] = *(const bf16x8*)(sp + kk * 16); }
    asm volatile("s_waitcnt vmcnt(0)" ::: "memory");
    __syncthreads();
    f32x16 o[2];
#pragma unroll
    for (int tt = 0; tt < 2; ++tt)
#pragma unroll
        for (int r = 0; r < 16; ++r) o[tt][r] = 0.f;
    const int q4 = (lane & 15) >> 2, p4 = lane & 3, g1 = (lane >> 4) & 1;
    const unsigned vA = G3_V + (4 * half + q4) * 512 + ((((wv * 4 + 2 * g1 + (p4 >> 1))) ^ (q4 << 2)) << 4) + (p4 & 1) * 8;
#pragma unroll
    for (int tt = 0; tt < 2; ++tt) {
#pragma unroll
        for (int kk = 0; kk < 8; ++kk) { const int t = 32 * tt + q;
            const bf16x8 a = *(LAS const bf16x8*)(lds + G3_QD + t * 256 + (((2 * kk + half) ^ (t & 15)) << 4));
            o[tt] = MFMA32(a, sf[kk], o[tt]); }
#pragma unroll
        for (int st = 0; st <= tt; ++st) {
            f32x16 x;
#pragma unroll
            for (int r = 0; r < 16; ++r) x[r] = 0.f;
#pragma unroll
            for (int kk = 0; kk < 8; ++kk) { const int srow = 32 * st + q, trow = 32 * tt + q;
                const bf16x8 a = *(LAS const bf16x8*)(lds + G3_KD + srow * 256 + (((2 * kk + half) ^ (srow & 15)) << 4));
                const bf16x8 bq = *(LAS const bf16x8*)(lds + G3_QD + trow * 256 + (((2 * kk + half) ^ (trow & 15)) << 4));
                x = MFMA32(a, bq, x); }
            if (st == tt) {
#pragma unroll
                for (int r = 0; r < 16; ++r) x[r] = (crow(r, half) <= q) ? x[r] : 0.f;
            }
#pragma unroll
            for (int ss = 0; ss < 2; ++ss) {
                u32x4 pw; pw.x = pk2(x[8 * ss], x[8 * ss + 1]); pw.y = pk2(x[8 * ss + 2], x[8 * ss + 3]); pw.z = pk2(x[8 * ss + 4], x[8 * ss + 5]); pw.w = pk2(x[8 * ss + 6], x[8 * ss + 7]);
                const bf16x8 pa = __builtin_bit_cast(bf16x8, pw);
                const s16x4 lo = ds_tr(lds + vA + (32 * st + 16 * ss) * 512);
                const s16x4 hi = ds_tr(lds + vA + (32 * st + 16 * ss + 8) * 512);
                const bf16x8 vb = (bf16x8){lo[0], lo[1], lo[2], lo[3], hi[0], hi[1], hi[2], hi[3]};
                o[tt] = MFMA32(pa, vb, o[tt]);
            }
        }
    }
    __syncthreads();
#pragma unroll
    for (int tt = 0; tt < 2; ++tt)
#pragma unroll
        for (int r = 0; r < 16; ++r) *(LAS float*)(lds + ((32 * tt + crow(r, half)) * 256 + 32 * wv + q) * 4) = o[tt][r];
    __syncthreads();
    { const int t = tid >> 3, sg = tid & 7;
      f32x4 v[8]; float ss = 0.f;
#pragma unroll
      for (int i = 0; i < 8; ++i) { v[i] = *(LAS const f32x4*)(lds + (t * 256 + 32 * sg + 4 * i) * 4); ss += (v[i][0] * v[i][0] + v[i][1] * v[i][1]) + (v[i][2] * v[i][2] + v[i][3] * v[i][3]); }
      ss += __shfl_xor(ss, 1); ss += __shfl_xor(ss, 2); ss += __shfl_xor(ss, 4);
      const float rstd = 1.f / sqrtf(ss * (1.f / 256.f) + EPS);
      const f32x4* gp = (const f32x4*)(p.g_gla + 32 * sg);
      bf16_t* dst = Uc + (size_t)t * LDU + C_GV + h * 256 + 32 * sg;
#pragma unroll
      for (int i = 0; i < 4; ++i) { const f32x4 g0 = gp[2 * i], g1 = gp[2 * i + 1]; if (!dry) st8bf(dst + 8 * i, v[2 * i] * g0 * rstd, v[2 * i + 1] * g1 * rstd); } }
}
__device__ void phase_gla_g3(const Params& p, int bid, int nb, unsigned char* lds, bool dry) { for (int it = bid; it < 1024; it += nb) gla_g3_item(p, it, lds, dry); }

__device__ void phase_cross_ref(const Params& p, int bid, int nb, unsigned char* lds) {
    float* qs = (float*)lds;
    float* lg = qs + 1024;
    bf16_t* U = Uptr(p); const bf16_t* MKV = (const bf16_t*)(p.ws + WS_MKV);
    const int tid = threadIdx.x, lane = tid & 63, wave = tid >> 6;
    for (int it = bid; it < MTOK; it += nb) {
        const int b = it / SEQ; const size_t m = (size_t)it; const bf16_t* mb = MKV + (size_t)b * NMEM * 2048;
        __syncthreads();
        qs[tid] = bf2f(U[m * LDU + C_XQ + tid]) * 0.0625f; qs[tid + 512] = bf2f(U[m * LDU + C_XQ + 512 + tid]) * 0.0625f;
        __syncthreads();
        { const int j = tid & 255, hp = tid >> 8;
          const bf16_t* kr = mb + (size_t)j * 2048 + hp * 512; float a0 = 0.f, a1 = 0.f;
          for (int d0 = 0; d0 < 256; d0 += 8) { const bf16x8 k0 = *(const bf16x8*)(kr + d0); const bf16x8 k1 = *(const bf16x8*)(kr + 256 + d0);
#pragma unroll
              for (int dd = 0; dd < 8; ++dd) { a0 += qs[hp * 512 + d0 + dd] * bf2f((bf16_t)k0[dd]); a1 += qs[hp * 512 + 256 + d0 + dd] * bf2f((bf16_t)k1[dd]); } }
          lg[(2 * hp) * 256 + j] = a0; lg[(2 * hp + 1) * 256 + j] = a1; }
        __syncthreads();
        if (wave < 4) { float v[4]; float mx = -3e38f;
#pragma unroll
            for (int i = 0; i < 4; ++i) { v[i] = lg[wave * 256 + lane + 64 * i]; mx = fmaxf(mx, v[i]); }
            mx = wave_max(mx); float sm = 0.f;
#pragma unroll
            for (int i = 0; i < 4; ++i) { v[i] = __expf(v[i] - mx); sm += v[i]; }
            sm = wave_sum(sm); const float inv = 1.f / sm;
#pragma unroll
            for (int i = 0; i < 4; ++i) lg[wave * 256 + lane + 64 * i] = v[i] * inv; }
        __syncthreads();
        { const int h = tid >> 7, d = (tid & 127) * 2; float o0 = 0.f, o1 = 0.f;
          for (int j = 0; j < NMEM; ++j) { const float pj = lg[h * 256 + j]; const unsigned w = *(const unsigned*)(mb + (size_t)j * 2048 + 1024 + h * 256 + d);
              o0 += pj * __uint_as_float(w << 16); o1 += pj * __uint_as_float(w & 0xffff0000u); }
          *(unsigned*)(U + m * LDU + C_XQ + h * 256 + d) = pk2(o0, o1); }
    }
}

__device__ void phase_final(const Params& p, int bid, int nb, bool dry) {
    const int lane = threadIdx.x & 63, wave = threadIdx.x >> 6; const bf16_t* U = Uptr(p);
    for (int m = bid * NWAVES + wave; m < MTOK; m += nb * NWAVES) {
        f32x4* orow = (f32x4*)(p.out + (size_t)m * DM) + lane; const f32x4* xr = (const f32x4*)(p.x + (size_t)m * DM) + lane; const f32x4* gr = (const f32x4*)p.g_post + lane;
        const bf16_t* ob = U + (size_t)m * LDU + C_H + 4 * lane;
        f32x4 v[4]; float s = 0.f;
#pragma unroll
        for (int j = 0; j < 4; ++j) { v[j] = ld4bf(ob + 256 * j); s += (v[j].x * v[j].x + v[j].y * v[j].y) + (v[j].z * v[j].z + v[j].w * v[j].w); }
        const float rstd = 1.f / sqrtf(wave_sum(s) * (1.f / DM) + EPS);
#pragma unroll
        for (int j = 0; j < 4; ++j) { const f32x4 ov = xr[64 * j] + v[j] * rstd * gr[64 * j]; if (!dry) orow[64 * j] = ov; }
    }
}

#define XB_TMO      128
#define XB_XCNT(j)  (256  + 64 * (j))
#define XB_XSUB(j)  (1280 + 64 * (j))
#define XB_XGEN(j)  (2304 + 64 * (j))
#define XB_TOP      3328
#define XB_TOPGEN   3392
#define XCD_BAR_WORDS 3456
#define XB_SPIN_CAP (1u << 22)
constexpr size_t WS_BAR = 46 * MiB;
__device__ __forceinline__ unsigned xb_ld(unsigned* p)              { return __hip_atomic_load(p, __ATOMIC_RELAXED, __HIP_MEMORY_SCOPE_AGENT); }
__device__ __forceinline__ unsigned xb_add(unsigned* p, unsigned v) { return __hip_atomic_fetch_add(p, v, __ATOMIC_RELAXED, __HIP_MEMORY_SCOPE_AGENT); }
__device__ __forceinline__ unsigned xb_xcc_id() { return (unsigned)__builtin_amdgcn_s_getreg((3 << 11) | 20) & 0xFu; }
#define XB_SPIN(cond, bar) do { unsigned _sp = 0; while (cond) { __builtin_amdgcn_s_sleep(1); \
    if ((++_sp & 255u) == 0u) { if (xb_ld(&(bar)[XB_TMO])) break; if (_sp > XB_SPIN_CAP) { atomicAdd(&(bar)[XB_TMO], 1u); break; } } } } while (0)
struct XcdBarrier { unsigned* bar; unsigned x; volatile LAS unsigned* st; };
__device__ __forceinline__ XcdBarrier xcd_barrier_post(unsigned* bar, volatile LAS unsigned* st) {
    XcdBarrier b; b.bar = bar; b.x = xb_xcc_id(); b.st = st;
    if (threadIdx.x == 0) (void)xb_add(&bar[XB_XCNT(b.x)], 1u);
    return b;
}
__device__ __forceinline__ void xcd_barrier_complete(unsigned* bar, unsigned x, unsigned& nloc, unsigned& nx) {
    const unsigned G = gridDim.x * gridDim.y * gridDim.z;
    unsigned sum, cnt, mine, sp = 0u;
    for (;;) {
        sum = 0u; cnt = 0u; mine = 0u;
#pragma unroll
        for (unsigned j = 0; j < 16; ++j) { const unsigned c = xb_ld(&bar[XB_XCNT(j)]); sum += c; cnt += (c > 0u) ? 1u : 0u; mine = (j == x) ? c : mine; }
        if (sum == G) break;
        __builtin_amdgcn_s_sleep(1);
        if ((++sp & 255u) == 0u) { if (xb_ld(&bar[XB_TMO])) break; if (sp > XB_SPIN_CAP) { atomicAdd(&bar[XB_TMO], 1u); break; } }
    }
    nloc = mine > 0u ? mine : 1u; nx = cnt > 0u ? cnt : 1u;
}
__device__ __forceinline__ void xcd_barrier(const XcdBarrier& b) {
    asm volatile("s_waitcnt vmcnt(0)" ::: "memory");
    __syncthreads();
    if (threadIdx.x == 0) {
        unsigned* bar = b.bar;
        __builtin_amdgcn_s_waitcnt(0);
        unsigned nloc = b.st[0], nx = b.st[1];
        if (nloc == 0u) { xcd_barrier_complete(bar, b.x, nloc, nx); b.st[0] = nloc; b.st[1] = nx; }
        const unsigned old = xb_add(&bar[XB_XSUB(b.x)], 1u);
        const unsigned gen = old / nloc;
        if (old + 1u == (gen + 1u) * nloc) {
            __builtin_amdgcn_fence(__ATOMIC_RELEASE, "agent");
            asm volatile("s_waitcnt vmcnt(0)" ::: "memory");
            const unsigned og = xb_add(&bar[XB_TOP], 1u);
            const unsigned tg = og / nx;
            if (og + 1u == (tg + 1u) * nx) xb_add(&bar[XB_TOPGEN], 1u);
            else XB_SPIN(xb_ld(&bar[XB_TOPGEN]) == tg, bar);
            __builtin_amdgcn_fence(__ATOMIC_ACQUIRE, "agent");
            xb_add(&bar[XB_XGEN(b.x)], 1u);
            asm volatile("s_waitcnt vmcnt(0)" ::: "memory");
        } else {
            XB_SPIN(xb_ld(&bar[XB_XGEN(b.x)]) == gen, bar);
            __builtin_amdgcn_fence(__ATOMIC_ACQUIRE, "agent");
            asm volatile("s_waitcnt vmcnt(0)" ::: "memory");
        }
    }
    __syncthreads();
}

constexpr int NPHASE = 9;
constexpr int LDS_BYTES = 144 * 1024;
#ifndef USE_PG8
#define USE_PG8 1
#endif
__device__ __forceinline__ void run_phase(const Params& p, int ph, int bid, int nb, unsigned char* lds, bool dry = false) {
    bf16_t* U = Uptr(p); const bf16_t* WT = (const bf16_t*)(p.ws + WS_WTALL);
    bf16_t* S2 = (bf16_t*)p.out; float* oraw = p.out;
    PG8_LAS unsigned char* lds3 = (PG8_LAS unsigned char*)lds;
    switch (ph) {
    case 0: phase_prep(p, bid, nb, lds, 0); break;
    case 1: { OpStoreBf16 o1{U, LDU, 1024}; OpStoreBf16 o2{(bf16_t*)(p.ws + WS_MKV), 2048, 0};
#if USE_PG8
              pg8::Sched S{}; S.j[0] = pg8::Job{U + C_H, WT, MTOK / 256, N1 / 256}; S.j[1] = pg8::Job{(const bf16_t*)p.out, (const bf16_t*)(p.ws + WS_WTMKV), MMEM / 256, 2048 / 256};
              S.njobs = 2; S.rep = 1; S.G = nb; S.c = bid; S.lda = LDU; S.astride = 0; S.bstride = 0;
              pg8::Epi<SelP1> E{SelP1{o1, o2}}; pg8::gemm_phase<pg8::Epi<SelP1>, true>(lds3, S, E);
              { const int nun = (MTOK / 256) * (N1 / 256) + (MMEM / 256) * (2048 / 256), extra = nun % nb;
                if (extra == 0) phase_prep(p, bid, nb, lds, 1); else if (bid >= extra) phase_prep(p, bid - extra, nb - extra, lds, 1); }
#else
              gemm_simple(U + C_H, LDU, WT, MTOK, N1, DM, o1, bid, nb); gemm_simple((const bf16_t*)p.out, LDU, (const bf16_t*)(p.ws + WS_WTMKV), MMEM, 2048, DM, o2, bid, nb); phase_prep(p, bid, nb, lds, 1);
#endif
            } break;
#if !defined(DSA_REF) && !defined(GLA_REF)
    case 2: if (bid & 1) { phase_dsa_select2(p, bid, nb, lds); phase_gla_g1(p, bid, nb, lds, dry); } else { phase_gla_g1(p, bid, nb, lds, dry); phase_dsa_select2(p, bid, nb, lds); } break;
    case 3: if (bid & 1) { phase_dsa_attend4(p, bid, nb, lds, dry); phase_gla_g2(p, bid, nb, dry); } else { phase_gla_g2(p, bid, nb, dry); phase_dsa_attend4(p, bid, nb, lds, dry); } break;
#elif !defined(DSA_REF)
    case 2: phase_gla_rec(p, oraw, bid, nb, lds); phase_dsa_select(p, bid, nb, lds); break;
    case 3: phase_gla_norm(p, oraw, bid, nb); phase_dsa_attend(p, bid, nb, lds, dry); break;
#else
    case 2: phase_gla_rec(p, oraw, bid, nb, lds); break;
    case 3: phase_gla_norm(p, oraw, bid, nb); phase_dsa_ref(p, bid, nb, lds); break;
#endif
#ifndef CROSS_REF
    case 4:
#ifndef GLA_REF
        if (bid & 1) { phase_cross_attend(p, bid, nb, lds, dry); phase_gla_g3(p, bid, nb, lds, dry); } else { phase_gla_g3(p, bid, nb, lds, dry); phase_cross_attend(p, bid, nb, lds, dry); }
#else
        phase_cross_attend(p, bid, nb, lds, dry);
#endif
        break;
#else
    case 4: phase_cross_ref(p, bid, nb, lds); break;
#endif
    case 5: { OpZGate oz{U, dry}; OpSig os{S2, U};
#if USE_PG8
              pg8::Sched S{}; S.j[0] = pg8::Job{U + C_H, WT + (size_t)WT_Z * DM, MTOK / 256, 3072 / 256}; S.j[1] = pg8::Job{U + C_H, WT + (size_t)WT_G * DM, MTOK / 256, 3072 / 256};
              S.njobs = 2; S.rep = 1; S.G = nb; S.c = bid; S.lda = LDU; S.astride = 0; S.bstride = 0;
              pg8::Epi<SelP5> E{SelP5{oz, os}}; pg8::gemm_phase<pg8::Epi<SelP5>, true>(lds3, S, E);
#else
              gemm_simple(U + C_H, LDU, WT + (size_t)WT_Z * DM, MTOK, 3072, DM, oz, bid, nb); gemm_simple(U + C_H, LDU, WT + (size_t)WT_G * DM, MTOK, 3072, DM, os, bid, nb);
#endif
            } break;
    case 6: {
#if USE_PG8
              pg8::Sched S{}; S.j[0] = pg8::Job{U + C_GV, (const bf16_t*)(p.ws + WS_WTGO), MTOK / 256, DM / 256};
              S.njobs = 1; S.rep = 3; S.G = nb; S.c = bid; S.lda = LDU; S.astride = 1024; S.bstride = (long)(WS_WTDO - WS_WTGO) / 2;
              pg8::Epi<SelP6> E{SelP6{S2, U}}; pg8::gemm_phase<pg8::Epi<SelP6>, true>(lds3, S, E);
#else
              gemm_simple(U + C_GV, LDU, (const bf16_t*)(p.ws + WS_WTGO), MTOK, DM, DM, m0, bid, nb);
              gemm_simple(U + C_DQ, LDU, (const bf16_t*)(p.ws + WS_WTDO), MTOK, DM, DM, m1, bid, nb);
              gemm_simple(U + C_XQ, LDU, (const bf16_t*)(p.ws + WS_WTXO), MTOK, DM, DM, m2, bid, nb);
#endif
            } break;
    case 7: { OpStoreBf16 oo{U, LDU, C_H};
#if USE_PG8
              pg8::Sched S{}; S.j[0] = pg8::Job{U + C_MG, (const bf16_t*)(p.ws + WS_WTO), MTOK / 256, DM / 256};
              S.njobs = 1; S.rep = 1; S.G = nb; S.c = bid; S.lda = LDU; S.astride = 0; S.bstride = 0;
              pg8::Epi<SelP7> E{SelP7{oo}}; pg8::gemm_phase<pg8::Epi<SelP7>, false>(lds3, S, E);
#else
              gemm_simple(U + C_MG, LDU, (const bf16_t*)(p.ws + WS_WTO), MTOK, DM, DM, oo, bid, nb);
#endif
            } break;
    case 8: phase_final(p, bid, nb, dry); break;
    }
}

#if ONE_LAUNCH
__global__ void __launch_bounds__(NTHREADS) fwd_mega(Params p) {
    extern __shared__ __attribute__((aligned(16))) unsigned char lds[];
    cg::grid_group grid = cg::this_grid();
    const int bid = blockIdx.x, nb = gridDim.x;
    volatile LAS unsigned* xst = (volatile LAS unsigned*)((LAS unsigned char*)lds + LDS_BYTES - 16);
    unsigned* barw = (unsigned*)(p.ws + WS_BAR);
    if (threadIdx.x < 4) xst[threadIdx.x] = 0u;
    __syncthreads();
    if (p.ws == nullptr) grid.sync();
    const XcdBarrier xbar = xcd_barrier_post(barw, xst);
#ifdef PROF_PHASE
#define PROF_DUP(k) if (PROF_PHASE == (k)) { run_phase(p, (k), bid, nb, lds, p.g_pre != nullptr); GSYNC(); } \
    if (PROF_PHASE == 10 * (k) + 0) { const bool dry_ = p.g_pre != nullptr; if ((k) == 2) phase_gla_g1(p, bid, nb, lds, dry_); if ((k) == 3) phase_gla_g2(p, bid, nb, dry_); if ((k) == 4) phase_gla_g3(p, bid, nb, lds, dry_); GSYNC(); } \
    if (PROF_PHASE == 10 * (k) + 1) { const bool dry_ = p.g_pre != nullptr; if ((k) == 2) phase_dsa_select2(p, bid, nb, lds); if ((k) == 3) phase_dsa_attend4(p, bid, nb, lds, dry_); if ((k) == 4) phase_cross_attend(p, bid, nb, lds, dry_); GSYNC(); }
#else
#define PROF_DUP(k)
#endif
#define GSYNC() xcd_barrier(xbar)
#if defined(PROF_PHASE) && PROF_PHASE >= 100
    unsigned long long ts_[10]; int nts_ = 0;
#define STAMP() do { ts_[nts_++] = __builtin_amdgcn_s_memrealtime(); } while (0)
#else
#define STAMP() do {} while (0)
#endif
    STAMP();
    PROF_DUP(0) run_phase(p, 0, bid, nb, lds); GSYNC(); STAMP();
    PROF_DUP(1) run_phase(p, 1, bid, nb, lds); GSYNC(); STAMP();
    PROF_DUP(2) run_phase(p, 2, bid, nb, lds); GSYNC(); STAMP();
    PROF_DUP(3) run_phase(p, 3, bid, nb, lds); GSYNC(); STAMP();
    PROF_DUP(4) run_phase(p, 4, bid, nb, lds); GSYNC(); STAMP();
    PROF_DUP(5) run_phase(p, 5, bid, nb, lds); GSYNC(); STAMP();
    PROF_DUP(6) run_phase(p, 6, bid, nb, lds); GSYNC(); STAMP();
    PROF_DUP(7) run_phase(p, 7, bid, nb, lds); GSYNC(); STAMP();
    PROF_DUP(8) run_phase(p, 8, bid, nb, lds);
#if defined(PROF_PHASE) && PROF_PHASE >= 100
    GSYNC(); STAMP();
    if (bid == 0 && threadIdx.x == 0) { const int k_ = PROF_PHASE - 100; const float us_ = (PROF_PHASE == 200) ? (float)(ts_[9] - ts_[0]) * 0.01f * 0.2f : (float)(ts_[k_ + 1] - ts_[k_]) * 0.01f; p.out[0] = us_ * 0.2f; }
#endif
#undef GSYNC
}
#else
template <int PH> __global__ void __launch_bounds__(NTHREADS) fwd_phase(Params p) {
    extern __shared__ __attribute__((aligned(16))) unsigned char lds[];
    run_phase(p, PH, blockIdx.x, gridDim.x, lds);
}
#endif

extern "C" void kernel_launch(void* const* d_in, const int* in_sizes, int n_in, void* d_out, int out_size, void* d_ws, size_t ws_size, hipStream_t stream) {
    if (n_in != 15 || out_size != MTOK * DM || ws_size < WS_END) { fprintf(stderr, "kernel_launch: unexpected shapes (n_in %d out %d ws %zu)\n", n_in, out_size, ws_size); return; }
    Params p{};
    p.x = (const float*)d_in[0]; p.mem = (const float*)d_in[1]; p.g_pre = (const float*)d_in[2]; p.g_post = (const float*)d_in[3]; p.g_mem = (const float*)d_in[4];
    p.w_in = (const float*)d_in[5]; p.w_a_up = (const float*)d_in[6]; p.b_a = (const float*)d_in[7]; p.g_gla = (const float*)d_in[8]; p.rel_bias = (const float*)d_in[9];
    p.w_mem_kv = (const float*)d_in[10]; p.w_gla_out = (const float*)d_in[11]; p.w_dsa_out = (const float*)d_in[12]; p.w_x_out = (const float*)d_in[13]; p.w_o = (const float*)d_in[14];
    p.out = (float*)d_out; p.ws = (unsigned char*)d_ws;
#if ONE_LAUNCH
    static int grid_blocks = 0;
    if (!grid_blocks) {
        int dev = 0, cus = 0, per_cu = 0;
        hipGetDevice(&dev); hipDeviceGetAttribute(&cus, hipDeviceAttributeMultiprocessorCount, dev);
        hipFuncSetAttribute((const void*)fwd_mega, hipFuncAttributeMaxDynamicSharedMemorySize, LDS_BYTES);
        hipOccupancyMaxActiveBlocksPerMultiprocessor(&per_cu, (const void*)fwd_mega, NTHREADS, LDS_BYTES);
        if (per_cu < 1) per_cu = 1;
        grid_blocks = cus * per_cu;
    }
    (void)hipMemsetAsync((unsigned char*)d_ws + WS_BAR, 0, XCD_BAR_WORDS * 4, stream);
    void* args[] = {&p};
    hipError_t e = hipLaunchCooperativeKernel((void*)fwd_mega, dim3(grid_blocks), dim3(NTHREADS), args, LDS_BYTES, stream);
    if (e != hipSuccess) fprintf(stderr, "cooperative launch failed: %s (grid %d)\n", hipGetErrorString(e), grid_blocks);
#else
    const int G = 1024;
    static bool attr_done = false;
#define LAUNCH(PH) do { if (!attr_done) (void)hipFuncSetAttribute((const void*)fwd_phase<PH>, hipFuncAttributeMaxDynamicSharedMemorySize, LDS_BYTES); hipLaunchKernelGGL(fwd_phase<PH>, dim3(G), dim3(NTHREADS), LDS_BYTES, stream, p); } while (0)
    LAUNCH(0); LAUNCH(1); LAUNCH(2); LAUNCH(3); LAUNCH(4); LAUNCH(5); LAUNCH(6); LAUNCH(7); LAUNCH(8);
    attr_done = true;
#undef LAUNCH
#endif
}
```

```cpp
#include <hip/hip_runtime.h>
#include <hip/hip_cooperative_groups.h>
#include <cstdio>
#include <cstdint>
namespace cg = cooperative_groups;

#ifndef ONE_LAUNCH
#define ONE_LAUNCH 1
#endif

typedef unsigned short bf16_t;
typedef short bf16x8 __attribute__((ext_vector_type(8)));
typedef float f32x4 __attribute__((ext_vector_type(4)));
typedef unsigned u32x2 __attribute__((ext_vector_type(2)));
typedef unsigned u32x4 __attribute__((ext_vector_type(4)));

constexpr int NBATCH = 4, SEQ = 4096, DM = 1024, MTOK = NBATCH * SEQ;
constexpr int NMEM = 256, MMEM = NBATCH * NMEM;
constexpr int WIN_COLS = 11352;
constexpr float EPS = 1e-6f;
constexpr int NTHREADS = 512, NWAVES = 8;
constexpr int LDU = 6400;
constexpr int C_H = 0, C_GV = 1024, C_DQ = 2048, C_XQ = 3072, C_GQ = 4096, C_GK = 4608, C_DK = 5120, C_DV = 5376, C_IQ = 5632, C_IK = 6144, C_GA = 6208, C_IW = 6224;
constexpr int C_SM = 4096;
constexpr int C_MG = 5120;
constexpr int N1 = 5376;
constexpr int WT_Z = 5376, WT_G = 8448, WT_ROWS = 11520;
constexpr size_t MiB = 1u << 20;
constexpr size_t WS_WTALL = 0, WS_WTMKV = 23 * MiB, WS_WTGO = 27 * MiB, WS_WTDO = 29 * MiB, WS_WTXO = 31 * MiB, WS_WTO = 33 * MiB;
constexpr size_t WS_MKV = 35 * MiB, WS_MASK = 39 * MiB  , WS_U = 48 * MiB, WS_END = 248 * MiB;
static_assert(WS_U + (size_t)MTOK * LDU * 2 == WS_END && WS_END <= 256 * MiB, "ws map");

struct Params {
    const float *x, *mem, *g_pre, *g_post, *g_mem, *w_in, *w_a_up, *b_a, *g_gla, *rel_bias, *w_mem_kv, *w_gla_out, *w_dsa_out, *w_x_out, *w_o;
    float* out; unsigned char* ws;
};

__device__ const unsigned char T5B[128] = {0, 1, 2, 3, 4, 5, 6, 7, 8, 9, 10, 11, 12, 13, 14, 15, 16, 16, 16, 17, 17, 18, 18, 18, 19, 19, 19, 20, 20, 20, 20, 21, 21, 21, 21, 22, 22, 22, 22, 22, 23, 23, 23, 23, 23, 23, 24, 24, 24, 24, 24, 24, 25, 25, 25, 25, 25, 25, 25, 26, 26, 26, 26, 26, 26, 26, 26, 27, 27, 27, 27, 27, 27, 27, 27, 27, 27, 28, 28, 28, 28, 28, 28, 28, 28, 28, 28, 29, 29, 29, 29, 29, 29, 29, 29, 29, 29, 29, 29, 30, 30, 30, 30, 30, 30, 30, 30, 30, 30, 30, 30, 30, 30, 31, 31, 31, 31, 31, 31, 31, 31, 31, 31, 31, 31, 31, 31, 31};

__device__ __forceinline__ float bf2f(bf16_t b) { return __uint_as_float((unsigned)b << 16); }
__device__ __forceinline__ unsigned f2bf(float f) { unsigned u = __float_as_uint(f); return (u + 0x7fffu + ((u >> 16) & 1u)) >> 16; }
typedef float f32x2_t_ __attribute__((ext_vector_type(2))); typedef __bf16 bf16x2_t_ __attribute__((ext_vector_type(2)));
__device__ __forceinline__ unsigned pk2(float lo, float hi) { f32x2_t_ v = {lo, hi}; bf16x2_t_ b = __builtin_convertvector(v, bf16x2_t_); return __builtin_bit_cast(unsigned, b); }
__device__ __forceinline__ float xhalf_max(float x) { const auto r = __builtin_amdgcn_permlane32_swap(__float_as_uint(x), __float_as_uint(x), false, false); return fmaxf(__uint_as_float(r[0]), __uint_as_float(r[1])); }
__device__ __forceinline__ float xhalf_sum(float x) { const auto r = __builtin_amdgcn_permlane32_swap(__float_as_uint(x), __float_as_uint(x), false, false); return __uint_as_float(r[0]) + __uint_as_float(r[1]); }
__device__ __forceinline__ float wave_sum(float v) {
    v += __builtin_bit_cast(float, __builtin_amdgcn_update_dpp(0, __builtin_bit_cast(int, v), 0x128, 0xf, 0xf, true)); v += __builtin_bit_cast(float, __builtin_amdgcn_update_dpp(0, __builtin_bit_cast(int, v), 0x124, 0xf, 0xf, true));
    v += __builtin_bit_cast(float, __builtin_amdgcn_update_dpp(0, __builtin_bit_cast(int, v), 0x122, 0xf, 0xf, true)); v += __builtin_bit_cast(float, __builtin_amdgcn_update_dpp(0, __builtin_bit_cast(int, v), 0x121, 0xf, 0xf, true));
    { const auto r = __builtin_amdgcn_permlane16_swap(__float_as_uint(v), __float_as_uint(v), false, false); v = __uint_as_float(r[0]) + __uint_as_float(r[1]); }
    { const auto r = __builtin_amdgcn_permlane32_swap(__float_as_uint(v), __float_as_uint(v), false, false); v = __uint_as_float(r[0]) + __uint_as_float(r[1]); }
    return v;
}
__device__ __forceinline__ float wave_max(float v) {
#pragma unroll
    for (int o = 1; o < 64; o <<= 1) v = fmaxf(v, __shfl_xor(v, o));
    return v;
}
__device__ __forceinline__ int opaque_tid() { int t = threadIdx.x; asm volatile("" : "+v"(t)); return t; }
__device__ __forceinline__ bf16_t* Uptr(const Params& p) { return (bf16_t*)(p.ws + WS_U); }

__device__ __forceinline__ int win_src_col(int r) {
    if (r < 1024) return 1024 + r;
    if (r < 2048) return 3088 + (r - 1024);
    if (r < 3072) return 6232 + (r - 2048);
    if (r < 3584) return r - 3072;
    if (r < 4096) return 512 + (r - 3584);
    if (r < 4352) return 4112 + (r - 4096);
    if (r < 4608) return 4368 + (r - 4352);
    if (r < 5120) return 4624 + (r - 4608);
    if (r < 5184) return 5136 + (r - 5120);
    if (r < 5200) return 2048 + (r - 5184);
    if (r < 5208) return 5200 + (r - 5200);
    if (r < 5376) return -1;
    if (r < 6400) return 2064 + (r - 5376);
    if (r < 7424) return 5208 + (r - 6400);
    if (r < 8448) return 7256 + (r - 7424);
    return 8280 + (r - 8448);
}

#define LAS_ __attribute__((address_space(3)))
template <bool MAP>
__device__ __forceinline__ void transpose_item(const float* W, int ldw, int K, bf16_t* WT, LAS_ float* scr  , int item, int lane) {
    const int nkb = K / 64, nb = item / nkb, kb = item % nkb, k0 = 64 * kb, n0 = 64 * nb;
    const int n4 = n0 + 4 * (lane & 15);
    const int c = MAP ? win_src_col(n4) : n4;
    f32x4 v[16];
#pragma unroll
    for (int i = 0; i < 16; ++i) { const int kk = 4 * i + (lane >> 4);
        v[i] = (c >= 0) ? *(const f32x4*)(W + (size_t)(k0 + kk) * ldw + c) : (f32x4){0.f, 0.f, 0.f, 0.f}; }
#pragma unroll
    for (int i = 0; i < 16; ++i) { const int kk = 4 * i + (lane >> 4); *(LAS_ f32x4*)(scr + kk * 68 + 4 * (lane & 15)) = v[i]; }
    asm volatile("s_waitcnt lgkmcnt(0)" ::: "memory");
#pragma unroll
    for (int c8 = 0; c8 < 8; ++c8) { LAS_ const float* s_ = scr + (8 * c8) * 68 + lane;
        u32x4 o; o.x = pk2(s_[0 * 68], s_[1 * 68]); o.y = pk2(s_[2 * 68], s_[3 * 68]); o.z = pk2(s_[4 * 68], s_[5 * 68]); o.w = pk2(s_[6 * 68], s_[7 * 68]);
        *(u32x4*)(WT + (size_t)(n0 + lane) * K + k0 + 8 * c8) = o; }
    asm volatile("s_waitcnt lgkmcnt(0)" ::: "memory");
}
__device__ __forceinline__ void rms_row_to_bf16(const float* xrow, const float* g, bf16_t* orow, int lane) {
    const f32x4* xr = (const f32x4*)xrow + lane; const f32x4* gr = (const f32x4*)g + lane;
    f32x4 v[4]; float s = 0.f;
#pragma unroll
    for (int j = 0; j < 4; ++j) { v[j] = xr[64 * j]; s += (v[j].x * v[j].x + v[j].y * v[j].y) + (v[j].z * v[j].z + v[j].w * v[j].w); }
    const float rstd = 1.f / sqrtf(wave_sum(s) * (1.f / DM) + EPS);
    unsigned long long* o8 = (unsigned long long*)orow + lane;
#pragma unroll
    for (int j = 0; j < 4; ++j) { const f32x4 gg = gr[64 * j];
        o8[64 * j] = (unsigned long long)pk2(v[j].x * rstd * gg.x, v[j].y * rstd * gg.y) | ((unsigned long long)pk2(v[j].z * rstd * gg.z, v[j].w * rstd * gg.w) << 32); }
}
__device__ __forceinline__ void phase_prep(const Params& p, int bid, int nb, unsigned char* lds, int part) {
    const int tid = threadIdx.x, lane = tid & 63, wave = tid >> 6;
    LAS_ float* scr = (LAS_ float*)lds + wave * (64 * 68);
    const int gw = bid * NWAVES + wave, NGW = nb * NWAVES;
    constexpr int I_G1 = (N1 / 64) * (DM / 64), I_ALL = (WT_ROWS / 64) * (DM / 64), I_MKV = (2048 / 64) * (DM / 64), I_SQ = (DM / 64) * (DM / 64);
    if (part == 0) {
        for (int it = gw; it < I_G1 + I_MKV; it += NGW) {
            if (it < I_G1) transpose_item<true>(p.w_in, WIN_COLS, DM, (bf16_t*)(p.ws + WS_WTALL), scr, it, lane);
            else transpose_item<false>(p.w_mem_kv, 2048, DM, (bf16_t*)(p.ws + WS_WTMKV), scr, it - I_G1, lane);
        }
        bf16_t* U = Uptr(p);
        for (int m = gw; m < MMEM; m += NGW) rms_row_to_bf16(p.mem + (size_t)m * DM, p.g_mem, (bf16_t*)p.out + (size_t)m * LDU, lane);
        { f32x4 gg[4];
#pragma unroll
          for (int j = 0; j < 4; ++j) gg[j] = ((const f32x4*)p.g_pre)[lane + 64 * j];
          for (int m0 = gw; m0 < MTOK; m0 += 8 * NGW) {
              f32x4 v[8][4];
#pragma unroll
              for (int r = 0; r < 8; ++r) { const int m = m0 + r * NGW;
                  if (m < MTOK) {
#pragma unroll
                      for (int j = 0; j < 4; ++j) v[r][j] = ((const f32x4*)(p.x + (size_t)m * DM))[lane + 64 * j]; } }
#pragma unroll
              for (int r = 0; r < 8; ++r) { const int m = m0 + r * NGW;
                  if (m < MTOK) { float s_ = 0.f;
#pragma unroll
                      for (int j = 0; j < 4; ++j) s_ += (v[r][j].x * v[r][j].x + v[r][j].y * v[r][j].y) + (v[r][j].z * v[r][j].z + v[r][j].w * v[r][j].w);
                      const float rstd = 1.f / sqrtf(wave_sum(s_) * (1.f / DM) + EPS);
                      unsigned long long* o8 = (unsigned long long*)(U + (size_t)m * LDU + C_H) + lane;
#pragma unroll
                      for (int j = 0; j < 4; ++j) o8[64 * j] = (unsigned long long)pk2(v[r][j].x * rstd * gg[j].x, v[r][j].y * rstd * gg[j].y) | ((unsigned long long)pk2(v[r][j].z * rstd * gg[j].z, v[r][j].w * rstd * gg[j].w) << 32); } } } }
    } else {
        for (int it = gw; it < (I_ALL - I_G1) + 4 * I_SQ; it += NGW) {
            int r = it;
            if (r < I_ALL - I_G1) { transpose_item<true>(p.w_in, WIN_COLS, DM, (bf16_t*)(p.ws + WS_WTALL), scr, I_G1 + r, lane); continue; } r -= I_ALL - I_G1;
            if (r < I_SQ) { transpose_item<false>(p.w_gla_out, DM, DM, (bf16_t*)(p.ws + WS_WTGO), scr, r, lane); continue; } r -= I_SQ;
            if (r < I_SQ) { transpose_item<false>(p.w_dsa_out, DM, DM, (bf16_t*)(p.ws + WS_WTDO), scr, r, lane); continue; } r -= I_SQ;
            if (r < I_SQ) { transpose_item<false>(p.w_x_out, DM, DM, (bf16_t*)(p.ws + WS_WTXO), scr, r, lane); continue; } r -= I_SQ;
            transpose_item<false>(p.w_o, DM, DM, (bf16_t*)(p.ws + WS_WTO), scr, r, lane);
        }
    }
}

__device__ __forceinline__ void ld8bf(const bf16_t* q, f32x4& a, f32x4& b) { const u32x4 w = *(const u32x4*)q; a[0] = __uint_as_float(w.x << 16); a[1] = __uint_as_float(w.x & 0xffff0000u); a[2] = __uint_as_float(w.y << 16); a[3] = __uint_as_float(w.y & 0xffff0000u);
    b[0] = __uint_as_float(w.z << 16); b[1] = __uint_as_float(w.z & 0xffff0000u); b[2] = __uint_as_float(w.w << 16); b[3] = __uint_as_float(w.w & 0xffff0000u); }
__device__ __forceinline__ void st8bf(bf16_t* q, f32x4 a, f32x4 b) { u32x4 w; w.x = pk2(a[0], a[1]); w.y = pk2(a[2], a[3]); w.z = pk2(b[0], b[1]); w.w = pk2(b[2], b[3]); *(u32x4*)q = w; }
struct OpStoreBf16 { bf16_t* C; int ldc, coff;
    __device__ __forceinline__ void op8(int r, int c, f32x4 a, f32x4 b) const { st8bf(C + (size_t)r * ldc + coff + c, a, b); }
    __device__ __forceinline__ void operator()(int r, int c, f32x4 v) const { u32x2 w; w.x = pk2(v[0], v[1]); w.y = pk2(v[2], v[3]); *(u32x2*)(C + (size_t)r * ldc + coff + c) = w; } };
__device__ __forceinline__ f32x4 ld4bf(const bf16_t* q) { const u32x2 w = *(const u32x2*)q; f32x4 o; o[0] = __uint_as_float(w.x << 16); o[1] = __uint_as_float(w.x & 0xffff0000u); o[2] = __uint_as_float(w.y << 16); o[3] = __uint_as_float(w.y & 0xffff0000u); return o; }
__device__ __forceinline__ void st4bf(bf16_t* q, f32x4 v) { u32x2 w; w.x = pk2(v[0], v[1]); w.y = pk2(v[2], v[3]); *(u32x2*)q = w; }
__device__ __forceinline__ float sigmoidf_(float x) { return __builtin_amdgcn_rcpf(1.f + __builtin_amdgcn_exp2f(-1.4426950408889634f * x)); }
struct OpZGate { bf16_t* U; bool dry;
    __device__ __forceinline__ void op8(int r, int c, f32x4 z0, f32x4 z1) const { bf16_t* q = U + (size_t)r * LDU + 1024 + c; f32x4 o0, o1; ld8bf(q, o0, o1);
#pragma unroll
        for (int i = 0; i < 4; ++i) { o0[i] = o0[i] * z0[i] * sigmoidf_(z0[i]); o1[i] = o1[i] * z1[i] * sigmoidf_(z1[i]); }
        if (!dry) st8bf(q, o0, o1); }
    __device__ __forceinline__ void operator()(int r, int c, f32x4 z) const { bf16_t* q = U + (size_t)r * LDU + 1024 + c; f32x4 o = ld4bf(q);
#pragma unroll
        for (int i = 0; i < 4; ++i) o[i] = o[i] * z[i] * sigmoidf_(z[i]);
        if (!dry) st4bf(q, o); } };
struct OpSig { bf16_t* S2; bf16_t* U;
    __device__ __forceinline__ void op8(int r, int c, f32x4 g0, f32x4 g1) const { f32x4 s0, s1;
#pragma unroll
        for (int i = 0; i < 4; ++i) { s0[i] = sigmoidf_(g0[i]); s1[i] = sigmoidf_(g1[i]); }
        bf16_t* q = (c < 2048) ? S2 + (size_t)r * 2048 + c : U + (size_t)r * LDU + C_SM + (c - 2048);
        st8bf(q, s0, s1); }
    __device__ __forceinline__ void operator()(int r, int c, f32x4 g) const { f32x4 s;
#pragma unroll
        for (int i = 0; i < 4; ++i) s[i] = sigmoidf_(g[i]);
        bf16_t* q = (c < 2048) ? S2 + (size_t)r * 2048 + c : U + (size_t)r * LDU + C_SM + (c - 2048);
        st4bf(q, s); } };
template <int B> struct OpMerge { const bf16_t* S2; bf16_t* U;
    __device__ __forceinline__ void op8(int r, int c, f32x4 v0, f32x4 v1) const {
        const bf16_t* sq = (B == 0) ? S2 + (size_t)r * 2048 + c : (B == 1) ? S2 + (size_t)r * 2048 + 1024 + c : U + (size_t)r * LDU + C_SM + c;
        f32x4 s0, s1; ld8bf(sq, s0, s1); bf16_t* q = U + (size_t)r * LDU + C_MG + c;
        f32x4 o0 = s0 * v0, o1 = s1 * v1; if (B != 0) { f32x4 m0, m1; ld8bf(q, m0, m1); o0 = o0 + m0; o1 = o1 + m1; }
        st8bf(q, o0, o1); }
    __device__ __forceinline__ void operator()(int r, int c, f32x4 v) const {
        const bf16_t* sq = (B == 0) ? S2 + (size_t)r * 2048 + c : (B == 1) ? S2 + (size_t)r * 2048 + 1024 + c : U + (size_t)r * LDU + C_SM + c;
        const f32x4 s = ld4bf(sq); bf16_t* q = U + (size_t)r * LDU + C_MG + c;
        f32x4 o = s * v; if (B != 0) o = o + ld4bf(q);
        st4bf(q, o); } };
struct OpOutF32 { float* O;
    __device__ __forceinline__ void operator()(int r, int c, f32x4 v) const { *(f32x4*)(O + (size_t)r * DM + c) = v; } };

template <class Op>
__device__ void gemm_simple(const bf16_t* A, int lda, const bf16_t* Bt, int M, int N, int K, const Op& op, int bid, int nb) {
    const int tid = threadIdx.x, lane = tid & 63, wave = tid >> 6, fr = lane & 15, fq = lane >> 4;
    const int ntn = N / 64, nitems = (M / 128) * ntn;
    for (int it = bid; it < nitems; it += nb) {
        const int tm = it / ntn, tn = it % ntn;
        const int row = tm * 128 + wave * 16 + fr;
        const bf16_t* ap = A + (size_t)row * lda + fq * 8;
        const bf16_t* bp = Bt + (size_t)(tn * 64 + fr) * K + fq * 8;
        f32x4 acc[4];
#pragma unroll
        for (int n = 0; n < 4; ++n) acc[n] = (f32x4){0.f, 0.f, 0.f, 0.f};
#pragma unroll 2
        for (int k0 = 0; k0 < K; k0 += 32) {
            const bf16x8 a = *(const bf16x8*)(ap + k0);
#pragma unroll
            for (int n = 0; n < 4; ++n) { const bf16x8 b = *(const bf16x8*)(bp + (size_t)n * 16 * K + k0); acc[n] = __builtin_amdgcn_mfma_f32_16x16x32_bf16(b, a, acc[n], 0, 0, 0); }
        }
#pragma unroll
        for (int n = 0; n < 4; ++n) op(row, tn * 64 + n * 16 + fq * 4, acc[n]);
    }
}


namespace pg8 {
#define PG8_LAS __attribute__((address_space(3)))
constexpr int BM = 256, BK = 64, HALF = 128, HTB = HALF * BK * 2  , STAGE_BYTES = 8 * HTB, NXCD = 8, WGM = 4;
__host__ __device__ __forceinline__ int lds_byte(int r, int c) { const int st = (r >> 4) * 2 + (c >> 5), rr = r & 15, cc = c & 31, ob = rr * 64 + cc * 2; return st * 1024 + (ob ^ (((ob >> 9) & 1) << 5)); }
__host__ __device__ __forceinline__ void stage_rc(int b, int& R, int& C) { const int st = b / 1024, sb = b % 1024, swz = sb ^ (((sb >> 9) & 1) << 5); R = (st >> 1) * 16 + swz / 64; C = (st & 1) * 32 + (swz % 64) / 2; }
__host__ __device__ __forceinline__ int perm32(int rho) { const int n = rho >> 4, i = rho & 15; return 8 * (i >> 2) + 4 * n + (i & 3); }
struct Unit { int pm, pn, kind; const char* a; const char* b; };
struct Job { const bf16_t* A; const bf16_t* Bt; int nM, nN; };
struct Sched {
    Job j[2]; int njobs, rep, G, c, lda; long astride, bstride;
    int alt;
    __device__ __forceinline__ bool next(int i, Unit& u) const {
        const int ti = i / rep, v = i - ti * rep; long L = (long)ti * G + c;
        if (alt && njobs == 2) { const int nwg0 = j[0].nM * j[0].nN;
            if (nwg0 == j[1].nM * j[1].nN && nwg0 % G == 0) { if (ti >= 2 * (nwg0 / G)) return false; const int q_ = (ti + c) & 1; L = (long)q_ * nwg0 + (long)(ti >> 1) * G + c; } }
#pragma unroll
        for (int q = 0; q < 2; ++q) { if (q < njobs) { const int nwg = j[q].nM * j[q].nN;
            if (L < nwg) { int wgid = (int)L; { const int qq = nwg / NXCD, r = nwg % NXCD, xcd = wgid % NXCD, off = wgid / NXCD; wgid = (xcd < r ? xcd * (qq + 1) : r * (qq + 1) + (xcd - r) * qq) + off; }
                const int nig = WGM * j[q].nN, gid = wgid / nig, fm = gid * WGM, gsz = (j[q].nM - fm) < WGM ? (j[q].nM - fm) : WGM;
                u.pm = fm + ((wgid % nig) % gsz); u.pn = (wgid % nig) / gsz; u.kind = 4 * q + v;
                u.a = (const char*)(j[q].A + (size_t)u.pm * BM * lda + (size_t)v * astride); u.b = (const char*)(j[q].Bt + (size_t)u.pn * BM * DM + (size_t)v * bstride); return true; }
            L -= nwg; } }
        return false;
    }
};
template <class Sel> struct Epi { static constexpr bool PERM = true, CHAIN = Sel::CHAIN; Sel sel;
    __device__ __forceinline__ void operator()(f32x4 (&acc)[2][2][4][2], const Unit& u, int wr, int wc, int fr, int fq) const {
#pragma unroll
        for (int ai = 0; ai < 2; ++ai)
#pragma unroll
            for (int m = 0; m < 4; ++m) { const int row = u.pm * BM + ai * HALF + wr * 64 + m * 16 + fr;
#pragma unroll
                for (int bj = 0; bj < 2; ++bj) { const int col = u.pn * BM + bj * HALF + wc * 32 + 8 * fq; sel(u.kind, row, col, acc[ai][bj][m][0], acc[ai][bj][m][1]); } }
    }
};
template <class EpiT, bool ALIGN_EPI>
__device__ __forceinline__ void gemm_phase(PG8_LAS unsigned char* lds, const Sched& S, const EpiT& E) {
    int tid_ = threadIdx.x; asm volatile("" : "+v"(tid_));
    const int tid = tid_, wid = __builtin_amdgcn_readfirstlane(tid >> 6), lane = tid & 63, wr = wid >> 2, wc = wid & 3, fr = lane & 15, fq = lane >> 4;
    constexpr int K = DM, nt = K / BK; const int lda = S.lda;
    unsigned voffA[2], voffB[2];
#pragma unroll
    for (int i = 0; i < 2; ++i) { int R, C; stage_rc(tid * 16 + i * 8192, R, C); const int Rb = EpiT::PERM ? ((R & ~31) + perm32(R & 31)) : R;
        voffA[i] = (unsigned)(R * lda + C) * 2u; voffB[i] = (unsigned)(Rb * K + C) * 2u; }
    const size_t kstep = (size_t)(BK * 2);
    const size_t hstepA = (size_t)HALF * lda * 2, hstepB = (size_t)HALF * K * 2;
    const unsigned ldsw = (unsigned)wid * 1024u;
    const int aoff = lds_byte(wr * 64 + fr, fq * 8), boff = lds_byte(wc * 32 + fr, fq * 8);
#define PG8_SA(b, h) (((b) * 2 + (h)) * HTB)
#define PG8_SB(b, h) ((4 + (b) * 2 + (h)) * HTB)
#define PG8_STAGE(bufoff, gbase, voff) do { _Pragma("unroll") for (int _i = 0; _i < 2; ++_i) \
        __builtin_amdgcn_global_load_lds((const unsigned*)((const char*)(gbase) + (voff)[_i]), (PG8_LAS unsigned*)(lds + (bufoff) + ldsw + _i * 8192), 16, 0, 0); } while (0)
#define PG8_LDA(dst, b, h) do { _Pragma("unroll") for (int m = 0; m < 4; ++m) _Pragma("unroll") for (int k = 0; k < 2; ++k) dst[m][k] = *(const PG8_LAS bf16x8*)(lds + PG8_SA(b, h) + aoff + m * 2048 + k * 1024); } while (0)
#define PG8_LDB(dst, b, h) do { _Pragma("unroll") for (int n = 0; n < 2; ++n) _Pragma("unroll") for (int k = 0; k < 2; ++k) dst[n][k] = *(const PG8_LAS bf16x8*)(lds + PG8_SB(b, h) + boff + n * 2048 + k * 1024); } while (0)
#define PG8_MMA(ai, bj, At, Bt) do { __builtin_amdgcn_s_setprio(1); _Pragma("unroll") for (int m = 0; m < 4; ++m) _Pragma("unroll") for (int n = 0; n < 2; ++n) _Pragma("unroll") for (int k = 0; k < 2; ++k) \
        acc[ai][bj][m][n] = __builtin_amdgcn_mfma_f32_16x16x32_bf16(Bt[n][k], At[m][k], acc[ai][bj][m][n], 0, 0, 0); __builtin_amdgcn_s_setprio(0); } while (0)
#define PG8_WAIT_V(n) asm volatile("s_waitcnt vmcnt(" #n ")" ::: "memory")
#define PG8_WAIT_L(n) asm volatile("s_waitcnt lgkmcnt(" #n ")" ::: "memory")
#define PG8_BAR __builtin_amdgcn_s_barrier()
#define PG8_SCHED __builtin_amdgcn_sched_barrier(0)
    Unit cur, nxt; int ui = 0;
    if (!S.next(0, cur)) return;
    f32x4 acc[2][2][4][2];
#pragma unroll
    for (int a = 0; a < 2; ++a)
#pragma unroll
        for (int b = 0; b < 2; ++b)
#pragma unroll
            for (int m = 0; m < 4; ++m)
#pragma unroll
                for (int n = 0; n < 2; ++n) acc[a][b][m][n] = (f32x4){0.f, 0.f, 0.f, 0.f};
    bf16x8 At[4][2], B0[2][2], B1[2][2];
    const char* cA = cur.a; const char* cB = cur.b;
    PG8_STAGE(PG8_SB(0, 0), cB, voffB); PG8_STAGE(PG8_SB(0, 1), cB + hstepB, voffB); PG8_STAGE(PG8_SA(0, 0), cA, voffA); PG8_STAGE(PG8_SA(0, 1), cA + hstepA, voffA);
    if (wr == 1) PG8_BAR;
    PG8_WAIT_V(2); PG8_BAR;
    PG8_STAGE(PG8_SB(1, 0), cB + kstep, voffB); PG8_STAGE(PG8_SA(1, 0), cA + kstep, voffA); PG8_STAGE(PG8_SB(1, 1), cB + hstepB + kstep, voffB);
    PG8_WAIT_V(6); PG8_BAR;
    for (;;) {
        const bool has_next = S.next(ui + 1, nxt);
        const char* nA = has_next ? nxt.a : cA; const char* nB = has_next ? nxt.b : cB;
        for (int t = 0; t < nt; t += 2) {
            const bool last = (t == nt - 2);
            const char* a1 = cA + (size_t)(t + 1) * kstep;
            const char* a2 = last ? nA : cA + (size_t)(t + 2) * kstep; const char* b2 = last ? nB : cB + (size_t)(t + 2) * kstep;
            const char* a3 = a2 + kstep; const char* b3 = b2 + kstep;
            PG8_LDB(B0, 0, 0); PG8_LDB(B1, 0, 1); PG8_SCHED; PG8_LDA(At, 0, 0); PG8_STAGE(PG8_SA(1, 1), a1 + hstepA, voffA);
            PG8_WAIT_V(8); PG8_WAIT_L(0); PG8_BAR; PG8_MMA(0, 0, At, B0); PG8_MMA(0, 1, At, B1); PG8_BAR; PG8_SCHED;
            PG8_LDA(At, 0, 1); PG8_STAGE(PG8_SB(0, 0), b2, voffB); PG8_STAGE(PG8_SB(0, 1), b2 + hstepB, voffB); PG8_STAGE(PG8_SA(0, 0), a2, voffA);
            PG8_WAIT_V(8); PG8_WAIT_L(0); PG8_BAR; PG8_MMA(1, 0, At, B0); PG8_MMA(1, 1, At, B1); PG8_BAR; PG8_SCHED;
            PG8_LDB(B0, 1, 0); PG8_LDB(B1, 1, 1); PG8_SCHED; PG8_LDA(At, 1, 0); PG8_STAGE(PG8_SA(0, 1), a2 + hstepA, voffA);
            PG8_WAIT_V(8); PG8_WAIT_L(0); PG8_BAR; PG8_MMA(0, 0, At, B0); PG8_MMA(0, 1, At, B1); PG8_BAR; PG8_SCHED;
            PG8_LDA(At, 1, 1); PG8_STAGE(PG8_SB(1, 0), b3, voffB); PG8_STAGE(PG8_SB(1, 1), b3 + hstepB, voffB); PG8_STAGE(PG8_SA(1, 0), a3, voffA);
            PG8_WAIT_V(8); PG8_WAIT_L(0); PG8_BAR; PG8_MMA(1, 0, At, B0); PG8_MMA(1, 1, At, B1); PG8_BAR; PG8_SCHED;
        }
        if constexpr (ALIGN_EPI) { if (wr == 0) PG8_BAR; }
        E(acc, cur, wr, wc, fr, fq);
        if (!has_next) break;
        if (!(EpiT::CHAIN && (nxt.kind & 3) != 0)) {
#pragma unroll
        for (int a = 0; a < 2; ++a)
#pragma unroll
            for (int b = 0; b < 2; ++b)
#pragma unroll
                for (int m = 0; m < 4; ++m)
#pragma unroll
                    for (int n = 0; n < 2; ++n) acc[a][b][m][n] = (f32x4){0.f, 0.f, 0.f, 0.f};
        }
        cur = nxt; cA = nA; cB = nB; ++ui;
        if constexpr (ALIGN_EPI) { if (wr == 1) PG8_BAR; }
    }
    PG8_WAIT_V(0);
    if constexpr (!ALIGN_EPI) { if (wr == 0) PG8_BAR; }
    PG8_BAR;
#undef PG8_SA
#undef PG8_SB
#undef PG8_STAGE
#undef PG8_LDA
#undef PG8_LDB
#undef PG8_MMA
#undef PG8_WAIT_V
#undef PG8_WAIT_L
#undef PG8_BAR
#undef PG8_SCHED
}
}
struct SelP1 { static constexpr bool CHAIN = false; OpStoreBf16 o1, o2; __device__ __forceinline__ void operator()(int kind, int r, int c, f32x4& v0, f32x4& v1) const { if (kind == 0) o1.op8(r, c, v0, v1); else o2.op8(r, c, v0, v1); } };
struct SelP5 { static constexpr bool CHAIN = false; OpZGate oz; OpSig os; __device__ __forceinline__ void operator()(int kind, int r, int c, f32x4& v0, f32x4& v1) const { if (kind == 0) oz.op8(r, c, v0, v1); else os.op8(r, c, v0, v1); } };
struct SelP6 { static constexpr bool CHAIN = true; const bf16_t* S2; bf16_t* U;
    __device__ __forceinline__ const bf16_t* sp(int b, int r, int c) const { return (b == 0) ? S2 + (size_t)r * 2048 + c : (b == 1) ? S2 + (size_t)r * 2048 + 1024 + c : U + (size_t)r * LDU + C_SM + c; }
    __device__ __forceinline__ void operator()(int kind, int r, int c, f32x4& v0, f32x4& v1) const {
        if (kind < 2) { f32x4 a0, a1, b0, b1; ld8bf(sp(kind, r, c), a0, a1); ld8bf(sp(kind + 1, r, c), b0, b1);
#pragma unroll
            for (int i = 0; i < 4; ++i) { v0[i] *= fmaxf(a0[i], 1e-30f) * __builtin_amdgcn_rcpf(fmaxf(b0[i], 1e-30f)); v1[i] *= fmaxf(a1[i], 1e-30f) * __builtin_amdgcn_rcpf(fmaxf(b1[i], 1e-30f)); }
        } else { f32x4 a0, a1; ld8bf(sp(2, r, c), a0, a1);
#pragma unroll
            for (int i = 0; i < 4; ++i) { a0[i] = v0[i] * fmaxf(a0[i], 1e-30f); a1[i] = v1[i] * fmaxf(a1[i], 1e-30f); }
            st8bf(U + (size_t)r * LDU + C_MG + c, a0, a1); } } };
__device__ __forceinline__ void sigq8(unsigned char* SQ, int r, int c, f32x4 g0, f32x4 g1) { u32x2 w2; unsigned p0 = 0u, p1 = 0u;
    asm volatile("" : "+v"(g0), "+v"(g1) :: "memory");
#pragma unroll
    for (int e = 0; e < 4; ++e) { p0 = __builtin_amdgcn_cvt_pk_u8_f32(__builtin_amdgcn_fmed3f(__builtin_fmaf(sigmoidf_(g0[e]), 256.f, -0.5f), 0.f, 255.f), e, p0);
        p1 = __builtin_amdgcn_cvt_pk_u8_f32(__builtin_amdgcn_fmed3f(__builtin_fmaf(sigmoidf_(g1[e]), 256.f, -0.5f), 0.f, 255.f), e, p1); }
    w2.x = p0; w2.y = p1; *(u32x2*)(SQ + (size_t)r * 3072 + c) = w2; }
struct EpiP5 { static constexpr bool PERM = true, CHAIN = false; OpZGate oz; OpSig os;
    __device__ __forceinline__ void operator()(f32x4 (&acc)[2][2][4][2], const pg8::Unit& u, int wr, int wc, int fr, int fq) const {
        int t__ = threadIdx.x; asm volatile("" : "+v"(t__)); const int l__ = t__ & 63, w__ = __builtin_amdgcn_readfirstlane(t__ >> 6); (void)wr; (void)wc; (void)fr; (void)fq;
        const int row0 = u.pm * 256 + (w__ >> 2) * 64 + (l__ & 15), col0 = u.pn * 256 + (w__ & 3) * 32 + 8 * (l__ >> 4);
        if (u.kind == 0) {
            u32x4 Y[2][4][2];
#pragma unroll
            for (int ai = 0; ai < 2; ++ai)
#pragma unroll
                for (int m = 0; m < 4; ++m)
#pragma unroll
                    for (int bj = 0; bj < 2; ++bj) Y[ai][m][bj] = *(const u32x4*)(oz.U + (size_t)(row0 + ai * 128 + m * 16) * LDU + 1024 + col0 + bj * 128);
#pragma unroll
            for (int ai = 0; ai < 2; ++ai)
#pragma unroll
                for (int m = 0; m < 4; ++m)
#pragma unroll
                    for (int bj = 0; bj < 2; ++bj) { const u32x4 w = Y[ai][m][bj]; f32x4 z0 = acc[ai][bj][m][0], z1 = acc[ai][bj][m][1]; f32x4 o0, o1;
                        asm volatile("" : "+v"(z0), "+v"(z1) :: "memory");
                        o0[0] = __uint_as_float(w.x << 16); o0[1] = __uint_as_float(w.x & 0xffff0000u); o0[2] = __uint_as_float(w.y << 16); o0[3] = __uint_as_float(w.y & 0xffff0000u);
                        o1[0] = __uint_as_float(w.z << 16); o1[1] = __uint_as_float(w.z & 0xffff0000u); o1[2] = __uint_as_float(w.w << 16); o1[3] = __uint_as_float(w.w & 0xffff0000u);
#pragma unroll
                        for (int i = 0; i < 4; ++i) { o0[i] = o0[i] * z0[i] * sigmoidf_(z0[i]); o1[i] = o1[i] * z1[i] * sigmoidf_(z1[i]); }
                        if (!oz.dry) st8bf(oz.U + (size_t)(row0 + ai * 128 + m * 16) * LDU + 1024 + col0 + bj * 128, o0, o1); }
        } else {
#pragma unroll
            for (int ai = 0; ai < 2; ++ai)
#pragma unroll
                for (int m = 0; m < 4; ++m)
#pragma unroll
                    for (int bj = 0; bj < 2; ++bj) sigq8((unsigned char*)os.S2, row0 + ai * 128 + m * 16, col0 + bj * 128, acc[ai][bj][m][0], acc[ai][bj][m][1]);
        }
    }
};
struct EpiP6 { static constexpr bool PERM = true, CHAIN = true; const bf16_t* S2; bf16_t* U;
    __device__ static __forceinline__ float gq(unsigned w, int e) { return (float)((w >> (8 * e)) & 0xffu) + 0.5f; }
    __device__ __forceinline__ void operator()(f32x4 (&acc)[2][2][4][2], const pg8::Unit& u, int wr, int wc, int fr, int fq) const {
        int t__ = threadIdx.x; asm volatile("" : "+v"(t__)); const int l__ = t__ & 63, w__ = __builtin_amdgcn_readfirstlane(t__ >> 6); (void)wr; (void)wc; (void)fr; (void)fq;
        const int row0 = u.pm * 256 + (w__ >> 2) * 64 + (l__ & 15), col0 = u.pn * 256 + (w__ & 3) * 32 + 8 * (l__ >> 4); const int kind = u.kind;
        const unsigned char* pa = (const unsigned char*)S2 + 1024 * kind;
        if (kind < 2) {
            const unsigned char* pb = pa + 1024;
#pragma unroll
            for (int ai = 0; ai < 2; ++ai) {
                u32x2 A[4][2], B[4][2];
#pragma unroll
                for (int m = 0; m < 4; ++m)
#pragma unroll
                    for (int bj = 0; bj < 2; ++bj) { const size_t o_ = (size_t)(row0 + ai * 128 + m * 16) * 3072 + col0 + bj * 128; A[m][bj] = *(const u32x2*)(pa + o_); B[m][bj] = *(const u32x2*)(pb + o_); }
#pragma unroll
                for (int m = 0; m < 4; ++m)
#pragma unroll
                    for (int bj = 0; bj < 2; ++bj)
#pragma unroll
                        for (int n = 0; n < 2; ++n) { const unsigned wa = n ? A[m][bj].y : A[m][bj].x, wb = n ? B[m][bj].y : B[m][bj].x;
#pragma unroll
                            for (int e = 0; e < 4; ++e) acc[ai][bj][m][n][e] *= gq(wa, e) * __builtin_amdgcn_rcpf(gq(wb, e)); }
            }
        } else {
            u32x2 A[2][4][2];
#pragma unroll
            for (int ai = 0; ai < 2; ++ai)
#pragma unroll
                for (int m = 0; m < 4; ++m)
#pragma unroll
                    for (int bj = 0; bj < 2; ++bj) A[ai][m][bj] = *(const u32x2*)(pa + (size_t)(row0 + ai * 128 + m * 16) * 3072 + col0 + bj * 128);
#pragma unroll
            for (int ai = 0; ai < 2; ++ai)
#pragma unroll
                for (int m = 0; m < 4; ++m)
#pragma unroll
                    for (int bj = 0; bj < 2; ++bj) { f32x4 a0, a1;
#pragma unroll
                        for (int e = 0; e < 4; ++e) { a0[e] = acc[ai][bj][m][0][e] * (gq(A[ai][m][bj].x, e) * (1.f / 256.f)); a1[e] = acc[ai][bj][m][1][e] * (gq(A[ai][m][bj].y, e) * (1.f / 256.f)); }
                        st8bf(U + (size_t)(row0 + ai * 128 + m * 16) * LDU + C_MG + col0 + bj * 128, a0, a1); }
        }
    }
};
struct SelP7 { static constexpr bool CHAIN = false; OpStoreBf16 oo; __device__ __forceinline__ void operator()(int kind, int r, int c, f32x4& v0, f32x4& v1) const { oo.op8(r, c, v0, v1); } };

__device__ void phase_gla_rec(const Params& p, float* oraw, int bid, int nb, unsigned char* lds) {
    constexpr int CH = 32, RS = 136;
    float* As = (float*)lds; float* Ks = As + CH * RS; float* Qs = Ks + CH * RS; float* Vs = Qs + CH * RS;
    const bf16_t* U = Uptr(p);
    const int tid = threadIdx.x, cl = tid >> 3, ds = tid & 7;
    for (int it = bid; it < 64; it += nb) {
        const int b = it >> 4, h = (it >> 2) & 3, q4 = it & 3;
        float s[16];
#pragma unroll
        for (int i = 0; i < 16; ++i) s[i] = 0.f;
        for (int t0 = 0; t0 < SEQ; t0 += CH) {
            __syncthreads();
            for (int e = tid; e < CH * 128; e += NTHREADS) {
                const int i = e >> 7, d = e & 127; const size_t m = (size_t)b * SEQ + t0 + i; const bf16_t* ur = U + m * LDU;
                float x = p.b_a[h * 128 + d];
#pragma unroll
                for (int r = 0; r < 16; ++r) x += bf2f(ur[C_GA + r]) * p.w_a_up[r * 512 + h * 128 + d];
                const float ls = fminf(x, 0.f) - log1pf(__expf(-fabsf(x)));
                const int o = i * RS + (d >> 4) * 17 + (d & 15);
                As[o] = __expf(ls * (1.f / 16.f));
                Ks[o] = bf2f(ur[C_GK + h * 128 + d]);
                Qs[o] = bf2f(ur[C_GQ + h * 128 + d]) * 0.08838834764831845f;
            }
            for (int e = tid; e < CH * 64; e += NTHREADS) { const int i = e >> 6, c = e & 63; Vs[e] = bf2f(U[((size_t)b * SEQ + t0 + i) * LDU + C_GV + h * 256 + q4 * 64 + c]); }
            __syncthreads();
            for (int i = 0; i < CH; ++i) {
                const float v = Vs[i * 64 + cl]; const float* a = As + i * RS + ds * 17; const float* k = Ks + i * RS + ds * 17; const float* q = Qs + i * RS + ds * 17;
                float o = 0.f;
#pragma unroll
                for (int dd = 0; dd < 16; ++dd) { s[dd] = a[dd] * s[dd] + k[dd] * v; o += q[dd] * s[dd]; }
                o += __shfl_xor(o, 1); o += __shfl_xor(o, 2); o += __shfl_xor(o, 4);
                if (ds == 0) oraw[((size_t)b * SEQ + t0 + i) * DM + h * 256 + q4 * 64 + cl] = o;
            }
        }
    }
}
__device__ void phase_gla_norm(const Params& p, const float* oraw, int bid, int nb) {
    bf16_t* U = Uptr(p);
    const int lane = threadIdx.x & 63, wave = threadIdx.x >> 6;
    for (int it = bid * NWAVES + wave; it < MTOK * 4; it += nb * NWAVES) {
        const int m = it >> 2, h = it & 3;
        const f32x4 v = *(const f32x4*)(oraw + (size_t)m * DM + h * 256 + lane * 4);
        const float ss = wave_sum((v[0] * v[0] + v[1] * v[1]) + (v[2] * v[2] + v[3] * v[3]));
        const float rstd = 1.f / sqrtf(ss * (1.f / 256.f) + EPS);
        const f32x4 g = *(const f32x4*)(p.g_gla + lane * 4);
        st4bf(U + (size_t)m * LDU + C_GV + h * 256 + lane * 4, v * g * rstd);
    }
}

__device__ __forceinline__ unsigned fkey(float f) { const unsigned u = __float_as_uint(f); return (u & 0x80000000u) ? ~u : (u | 0x80000000u); }
__device__ void phase_dsa_ref(const Params& p, int bid, int nb, unsigned char* lds) {
    float* sc = (float*)lds;
    float* iqs = sc + 4096;
    float* qs = iqs + 512;
    float* lg = qs + 1024;
    int* sel = (int*)(lg + 2048);
    unsigned* hist = (unsigned*)(sel + 256);
    unsigned* cnt = hist + 256;
    int* misc = (int*)(cnt + 512);
    float* ws8 = (float*)(misc + 8);
    bf16_t* U = Uptr(p);
    const int tid = threadIdx.x, lane = tid & 63, wave = tid >> 6;
    for (int it = bid; it < MTOK; it += nb) {
        const int b = it / SEQ, t = it % SEQ; const size_t m = (size_t)it; const bf16_t* ur = U + m * LDU; const bf16_t* ub = U + (size_t)b * SEQ * LDU;
        __syncthreads();
        iqs[tid] = bf2f(ur[C_IQ + tid]);
        qs[tid] = bf2f(ur[C_DQ + tid]) * 0.08838834764831845f; qs[tid + 512] = bf2f(ur[C_DQ + 512 + tid]) * 0.08838834764831845f;
        if (tid < 8) ws8[tid] = bf2f(ur[C_IW + tid]);
        if (tid == 0) misc[0] = 0;
        __syncthreads();
        const int n = t + 1, ksel = n < 256 ? n : 256;
#pragma unroll 1
        for (int j = 0; j < 8; ++j) {
            const int s = tid * 8 + j;
            if (s < n) {
                const bf16_t* kr = ub + (size_t)s * LDU + C_IK;
                float acc[8];
#pragma unroll
                for (int h = 0; h < 8; ++h) acc[h] = 0.f;
#pragma unroll 1
                for (int d0 = 0; d0 < 64; d0 += 8) {
                    const bf16x8 kv = *(const bf16x8*)(kr + d0);
#pragma unroll
                    for (int dd = 0; dd < 8; ++dd) { const float kd = bf2f((bf16_t)kv[dd]);
#pragma unroll
                        for (int h = 0; h < 8; ++h) acc[h] += iqs[h * 64 + d0 + dd] * kd; }
                }
                float score = 0.f;
#pragma unroll
                for (int h = 0; h < 8; ++h) score += ws8[h] * fmaxf(acc[h], 0.f);
                sc[s] = score;
            }
        }
        __syncthreads();
        if (n <= 256) { if (tid < n) sel[tid] = tid; }
        else {
            unsigned prefix = 0u, mask = 0u; int need = ksel;
            for (int pass = 3; pass >= 0; --pass) {
                const int shift = 8 * pass;
                if (tid < 256) hist[tid] = 0u;
                __syncthreads();
#pragma unroll 1
                for (int j = 0; j < 8; ++j) { const int s = tid * 8 + j; if (s < n) { const unsigned u = fkey(sc[s]); if ((u & mask) == prefix) atomicAdd(&hist[(u >> shift) & 255u], 1u); } }
                __syncthreads();
                if (tid == 0) { int cum = 0, d = 255; for (; d > 0; --d) { const int c = (int)hist[d]; if (cum + c >= need) break; cum += c; } misc[1] = d; misc[2] = need - cum; }
                __syncthreads();
                prefix |= (unsigned)misc[1] << shift; mask |= 0xFFu << shift; need = misc[2];
                __syncthreads();
            }
            unsigned myeq = 0u;
#pragma unroll 1
            for (int j = 0; j < 8; ++j) { const int s = tid * 8 + j; if (s < n && fkey(sc[s]) == prefix) ++myeq; }
            cnt[tid] = myeq;
            __syncthreads();
            int rank = 0; for (int i = 0; i < tid; ++i) rank += (int)cnt[i];
#pragma unroll 1
            for (int j = 0; j < 8; ++j) { const int s = tid * 8 + j; if (s < n) { const unsigned u = fkey(sc[s]);
                bool take = u > prefix; if (u == prefix) { take = rank < need; ++rank; }
                if (take) { const int pos = atomicAdd(&misc[0], 1); if (pos < 256) sel[pos] = s; } } }
        }
        __syncthreads();
        { const int j = tid & 255, c = tid >> 8;
          float l4[4];
          if (j < ksel) { const int s = sel[j]; const bf16_t* kr = ub + (size_t)s * LDU + C_DK + c * 128;
              float a0 = 0.f, a1 = 0.f, a2 = 0.f, a3 = 0.f;
#pragma unroll 1
              for (int d0 = 0; d0 < 128; d0 += 8) { const bf16x8 kv = *(const bf16x8*)(kr + d0);
#pragma unroll
                  for (int dd = 0; dd < 8; ++dd) { const float kd = bf2f((bf16_t)kv[dd]); const float* qq = qs + c * 512 + d0 + dd; a0 += qq[0] * kd; a1 += qq[128] * kd; a2 += qq[256] * kd; a3 += qq[384] * kd; } }
              int dist = t - s; if (dist < 0) dist = 0; const int bk = dist < 128 ? (int)T5B[dist] : 31; const float* rb = p.rel_bias + bk * 8 + c * 4;
              l4[0] = a0 + rb[0]; l4[1] = a1 + rb[1]; l4[2] = a2 + rb[2]; l4[3] = a3 + rb[3];
          } else { l4[0] = l4[1] = l4[2] = l4[3] = -1e30f; }
#pragma unroll
          for (int g = 0; g < 4; ++g) lg[(c * 4 + g) * 256 + j] = l4[g]; }
        __syncthreads();
        { float v[4]; float mx = -3e38f;
#pragma unroll
          for (int i = 0; i < 4; ++i) { v[i] = lg[wave * 256 + lane + 64 * i]; mx = fmaxf(mx, v[i]); }
          mx = wave_max(mx); float sm = 0.f;
#pragma unroll
          for (int i = 0; i < 4; ++i) { v[i] = __expf(v[i] - mx); sm += v[i]; }
          sm = wave_sum(sm); const float inv = 1.f / sm;
#pragma unroll
          for (int i = 0; i < 4; ++i) lg[wave * 256 + lane + 64 * i] = v[i] * inv; }
        __syncthreads();
        { const int h = wave, c = h >> 2; float o0 = 0.f, o1 = 0.f;
#pragma unroll 4
          for (int j = 0; j < ksel; ++j) { const float pj = lg[h * 256 + j]; const unsigned w = *(const unsigned*)(ub + (size_t)sel[j] * LDU + C_DV + c * 128 + lane * 2);
              o0 += pj * __uint_as_float(w << 16); o1 += pj * __uint_as_float(w & 0xffff0000u); }
          *(unsigned*)(U + m * LDU + C_DQ + h * 128 + lane * 2) = pk2(o0, o1); }
    }
}


typedef float f32x16 __attribute__((ext_vector_type(16)));
typedef short s16x4 __attribute__((ext_vector_type(4)));
#define LAS __attribute__((address_space(3)))
#define MFMA32(a, b, c) __builtin_amdgcn_mfma_f32_32x32x16_bf16((a), (b), (c), 0, 0, 0)
__device__ __forceinline__ int crow(int r, int h) { return (r & 3) + 8 * (r >> 2) + 4 * h; }
constexpr int TRI = 8256;
__device__ __forceinline__ size_t mask_index(int b, int j, int kt, int lane) { return ((size_t)(b * TRI + j * (j + 1) / 2 + kt)) * 64 + lane; }

__device__ __forceinline__ void idx_tile(f32x16& sc, const bf16x8 (&aik)[4], LAS const bf16x8* biq  , const float (&wq)[8]) {
#pragma unroll
    for (int r = 0; r < 16; ++r) sc[r] = 0.f;
#pragma unroll
    for (int h = 0; h < 8; ++h) {
        f32x16 d;
#pragma unroll
        for (int r = 0; r < 16; ++r) d[r] = 0.f;
#pragma unroll
        for (int kk = 0; kk < 4; ++kk) d = MFMA32(aik[kk], biq[(h * 4 + kk) * 64], d);
#pragma unroll
        for (int r = 0; r < 16; ++r) sc[r] = __builtin_fmaf(wq[h], __builtin_fmaxf(d[r], 0.f), sc[r]);
    }
}

__device__ __forceinline__ void dsa_select_item(const Params& p, int idx, unsigned char* lds) {
    unsigned* hist = (unsigned*)lds;
    unsigned* qpref = hist + 32 * 256;
    int* qneed = (int*)(qpref + 32);
    int* qcut = qneed + 32;
    int* qflag = qcut + 32;
    int* anyflag = qflag + 32;
    unsigned* tb = (unsigned*)(anyflag + 8);
    LAS bf16x8* iqf = (LAS bf16x8*)((LAS unsigned char*)lds + 65536);
    const bf16_t* U = Uptr(p); unsigned short* maskbuf = (unsigned short*)(p.ws + WS_MASK);
    const int tid = opaque_tid(), lane = tid & 63, wave = __builtin_amdgcn_readfirstlane(tid >> 6), q = lane & 31, half = lane >> 5;
    const int b = idx & 3, j = idx >> 2, t0 = 32 * j; const size_t mb = (size_t)b * SEQ;
    __syncthreads();
    for (int e = tid; e < 32 * 256; e += NTHREADS) hist[e] = 0u;
    if (tid < 32) { qpref[tid] = 0u; qneed[tid] = 256; qcut[tid] = 0x7fffffff; qflag[tid] = 0; }
    if (tid < 8) anyflag[tid] = 0;
    float wq[8];
    { const bf16_t* ur = U + (mb + t0 + q) * LDU;
#pragma unroll
      for (int i = 0; i < 4; ++i) { const int f = wave + 8 * i; iqf[f * 64 + lane] = *(const bf16x8*)(ur + C_IQ + f * 16 + 8 * half); }
#pragma unroll
      for (int h = 0; h < 8; ++h) wq[h] = bf2f(ur[C_IW + h]); }
    LAS const bf16x8* biq = iqf + lane;
    __syncthreads();
#pragma unroll 1
    for (int ps = 0; ps < 6; ++ps) {
        if (ps == 4) { if (anyflag[0] == 0) continue; }
        const unsigned myT = qpref[q]; const int mycut = qcut[q];
        const int shift = 24 - 8 * ps; const unsigned mhi = (ps == 0 || ps > 3) ? 0u : (0xFFFFFFFFu << (32 - 8 * ps));
#pragma unroll 1
        for (int kt = wave; kt <= j; kt += NWAVES) {
            bf16x8 aik[4];
            { const bf16_t* kr = U + (mb + 32 * kt + q) * LDU + C_IK + 8 * half;
#pragma unroll
              for (int kk = 0; kk < 4; ++kk) aik[kk] = *(const bf16x8*)(kr + kk * 16); }
            f32x16 sc; idx_tile(sc, aik, biq, wq);
            unsigned word = 0u;
#pragma unroll
            for (int r = 0; r < 16; ++r) {
                const int kin = crow(r, half); const bool valid = (kt < j) || (kin <= q);
                const unsigned key = fkey(sc[r]);
                if (ps < 4) { if (valid && (key & mhi) == myT) atomicAdd(&hist[q * 256 + ((key >> shift) & 255u)], 1u); }
                else if (ps == 4) { if (valid && key == myT) word |= 1u << kin; }
                else { const bool sel = valid && (key > myT || (key == myT && (32 * kt + kin) <= mycut)); word |= sel ? (1u << r) : 0u; }
            }
            if (ps == 4) { if (word) atomicOr(&tb[kt * 32 + q], word); }
            if (ps == 5) maskbuf[mask_index(b, j, kt, lane)] = (unsigned short)word;
        }
        __syncthreads();
        if (ps < 4) {
            for (int qi = 0; qi < 4; ++qi) {
                const int qq = 4 * wave + qi; const int need = qneed[qq];
                u32x4 c = *(u32x4*)&hist[qq * 256 + 4 * lane];
                const int tot = (int)(c.x + c.y + c.z + c.w);
                int suf = tot;
#pragma unroll
                for (int o = 1; o < 64; o <<= 1) { const int tv = __shfl_down(suf, o); if (lane + o < 64) suf += tv; }
                const int above = suf - tot;
                if (above < need && need <= suf) {
                    int cum = above, digit, eq;
                    if (cum + (int)c.w >= need) { digit = 3; eq = (int)c.w; }
                    else { cum += (int)c.w; if (cum + (int)c.z >= need) { digit = 2; eq = (int)c.z; }
                        else { cum += (int)c.z; if (cum + (int)c.y >= need) { digit = 1; eq = (int)c.y; } else { cum += (int)c.y; digit = 0; eq = (int)c.x; } } }
                    qpref[qq] |= (unsigned)(4 * lane + digit) << shift; qneed[qq] = need - cum;
                    if (ps == 3 && eq > need - cum) { qflag[qq] = 1; anyflag[0] = 1; }
                }
                *(u32x4*)&hist[qq * 256 + 4 * lane] = (u32x4){0u, 0u, 0u, 0u};
            }
            if (ps == 3) { for (int e = tid; e < (j + 1) * 32; e += NTHREADS) tb[e] = 0u; }
        }
        if (ps == 4) {
            if (tid < 32 && qflag[tid]) { const int need = qneed[tid]; int cnt = 0, cut = 0x7fffffff;
                for (int kt = 0; kt <= j; ++kt) { unsigned w = tb[kt * 32 + tid]; const int pc = __popc(w);
                    if (cnt + pc >= need) { int left = need - cnt, pos = 0; for (;;) { pos = __ffs(w) - 1; if (--left == 0) break; w &= w - 1; } cut = 32 * kt + pos; break; }
                    cnt += pc; }
                qcut[tid] = cut; }
        }
        __syncthreads();
    }
}
__device__ void phase_dsa_select(const Params& p, int bid, int nb, unsigned char* lds) {
    for (int k2 = 2 * bid; k2 < 512; k2 += (k2 & 1) ? 2 * nb - 1 : 1) { const int k = k2 >> 1; dsa_select_item(p, (k2 & 1) ? 511 - k : k, lds); }
}


typedef float f32x4_ __attribute__((ext_vector_type(4)));
#define MFMA16(a, b, c) __builtin_amdgcn_mfma_f32_16x16x32_bf16((a), (b), (c), 0, 0, 0)
constexpr int S2_PITCH = 8192 + 16;
constexpr int S2_KEYS = 0, S2_HIST = 16 * S2_PITCH, S2_MISC = S2_HIST + 16 * 256 * 4;
__device__ __forceinline__ unsigned key16x2(float a, float b) {
    const unsigned x = __builtin_bit_cast(unsigned, __builtin_amdgcn_cvt_pkrtz(a, b));
    const unsigned neg = (x >> 15) & 0x00010001u;
    return x ^ ((neg * 0xFFFFu) | 0x80008000u);
}
__device__ __forceinline__ float relu_(float x) { return __builtin_amdgcn_fmed3f(x, 0.f, __builtin_inff()); }
__device__ __forceinline__ void dsa_select16_item(const Params& p, int idx, int a, unsigned char* lds_) {
    LAS char* lds = (LAS char*)lds_;
    LAS unsigned* hist = (LAS unsigned*)(lds + S2_HIST);
    LAS unsigned* qT = (LAS unsigned*)(lds + S2_MISC);
    LAS int* qneed = (LAS int*)(qT + 16);
    LAS int* qcut = qneed + 16;
    LAS int* qflag = qcut + 16;
    const bf16_t* U = Uptr(p); unsigned short* maskbuf = (unsigned short*)(p.ws + WS_MASK);
    const int tid = opaque_tid(), lane = tid & 63, wave = __builtin_amdgcn_readfirstlane(tid >> 6), qn = lane & 15, quad = lane >> 4;
    const int b = idx & 3, j = idx >> 2, t0 = 32 * j + 16 * a; const size_t mb = (size_t)b * SEQ;
    const int ntile16 = 2 * j + a + 1;
    bf16x8 biq[8][2]; float wq[8];
    { const bf16_t* ur = U + (mb + t0 + qn) * LDU;
#pragma unroll
      for (int h = 0; h < 8; ++h) { biq[h][0] = *(const bf16x8*)(ur + C_IQ + h * 64 + 8 * quad); biq[h][1] = *(const bf16x8*)(ur + C_IQ + h * 64 + 32 + 8 * quad); wq[h] = bf2f(ur[C_IW + h]); } }
    bf16x8 blin[2];
#pragma unroll
    for (int ks = 0; ks < 2; ++ks) { unsigned pw_[4];
#pragma unroll
        for (int e2 = 0; e2 < 4; ++e2) { float a0 = 0.f, a1 = 0.f;
#pragma unroll
            for (int h = 0; h < 8; ++h) { a0 = __builtin_fmaf(wq[h], bf2f((bf16_t)biq[h][ks][2 * e2]), a0); a1 = __builtin_fmaf(wq[h], bf2f((bf16_t)biq[h][ks][2 * e2 + 1]), a1); }
            pw_[e2] = pk2(a0, a1); }
        blin[ks] = __builtin_bit_cast(bf16x8, (u32x4){pw_[0], pw_[1], pw_[2], pw_[3]}); }
    __syncthreads();
    for (int e = tid; e < 16 * 256; e += NTHREADS) hist[e] = 0u;
    if (tid < 16) { qT[tid] = 0u; qneed[tid] = 256; qcut[tid] = 0x7fffffff; qflag[tid] = 0; }
    __syncthreads();
    {
        const bf16_t* kb = U + (mb + qn) * LDU + C_IK + 8 * quad; const int nq_ = t0 + qn + 1;
        bf16x8 a00, a01, a10, a11;
        { const bool two = wave + NWAVES < ntile16; const bf16_t* k0 = kb + (size_t)16 * wave * LDU; const bf16_t* k1 = kb + (size_t)16 * (two ? wave + NWAVES : wave) * LDU;
          if (wave < ntile16) { a00 = *(const bf16x8*)k0; a01 = *(const bf16x8*)(k0 + 32); a10 = *(const bf16x8*)k1; a11 = *(const bf16x8*)(k1 + 32); } }
#pragma unroll 1
        for (int tile = wave; tile < ntile16; tile += 2 * NWAVES) {
            const bool two = tile + NWAVES < ntile16;
            const int nt = tile + 2 * NWAVES; const bool hn = nt < ntile16, hn2 = nt + NWAVES < ntile16;
            bf16x8 n00 = a00, n01 = a01, n10 = a10, n11 = a11;
            if (hn) { const bf16_t* k0 = kb + (size_t)16 * nt * LDU; const bf16_t* k1 = kb + (size_t)16 * (hn2 ? nt + NWAVES : nt) * LDU;
                n00 = *(const bf16x8*)k0; n01 = *(const bf16x8*)(k0 + 32); n10 = *(const bf16x8*)k1; n11 = *(const bf16x8*)(k1 + 32); }
            f32x4_ s0 = (f32x4_){0.f, 0.f, 0.f, 0.f}, s1 = s0;
            s0 = MFMA16(a00, blin[0], s0); s1 = MFMA16(a10, blin[0], s1); s0 = MFMA16(a01, blin[1], s0); s1 = MFMA16(a11, blin[1], s1);
#pragma unroll
            for (int h = 0; h < 8; ++h) {
                f32x4_ d0 = (f32x4_){0.f, 0.f, 0.f, 0.f}, d1 = d0;
                d0 = MFMA16(a00, biq[h][0], d0); d1 = MFMA16(a10, biq[h][0], d1);
                d0 = MFMA16(a01, biq[h][1], d0); d1 = MFMA16(a11, biq[h][1], d1);
#pragma unroll
                for (int r = 0; r < 4; ++r) { s0[r] = __builtin_fmaf(wq[h], __builtin_fabsf(d0[r]), s0[r]); s1[r] = __builtin_fmaf(wq[h], __builtin_fabsf(d1[r]), s1[r]); }
            }
            u32x2 w0; w0.x = key16x2(s0[0], s0[1]); w0.y = key16x2(s0[2], s0[3]);
            *(LAS u32x2*)(lds + S2_KEYS + qn * S2_PITCH + (16 * tile + 4 * quad) * 2) = w0;
            { const int k0i = 16 * tile + 4 * quad; const bool part = 16 * tile + 15 > t0;
              if (__builtin_amdgcn_readfirstlane((int)part) == 0) {
#pragma unroll
                  for (int r = 0; r < 4; ++r) { const unsigned key = ((r & 2) ? w0.y : w0.x) >> (16 * (r & 1)) & 0xffffu; __hip_atomic_fetch_add(hist + qn * 256 + (key >> 8), 1u, __ATOMIC_RELAXED, __HIP_MEMORY_SCOPE_WORKGROUP); }
              } else {
#pragma unroll
                  for (int r = 0; r < 4; ++r) { const unsigned key = ((r & 2) ? w0.y : w0.x) >> (16 * (r & 1)) & 0xffffu; if (k0i + r < nq_) __hip_atomic_fetch_add(hist + qn * 256 + (key >> 8), 1u, __ATOMIC_RELAXED, __HIP_MEMORY_SCOPE_WORKGROUP); } } }
            if (two) { u32x2 w1; w1.x = key16x2(s1[0], s1[1]); w1.y = key16x2(s1[2], s1[3]);
                *(LAS u32x2*)(lds + S2_KEYS + qn * S2_PITCH + (16 * (tile + NWAVES) + 4 * quad) * 2) = w1;
                const int k1i = 16 * (tile + NWAVES) + 4 * quad; const bool part1 = 16 * (tile + NWAVES) + 15 > t0;
                if (__builtin_amdgcn_readfirstlane((int)part1) == 0) {
#pragma unroll
                    for (int r = 0; r < 4; ++r) { const unsigned key = ((r & 2) ? w1.y : w1.x) >> (16 * (r & 1)) & 0xffffu; __hip_atomic_fetch_add(hist + qn * 256 + (key >> 8), 1u, __ATOMIC_RELAXED, __HIP_MEMORY_SCOPE_WORKGROUP); }
                } else {
#pragma unroll
                    for (int r = 0; r < 4; ++r) { const unsigned key = ((r & 2) ? w1.y : w1.x) >> (16 * (r & 1)) & 0xffffu; if (k1i + r < nq_) __hip_atomic_fetch_add(hist + qn * 256 + (key >> 8), 1u, __ATOMIC_RELAXED, __HIP_MEMORY_SCOPE_WORKGROUP); } } }
            a00 = n00; a01 = n01; a10 = n10; a11 = n11;
        }
    }
    __syncthreads();
    const int rq = tid & 15, part = tid >> 4, nq = t0 + rq + 1;
#pragma unroll 1
    for (int ps = 0; ps < 2; ++ps) {
        const unsigned hiT = qT[rq] >> 8;
        LAS const char* krow = lds + S2_KEYS + rq * S2_PITCH;
        if (ps == 1) for (int base = part * 8; base < nq; base += 256) {
            const u32x4 kv = *(LAS const u32x4*)(krow + base * 2);
#pragma unroll
            for (int e = 0; e < 8; ++e) { const unsigned w = e < 2 ? kv.x : e < 4 ? kv.y : e < 6 ? kv.z : kv.w; const unsigned key = (e & 1) ? (w >> 16) : (w & 0xffffu);
                const bool ok = (base + e < nq) && (key >> 8) == hiT;
                if (ok) __hip_atomic_fetch_add(hist + rq * 256 + (key & 255u), 1u, __ATOMIC_RELAXED, __HIP_MEMORY_SCOPE_WORKGROUP); }
        }
        __syncthreads();
#pragma unroll
        for (int qi = 0; qi < 2; ++qi) {
            const int qq = 2 * wave + qi; const int need = qneed[qq];
            const u32x4 hw = *(LAS u32x4*)(hist + qq * 256 + 4 * lane);
            const int c0 = (int)hw.x, c1 = (int)hw.y, c2 = (int)hw.z, c3 = (int)hw.w;
            const int tot = c0 + c1 + c2 + c3;
            int suf = tot;
            suf += __builtin_amdgcn_update_dpp(0, suf, 0x101, 0xf, 0xf, true); suf += __builtin_amdgcn_update_dpp(0, suf, 0x102, 0xf, 0xf, true);
            suf += __builtin_amdgcn_update_dpp(0, suf, 0x104, 0xf, 0xf, true); suf += __builtin_amdgcn_update_dpp(0, suf, 0x108, 0xf, 0xf, true);
            { const int T1 = __builtin_amdgcn_readlane(suf, 16), T2 = __builtin_amdgcn_readlane(suf, 32), T3 = __builtin_amdgcn_readlane(suf, 48);
              suf += (lane < 16) ? (T1 + T2 + T3) : (lane < 32) ? (T2 + T3) : (lane < 48) ? T3 : 0; }
            const int above = suf - tot;
            if (above < need && need <= suf) {
                int cum = above, digit, eq;
                if (cum + c3 >= need) { digit = 3; eq = c3; }
                else { cum += c3; if (cum + c2 >= need) { digit = 2; eq = c2; }
                    else { cum += c2; if (cum + c1 >= need) { digit = 1; eq = c1; } else { cum += c1; digit = 0; eq = c0; } } }
                qT[qq] |= (unsigned)(4 * lane + digit) << (ps == 0 ? 8 : 0); qneed[qq] = need - cum;
                if (ps == 1 && eq > need - cum) qflag[qq] = 1;
            }
            *(LAS u32x4*)(hist + qq * 256 + 4 * lane) = (u32x4){0u, 0u, 0u, 0u};
        }
        __syncthreads();
    }
#pragma unroll 1
    for (int qi = 0; qi < 2; ++qi) {
        const int qq = 2 * wave + qi;
        if (qflag[qq]) { const int nqq = t0 + qq + 1, need = qneed[qq]; const unsigned T = qT[qq]; int acc = 0;
            LAS const char* krow_ = lds + S2_KEYS + qq * S2_PITCH;
#pragma unroll 1
            for (int base = 0; base < nqq; base += 512) { const int s0 = base + 8 * lane;
                const u32x4 kv = *(LAS const u32x4*)(krow_ + s0 * 2);
                unsigned m = 0u;
#pragma unroll
                for (int e = 0; e < 8; ++e) { const unsigned w = e < 2 ? kv.x : e < 4 ? kv.y : e < 6 ? kv.z : kv.w; const unsigned key = (e & 1) ? (w >> 16) : (w & 0xffffu);
                    m |= (unsigned)((s0 + e < nqq) && key == T) << e; }
                const int c = __popc(m);
                int inc = c;
                inc += __builtin_amdgcn_update_dpp(0, inc, 0x111, 0xf, 0xf, true); inc += __builtin_amdgcn_update_dpp(0, inc, 0x112, 0xf, 0xf, true);
                inc += __builtin_amdgcn_update_dpp(0, inc, 0x114, 0xf, 0xf, true); inc += __builtin_amdgcn_update_dpp(0, inc, 0x118, 0xf, 0xf, true);
                { const int R0 = __builtin_amdgcn_readlane(inc, 15), R1 = __builtin_amdgcn_readlane(inc, 31), R2 = __builtin_amdgcn_readlane(inc, 47);
                  inc += (lane >= 48) ? (R0 + R1 + R2) : (lane >= 32) ? (R0 + R1) : (lane >= 16) ? R0 : 0; }
                const int total = __builtin_amdgcn_readlane(inc, 63);
                if (acc + total >= need) { const int target = need - acc, pre = inc - c;
                    if (pre < target && target <= inc) { int left = target - pre; unsigned mm = m; while (--left > 0) mm &= mm - 1; qcut[qq] = s0 + (int)__ffs((int)mm) - 1; }
                    break; }
                acc += total; }
        }
    }
    __syncthreads();
    for (int pi = tid; pi < 16 * (j + 1); pi += NTHREADS) {
        const int eq_ = pi & 15, kt = pi >> 4; const int nqq = t0 + eq_ + 1, cut = qcut[eq_]; const unsigned T = (nqq <= 256) ? 0u : qT[eq_];
        LAS const char* kp = lds + S2_KEYS + eq_ * S2_PITCH + kt * 64;
        unsigned ge = 0u, eqm = 0u;
#pragma unroll
        for (int v4 = 0; v4 < 4; ++v4) { const u32x4 kv = *(LAS const u32x4*)(kp + v4 * 16);
#pragma unroll
            for (int e = 0; e < 8; ++e) { const unsigned w = e < 2 ? kv.x : e < 4 ? kv.y : e < 6 ? kv.z : kv.w; const unsigned key = (e & 1) ? (w >> 16) : (w & 0xffffu);
                ge |= (unsigned)(key >= T) << (8 * v4 + e); eqm |= (unsigned)(key == T) << (8 * v4 + e); } }
        const int nv = nqq - 32 * kt; const unsigned vmask = nv >= 32 ? 0xffffffffu : (nv <= 0 ? 0u : ((1u << nv) - 1u));
        const int nc = cut - 32 * kt; const unsigned cmask = nc >= 31 ? 0xffffffffu : (nc < 0 ? 0u : ((2u << nc) - 1u));
        const unsigned w32 = vmask & ge & (~eqm | cmask);
#pragma unroll
        for (int hf = 0; hf < 2; ++hf) { const unsigned x = w32 >> (4 * hf); const unsigned wd = (x & 0xFu) | ((x >> 4) & 0xF0u) | ((x >> 8) & 0xF00u) | ((x >> 12) & 0xF000u);
            maskbuf[mask_index(b, j, kt, 16 * a + eq_ + 32 * hf)] = (unsigned short)wd; }
    }
}
__device__ __forceinline__ void phase_dsa_select2(const Params& p, int bid, int nb, unsigned char* lds) {
    for (int k4 = 4 * bid; k4 < 1024; k4 += ((k4 & 3) == 3) ? 4 * nb - 3 : 1) { const int k = k4 >> 2, r = k4 & 3; dsa_select16_item(p, (r & 2) ? (((127 - (k >> 2)) << 2) | (k & 3)) : k, r & 1, lds); }
}

__device__ __forceinline__ int max3i_(int a, int b, int c) { return max(max(a, b), c); }
__device__ __forceinline__ float bound_from_bits(int mi) { const auto r = __builtin_amdgcn_permlane32_swap((unsigned)mi, (unsigned)mi, false, false); return __int_as_float(max(max((int)r[0], (int)r[1]), 0)); }
constexpr int DA_K = 0, DA_V = 32768, DA_BUF = 65536  , DA_TB = 131072, DA_WS = DA_TB + 8 * 132 * 4, DA_END = DA_WS + 8 * 64 * 4;
__device__ __forceinline__ s16x4 ds_tr(LAS const char* pp) { typedef short v4i16_t __attribute__((ext_vector_type(4))); return __builtin_bit_cast(s16x4, __builtin_amdgcn_ds_read_tr16_b64_v4i16((LAS v4i16_t*)pp)); }
template <int MODE>
__device__ __forceinline__ void attend_item(const Params& p, int idx, unsigned char* lds_, bool dry) {
    LAS char* lds = (LAS char*)lds_;
    bf16_t* U = Uptr(p); const unsigned short* maskbuf = (const unsigned short*)(p.ws + WS_MASK);
    const int tid = opaque_tid(), lane = tid & 63, wv = __builtin_amdgcn_readfirstlane(tid >> 6), q = lane & 31, half = lane >> 5;
    constexpr int NKK = MODE == 0 ? 8 : 16;
    const int h = MODE == 0 ? wv : (idx & 3); const int c = wv >> 2;
    const int b = MODE == 0 ? (idx & 3) : ((idx >> 2) >> 5); const int j = idx >> 2;
    const size_t mb = (size_t)b * SEQ;
    const size_t mq = MODE == 0 ? mb + 32 * j : (size_t)128 * j + 32 * (wv & 3);
    const int t0 = 32 * j;
    LAS const float* tbh = (LAS const float*)(lds + DA_TB) + h * 132; LAS float* wsc = (LAS float*)(lds + DA_WS) + wv * 64;
    constexpr float C1 = (MODE == 0 ? 0.08838834764831845f : 0.0625f) * 1.4426950408889634f;
    const float b31 = MODE == 0 ? tbh[128] : 0.f, bmaxh = MODE == 0 ? tbh[129] : 0.f;
    const int nsteps = MODE == 0 ? (j >> 1) + 1 : 4;
    const int srow = 2 * wv + half, spc = lane & 31;
    const bf16_t* gk; const bf16_t* gv; size_t gpitch;
    if (MODE == 0) { gk = U + (mb + srow) * LDU + C_DK + ((spc ^ (srow & 15)) << 3); gv = U + (mb + srow) * LDU + C_DV + ((spc ^ ((srow & 3) << 2)) << 3); gpitch = LDU; }
    else { const bf16_t* MKV = (const bf16_t*)(p.ws + WS_MKV) + ((size_t)b * NMEM + srow) * 2048 + h * 256; gk = MKV + ((spc ^ (srow & 15)) << 3); gv = MKV + 1024 + ((spc ^ ((srow & 3) << 2)) << 3); gpitch = 2048; }
#define DA_STAGE(st_, bufoff_) do { const size_t go_ = (size_t)(64 * (st_)) * gpitch; _Pragma("unroll") for (int i_ = 0; i_ < 4; ++i_) { \
        __builtin_amdgcn_global_load_lds((const unsigned*)(gk + go_ + (size_t)16 * i_ * gpitch), (LAS unsigned*)(lds + (bufoff_) + DA_K + (wv + 8 * i_) * 1024), 16, 0, 0); \
        __builtin_amdgcn_global_load_lds((const unsigned*)(gv + go_ + (size_t)16 * i_ * gpitch), (LAS unsigned*)(lds + (bufoff_) + DA_V + (wv + 8 * i_) * 1024), 16, 0, 0); } } while (0)
    __syncthreads();
    DA_STAGE(0, 0);
    bf16x8 qf[NKK];
    { const bf16_t* ur = U + (mq + q) * LDU + (MODE == 0 ? C_DQ + h * 128 : C_XQ + h * 256) + 8 * half;
#pragma unroll
      for (int kk = 0; kk < NKK; ++kk) qf[kk] = *(const bf16x8*)(ur + kk * 16); }
    f32x16 o[4];
#pragma unroll
    for (int dt = 0; dt < 4; ++dt)
#pragma unroll
        for (int r = 0; r < 16; ++r) o[dt][r] = 0.f;
    float m = -1e20f, l = 0.f;
    unsigned kA0, vA0;
    { const int q4 = (lane & 15) >> 2, p4 = lane & 3, g1 = (lane >> 4) & 1;
      kA0 = DA_K + q * 512 + ((((MODE == 0 ? c * 16 : 0) + half) ^ (q & 15)) << 4);
      vA0 = DA_V + (4 * half + q4) * 512 + (((c * 16 + 2 * g1 + (p4 >> 1)) ^ (q4 << 2)) << 4) + (p4 & 1) * 8; }
    unsigned mw0 = 0xffffu, mw1 = 0xffffu;
    if (MODE == 0) { mw0 = maskbuf[mask_index(b, j, 0, lane)]; mw1 = (1 <= j) ? maskbuf[mask_index(b, j, 1, lane)] : 0u; }
#pragma unroll 1
    for (int st = 0; st < nsteps; ++st) {
        const int kbase = 64 * st;
        asm volatile("s_waitcnt vmcnt(0)" ::: "memory");
        __syncthreads();
        const unsigned cw0 = mw0, cw1 = mw1;
        if (st + 1 < nsteps) { DA_STAGE(st + 1, ((st + 1) & 1) * DA_BUF);
            if (MODE == 0) { const int kt = 2 * st + 2; mw0 = maskbuf[mask_index(b, j, kt, lane)]; mw1 = (kt + 1 <= j) ? maskbuf[mask_index(b, j, kt + 1, lane)] : 0u; } }
        f32x16 s0, s1;
#pragma unroll
        for (int r = 0; r < 16; ++r) { s0[r] = 0.f; s1[r] = 0.f; }
#pragma unroll
        for (int k4 = 0; k4 < NKK; k4 += 4) {
            bf16x8 ka[4], kb[4];
#pragma unroll
            for (int kk = 0; kk < 4; ++kk) { ka[kk] = *(LAS const bf16x8*)(lds + (kA0 ^ (unsigned)((k4 + kk) << 5))); kb[kk] = *(LAS const bf16x8*)(lds + (kA0 ^ (unsigned)((k4 + kk) << 5)) + 32 * 512); }
            __builtin_amdgcn_sched_barrier(0);
#pragma unroll
            for (int kk = 0; kk < 4; ++kk) { s0 = MFMA32(ka[kk], qf[k4 + kk], s0); s1 = MFMA32(kb[kk], qf[k4 + kk], s1); }
            __builtin_amdgcn_sched_barrier(0); }
        const bool far_ = MODE == 0 && (t0 - (kbase + 63)) >= 128;
        int smi = max(__float_as_int(s0[0]), __float_as_int(s1[0]));
#pragma unroll
        for (int r = 1; r < 16; ++r) smi = max3i_(smi, __float_as_int(s0[r]), __float_as_int(s1[r]));
        const float sm = bound_from_bits(smi);
        const float mc = __builtin_fmaf(sm, C1, MODE == 0 ? (far_ ? b31 : bmaxh) : 0.f);
        if (__any(mc > m + 16.f)) {
            const float mnew = fmaxf(m, mc);
            const float alpha = __builtin_amdgcn_exp2f(m - mnew); l *= alpha;
            if (half == 0) wsc[q] = alpha;
            asm volatile("s_waitcnt lgkmcnt(0)" ::: "memory");
#pragma unroll
            for (int r = 0; r < 16; ++r) { const float a = wsc[crow(r, half)];
#pragma unroll
                for (int dt = 0; dt < 4; ++dt) o[dt][r] *= a; }
            m = mnew;
        }
        float ls = 0.f;
        if (MODE == 1) {
            const float nm = -m;
#pragma unroll
            for (int r = 0; r < 16; ++r) { s0[r] = __builtin_amdgcn_exp2f(__builtin_fmaf(s0[r], C1, nm)); s1[r] = __builtin_amdgcn_exp2f(__builtin_fmaf(s1[r], C1, nm)); ls += s0[r] + s1[r]; }
        } else if (far_) {
            const int bm = __float_as_int(b31 - m), NEGI = __float_as_int(-1e30f);
#pragma unroll
            for (int r = 0; r < 16; ++r) {
                const int k0 = __builtin_amdgcn_sbfe((int)cw0, r, 1), k1 = __builtin_amdgcn_sbfe((int)cw1, r, 1);
                const float a0 = __int_as_float((k0 & bm) | (~k0 & NEGI)), a1 = __int_as_float((k1 & bm) | (~k1 & NEGI));
                s0[r] = __builtin_amdgcn_exp2f(__builtin_fmaf(s0[r], C1, a0)); s1[r] = __builtin_amdgcn_exp2f(__builtin_fmaf(s1[r], C1, a1)); ls += s0[r] + s1[r]; }
        } else {
            const int NEGI = __float_as_int(-1e30f);
#pragma unroll
            for (int r = 0; r < 16; ++r) {
                int d0 = t0 + q - (kbase + crow(r, half)); int d1 = d0 - 32; d0 = d0 < 0 ? 0 : (d0 > 128 ? 128 : d0); d1 = d1 < 0 ? 0 : (d1 > 128 ? 128 : d1);
                const int b0 = __float_as_int(tbh[d0] - m), b1 = __float_as_int(tbh[d1] - m);
                const int k0 = __builtin_amdgcn_sbfe((int)cw0, r, 1), k1 = __builtin_amdgcn_sbfe((int)cw1, r, 1);
                const float a0 = __int_as_float((k0 & b0) | (~k0 & NEGI)), a1 = __int_as_float((k1 & b1) | (~k1 & NEGI));
                s0[r] = __builtin_amdgcn_exp2f(__builtin_fmaf(s0[r], C1, a0)); s1[r] = __builtin_amdgcn_exp2f(__builtin_fmaf(s1[r], C1, a1)); ls += s0[r] + s1[r]; }
        }
        l += ls;
#pragma unroll
        for (int u = 0; u < 2; ++u) {
#pragma unroll
            for (int ss = 0; ss < 2; ++ss) {
                u32x4 pw;
                if (u == 0) { pw.x = pk2(s0[8 * ss], s0[8 * ss + 1]); pw.y = pk2(s0[8 * ss + 2], s0[8 * ss + 3]); pw.z = pk2(s0[8 * ss + 4], s0[8 * ss + 5]); pw.w = pk2(s0[8 * ss + 6], s0[8 * ss + 7]); }
                else { pw.x = pk2(s1[8 * ss], s1[8 * ss + 1]); pw.y = pk2(s1[8 * ss + 2], s1[8 * ss + 3]); pw.z = pk2(s1[8 * ss + 4], s1[8 * ss + 5]); pw.w = pk2(s1[8 * ss + 6], s1[8 * ss + 7]); }
                const bf16x8 pa = __builtin_bit_cast(bf16x8, pw);
#pragma unroll
                for (int dt = 0; dt < 4; ++dt) {
                    const s16x4 lo = ds_tr(lds + (vA0 ^ (unsigned)(dt << 6)) + (32 * u + 16 * ss) * 512);
                    const s16x4 hi = ds_tr(lds + (vA0 ^ (unsigned)(dt << 6)) + (32 * u + 16 * ss + 8) * 512);
                    const bf16x8 vb = (bf16x8){lo[0], lo[1], lo[2], lo[3], hi[0], hi[1], hi[2], hi[3]};
                    o[dt] = MFMA32(pa, vb, o[dt]);
                }
            }
        }
        kA0 ^= DA_BUF; vA0 ^= DA_BUF;
    }
#undef DA_STAGE
    l = xhalf_sum(l);
    if (half == 0) wsc[q] = 1.f / l;
    asm volatile("s_waitcnt lgkmcnt(0)" ::: "memory");
#pragma unroll
    for (int r = 0; r < 16; ++r) { const int qq = crow(r, half); const float a = wsc[qq];
        bf16_t* orow = U + (mq + qq) * LDU + (MODE == 0 ? C_DQ + h * 128 : C_XQ + h * 256 + c * 128) + q;
#pragma unroll
        for (int dt = 0; dt < 4; ++dt) { const bf16_t ov = (bf16_t)f2bf(o[dt][r] * a); if (!dry) orow[dt * 32] = ov; } }
}

constexpr int D4_GRP = 65536, D4_K = 0, D4_V = 16384, D4_BUF = 32768, D4_CNT = DA_END;
__device__ __forceinline__ void group_barrier(LAS unsigned* cnt, int lane) {
    asm volatile("s_waitcnt vmcnt(0) lgkmcnt(0)" ::: "memory");
    if (lane == 0) { const unsigned old = __hip_atomic_fetch_add(cnt, 1u, __ATOMIC_RELAXED, __HIP_MEMORY_SCOPE_WORKGROUP); const unsigned target = (old & ~3u) + 4u;
        while (__hip_atomic_load(cnt, __ATOMIC_RELAXED, __HIP_MEMORY_SCOPE_WORKGROUP) < target) __builtin_amdgcn_s_sleep(1); }
    asm volatile("" ::: "memory");
}
__device__ __forceinline__ void group_barrier_f(LAS unsigned* slots  , int w4, int lane, unsigned& step) {
    asm volatile("s_waitcnt vmcnt(0) lgkmcnt(0)" ::: "memory");
    ++step;
    if (lane == 0) { __hip_atomic_store(slots + w4, step, __ATOMIC_RELAXED, __HIP_MEMORY_SCOPE_WORKGROUP);
        for (;;) { const u32x4 v = *(volatile LAS u32x4*)slots; const unsigned mn = min(min(v.x, v.y), min(v.z, v.w)); if (mn >= step) break; __builtin_amdgcn_s_sleep(1); } }
    asm volatile("" ::: "memory");
}
__device__ __forceinline__ float max3f_(float a, float b, float c) { return __builtin_fmaxf(__builtin_fmaxf(a, b), c); }
__device__ __forceinline__ void dsa_attend4_item(const Params& p, int idx, unsigned char* lds_, bool dry, unsigned& bstep) {
    LAS char* lds = (LAS char*)lds_;
    bf16_t* U = Uptr(p); const unsigned short* maskbuf = (const unsigned short*)(p.ws + WS_MASK);
    const int tid = opaque_tid(), lane = tid & 63, wv = __builtin_amdgcn_readfirstlane(tid >> 6), q = lane & 31, half = lane >> 5;
    const int grp = wv >> 2, w4 = wv & 3, h = wv;
    const int b = idx & 3, j = idx >> 2, t0 = 32 * j; const size_t mb = (size_t)b * SEQ;
    LAS const float* tbh = (LAS const float*)(lds + DA_TB) + h * 132; LAS float* wsc = (LAS float*)(lds + DA_WS) + wv * 64;
    LAS unsigned* gcnt = (LAS unsigned*)(lds + D4_CNT) + grp * 16;
    constexpr float C1 = 0.08838834764831845f * 1.4426950408889634f;
    const float b31 = tbh[128], bmaxh = tbh[129];
    const int nsteps = (j >> 1) + 1;
    const unsigned gb = grp * D4_GRP;
    const int sr = 4 * w4 + (lane >> 4), spc = lane & 15;
    const bf16_t* gk = U + (mb + sr) * LDU + C_DK + grp * 128 + ((spc ^ (sr & 15)) << 3);
    const bf16_t* gv = U + (mb + sr) * LDU + C_DV + grp * 128 + ((spc ^ ((sr & 3) << 2)) << 3);
#define D4_STAGE(st_, bufoff_) do { const size_t go_ = (size_t)(64 * (st_)) * LDU; _Pragma("unroll") for (int i_ = 0; i_ < 4; ++i_) { \
        __builtin_amdgcn_global_load_lds((const unsigned*)(gk + go_ + (size_t)16 * i_ * LDU), (LAS unsigned*)(lds + gb + (bufoff_) + D4_K + (w4 + 4 * i_) * 1024), 16, 0, 0); \
        __builtin_amdgcn_global_load_lds((const unsigned*)(gv + go_ + (size_t)16 * i_ * LDU), (LAS unsigned*)(lds + gb + (bufoff_) + D4_V + (w4 + 4 * i_) * 1024), 16, 0, 0); } } while (0)
    group_barrier_f(gcnt, w4, lane, bstep);
    D4_STAGE(0, 0);
    bf16x8 qf[8];
    { const bf16_t* ur = U + (mb + t0 + q) * LDU + C_DQ + h * 128 + 8 * half;
#pragma unroll
      for (int kk = 0; kk < 8; ++kk) qf[kk] = *(const bf16x8*)(ur + kk * 16); }
    f32x16 o[4];
#pragma unroll
    for (int dt = 0; dt < 4; ++dt)
#pragma unroll
        for (int r = 0; r < 16; ++r) o[dt][r] = 0.f;
    float m = -1e20f, l = 0.f;
    unsigned kA0, vA0;
    { const int q4 = (lane & 15) >> 2, p4 = lane & 3, g1 = (lane >> 4) & 1;
      kA0 = gb + D4_K + q * 256 + ((half ^ (q & 15)) << 4);
      vA0 = gb + D4_V + (4 * half + q4) * 256 + (((2 * g1 + (p4 >> 1)) ^ (q4 << 2)) << 4) + (p4 & 1) * 8; }
    unsigned mw0 = maskbuf[mask_index(b, j, 0, lane)], mw1 = (1 <= j) ? maskbuf[mask_index(b, j, 1, lane)] : 0u;
#pragma unroll 1
    for (int st = 0; st < nsteps; ++st) {
        const int kbase = 64 * st;
        group_barrier_f(gcnt, w4, lane, bstep);
        const unsigned cw0 = mw0, cw1 = mw1;
        const bool nxt = st + 1 < nsteps;
        if (nxt) { const int kt = 2 * st + 2; mw0 = maskbuf[mask_index(b, j, kt, lane)]; mw1 = (kt + 1 <= j) ? maskbuf[mask_index(b, j, kt + 1, lane)] : 0u; }
        f32x16 s0, s1;
#pragma unroll
        for (int r = 0; r < 16; ++r) { s0[r] = 0.f; s1[r] = 0.f; }
        { bf16x8 ka[8], kb[8];
#pragma unroll
          for (int kk = 0; kk < 8; ++kk) { const unsigned ad_ = (unsigned)(size_t)lds + (kA0 ^ (unsigned)(kk << 5));
              asm volatile("ds_read_b128 %0, %1" : "=&v"(ka[kk]) : "v"(ad_) : "memory");
              asm volatile("ds_read_b128 %0, %1 offset:8192" : "=&v"(kb[kk]) : "v"(ad_) : "memory"); }
          const size_t go_ = (size_t)(64 * (st + 1)) * LDU; const unsigned bo_ = ((st + 1) & 1) * D4_BUF;
#pragma unroll
          for (int kk = 0; kk < 8; ++kk) {
              asm volatile("s_waitcnt lgkmcnt(%2)" : "+v"(ka[kk]), "+v"(kb[kk]) : "n"(14 - 2 * kk) : "memory");
              s0 = MFMA32(ka[kk], qf[kk], s0); s1 = MFMA32(kb[kk], qf[kk], s1);
              if (nxt) { const int i_ = kk >> 1;
                  if ((kk & 1) == 0) __builtin_amdgcn_global_load_lds((const unsigned*)(gk + go_ + (size_t)16 * i_ * LDU), (LAS unsigned*)(lds + gb + bo_ + D4_K + (w4 + 4 * i_) * 1024), 16, 0, 0);
                  else __builtin_amdgcn_global_load_lds((const unsigned*)(gv + go_ + (size_t)16 * i_ * LDU), (LAS unsigned*)(lds + gb + bo_ + D4_V + (w4 + 4 * i_) * 1024), 16, 0, 0); }
              __builtin_amdgcn_sched_barrier(0); }
          __builtin_amdgcn_sched_barrier(0); }
        s16x4 vl[2][4], vh[2][4]; unsigned vb_[4];
#pragma unroll
        for (int dt = 0; dt < 4; ++dt) vb_[dt] = (unsigned)(size_t)lds + (vA0 ^ (unsigned)(dt << 6));
#define TRR(dst, base, off) asm volatile("ds_read_b64_tr_b16 %0, %1 offset:%c2" : "=&v"(dst) : "v"(base), "i"(off) : "memory")
#pragma unroll
        for (int dt = 0; dt < 4; ++dt) { TRR(vl[0][dt], vb_[dt], 0); TRR(vh[0][dt], vb_[dt], 8 * 256); }
        const bool far_ = (t0 - (kbase + 63)) >= 128;
        int smi = max3i_(__float_as_int(s0[0]), __float_as_int(s1[0]), __float_as_int(s0[1]));
#pragma unroll
        for (int r = 1; r < 16; ++r) smi = (r < 15) ? max3i_(smi, __float_as_int(s1[r]), __float_as_int(s0[r + 1])) : max(smi, __float_as_int(s1[r]));
        const float sm = bound_from_bits(smi);
        const float mc = __builtin_fmaf(sm, C1, far_ ? b31 : bmaxh);
        if (__any(mc > m + 16.f)) {
            const float mnew = fmaxf(m, mc);
            const float alpha = __builtin_amdgcn_exp2f(m - mnew); l *= alpha;
            if (half == 0) wsc[q] = alpha;
            asm volatile("s_waitcnt lgkmcnt(0)" ::: "memory");
#pragma unroll
            for (int r = 0; r < 16; ++r) { const float a = wsc[crow(r, half)];
#pragma unroll
                for (int dt = 0; dt < 4; ++dt) o[dt][r] *= a; }
            m = mnew;
        }
        float ls = 0.f;
        if (far_) {
            const int bm = __float_as_int(b31 - m), NEGI = __float_as_int(-1e30f);
#pragma unroll
            for (int r = 0; r < 16; ++r) {
                const int k0 = __builtin_amdgcn_sbfe((int)cw0, r, 1), k1 = __builtin_amdgcn_sbfe((int)cw1, r, 1);
                const float a0 = __int_as_float((k0 & bm) | (~k0 & NEGI)), a1 = __int_as_float((k1 & bm) | (~k1 & NEGI));
                s0[r] = __builtin_amdgcn_exp2f(__builtin_fmaf(s0[r], C1, a0)); s1[r] = __builtin_amdgcn_exp2f(__builtin_fmaf(s1[r], C1, a1)); ls += s0[r] + s1[r]; }
        } else {
            const int NEGI = __float_as_int(-1e30f);
#pragma unroll
            for (int r = 0; r < 16; ++r) {
                int d0 = t0 + q - (kbase + crow(r, half)); int d1 = d0 - 32; d0 = d0 < 0 ? 0 : (d0 > 128 ? 128 : d0); d1 = d1 < 0 ? 0 : (d1 > 128 ? 128 : d1);
                const int b0 = __float_as_int(tbh[d0] - m), b1 = __float_as_int(tbh[d1] - m);
                const int k0 = __builtin_amdgcn_sbfe((int)cw0, r, 1), k1 = __builtin_amdgcn_sbfe((int)cw1, r, 1);
                const float a0 = __int_as_float((k0 & b0) | (~k0 & NEGI)), a1 = __int_as_float((k1 & b1) | (~k1 & NEGI));
                s0[r] = __builtin_amdgcn_exp2f(__builtin_fmaf(s0[r], C1, a0)); s1[r] = __builtin_amdgcn_exp2f(__builtin_fmaf(s1[r], C1, a1)); ls += s0[r] + s1[r]; }
        }
        l += ls;
        {
#pragma unroll
          for (int g = 0; g < 4; ++g) { const int u = g >> 1, ss = g & 1;
              if (g < 3) { const int gn = g + 1, un = gn >> 1, sn = gn & 1;
#pragma unroll
                  for (int dt = 0; dt < 4; ++dt) { TRR(vl[gn & 1][dt], vb_[dt], (32 * un + 16 * sn) * 256); TRR(vh[gn & 1][dt], vb_[dt], (32 * un + 16 * sn + 8) * 256); } }
              u32x4 pw;
              if (u == 0) { pw.x = pk2(s0[8 * ss], s0[8 * ss + 1]); pw.y = pk2(s0[8 * ss + 2], s0[8 * ss + 3]); pw.z = pk2(s0[8 * ss + 4], s0[8 * ss + 5]); pw.w = pk2(s0[8 * ss + 6], s0[8 * ss + 7]); }
              else { pw.x = pk2(s1[8 * ss], s1[8 * ss + 1]); pw.y = pk2(s1[8 * ss + 2], s1[8 * ss + 3]); pw.z = pk2(s1[8 * ss + 4], s1[8 * ss + 5]); pw.w = pk2(s1[8 * ss + 6], s1[8 * ss + 7]); }
              const bf16x8 pa = __builtin_bit_cast(bf16x8, pw);
              if (g < 3) asm volatile("s_waitcnt lgkmcnt(8)" : "+v"(vl[g & 1][0]), "+v"(vh[g & 1][0]), "+v"(vl[g & 1][1]), "+v"(vh[g & 1][1]), "+v"(vl[g & 1][2]), "+v"(vh[g & 1][2]), "+v"(vl[g & 1][3]), "+v"(vh[g & 1][3]) :: "memory");
              else asm volatile("s_waitcnt lgkmcnt(0)" : "+v"(vl[g & 1][0]), "+v"(vh[g & 1][0]), "+v"(vl[g & 1][1]), "+v"(vh[g & 1][1]), "+v"(vl[g & 1][2]), "+v"(vh[g & 1][2]), "+v"(vl[g & 1][3]), "+v"(vh[g & 1][3]) :: "memory");
#pragma unroll
              for (int dt = 0; dt < 4; ++dt) { const s16x4 lo = vl[g & 1][dt], hi = vh[g & 1][dt];
                  const bf16x8 vb = (bf16x8){lo[0], lo[1], lo[2], lo[3], hi[0], hi[1], hi[2], hi[3]};
                  o[dt] = MFMA32(pa, vb, o[dt]); }
              __builtin_amdgcn_sched_barrier(0); } }
#undef TRR
        kA0 ^= D4_BUF; vA0 ^= D4_BUF;
    }
#undef D4_STAGE
    l = xhalf_sum(l);
    if (half == 0) wsc[q] = 1.f / l;
    asm volatile("s_waitcnt lgkmcnt(0)" ::: "memory");
#pragma unroll
    for (int r = 0; r < 16; ++r) { const int qq = crow(r, half); const float a = wsc[qq];
        bf16_t* orow = U + (mb + t0 + qq) * LDU + C_DQ + h * 128 + q;
#pragma unroll
        for (int dt = 0; dt < 4; ++dt) { const bf16_t ov = (bf16_t)f2bf(o[dt][r] * a); if (!dry) orow[dt * 32] = ov; } }
}
__device__ __forceinline__ void phase_dsa_attend4(const Params& p, int bid, int nb, unsigned char* lds, bool dry) {
    { float* tb = (float*)(lds + DA_TB);
      for (int e = threadIdx.x; e < 8 * 129; e += NTHREADS) { const int hh = e / 129, d = e % 129; tb[hh * 132 + d] = p.rel_bias[(d < 128 ? (int)T5B[d] : 31) * 8 + hh] * 1.4426950408889634f; }
      if (threadIdx.x < 8) { float mx = -1e30f; for (int bk = 0; bk < 32; ++bk) mx = fmaxf(mx, p.rel_bias[bk * 8 + threadIdx.x]); tb[threadIdx.x * 132 + 129] = mx * 1.4426950408889634f; }
      if (threadIdx.x < 32) ((unsigned*)(lds + D4_CNT))[threadIdx.x] = 0u; }
    __syncthreads();
    const int grp = __builtin_amdgcn_readfirstlane(threadIdx.x >> 8);
    unsigned bstep = 0u;
    for (int k = bid; k < 256; k += nb) {
        const int ia = k, ib = ((127 - (k >> 2)) << 2) | (k & 3);
#pragma unroll 1
        for (int r = 0; r < 2; ++r) dsa_attend4_item(p, (r ^ grp) ? ib : ia, lds, dry, bstep);
    }
    __syncthreads();
}

__device__ __forceinline__ void phase_cross_attend(const Params& p, int bid, int nb, unsigned char* lds, bool dry) {
    for (int k = bid; k < 512; k += nb) attend_item<1>(p, k, lds, dry);
}
__device__ void phase_dsa_attend(const Params& p, int bid, int nb, unsigned char* lds, bool dry) {
    { float* tb = (float*)(lds + DA_TB);
      for (int e = threadIdx.x; e < 8 * 129; e += NTHREADS) { const int hh = e / 129, d = e % 129; tb[hh * 132 + d] = p.rel_bias[(d < 128 ? (int)T5B[d] : 31) * 8 + hh] * 1.4426950408889634f; }
      if (threadIdx.x < 8) { float mx = -1e30f; for (int bk = 0; bk < 32; ++bk) mx = fmaxf(mx, p.rel_bias[bk * 8 + threadIdx.x]); tb[threadIdx.x * 132 + 129] = mx * 1.4426950408889634f; } }
    __syncthreads();
    for (int k2 = 2 * bid; k2 < 512; k2 += (k2 & 1) ? 2 * nb - 1 : 1) { const int k = k2 >> 1; attend_item<0>(p, (k2 & 1) ? (((127 - (k >> 2)) << 2) | (k & 3)) : k, lds, dry); }
}


constexpr size_t WS_GD = 44 * MiB;
static_assert(WS_MASK + (size_t)4 * TRI * 128 <= WS_GD && WS_GD + 1024 * 128 * 4 <= WS_U, "ws map (mask, gla decay)");
__device__ __forceinline__ void gla_stage_v(LAS char* vdst, const bf16_t* Uc, int h, int tid) {
    const int lane = tid & 63, wv = __builtin_amdgcn_readfirstlane(tid >> 6), half = lane >> 5, srow = 2 * wv + half, spc = lane & 31;
    const bf16_t* gv = Uc + (size_t)srow * LDU + C_GV + h * 256 + ((spc ^ ((srow & 3) << 2)) << 3);
#pragma unroll
    for (int i = 0; i < 4; ++i) __builtin_amdgcn_global_load_lds((const unsigned*)(gv + (size_t)16 * i * LDU), (LAS unsigned*)(vdst + (wv + 8 * i) * 1024), 16, 0, 0);
}
constexpr int G1_KT = 0, G1_V = 16384, G1_B = 49152, G1_GA = 81920, G1_SEG = 83968, G1_BT = 86016;
struct G1Pre { u32x4 qa, qb, ka, kb, gav; };
__device__ __forceinline__ void gla_g1_load(const Params& p, int item, int tid, G1Pre& o) {
    const bf16_t* U = Uptr(p); const int bh = item >> 6, n = item & 63, b = bh >> 2, h = bh & 3; const bf16_t* Uc = U + ((size_t)b * SEQ + 64 * n) * LDU; const int d8 = tid & 15, tg = tid >> 4;
    o.qa = *(const u32x4*)(Uc + (size_t)(2 * tg) * LDU + C_GQ + h * 128 + 8 * d8); o.qb = *(const u32x4*)(Uc + (size_t)(2 * tg + 1) * LDU + C_GQ + h * 128 + 8 * d8);
    o.ka = *(const u32x4*)(Uc + (size_t)(2 * tg) * LDU + C_GK + h * 128 + 8 * d8); o.kb = *(const u32x4*)(Uc + (size_t)(2 * tg + 1) * LDU + C_GK + h * 128 + 8 * d8);
    o.gav = (u32x4){0u, 0u, 0u, 0u}; if (tid < 128) o.gav = *(const u32x4*)(Uc + (size_t)(tid >> 1) * LDU + C_GA + 8 * (tid & 1));
}
__device__ __forceinline__ void gla_g1_item(const Params& p, int item, unsigned char* lds_, bool dry, const G1Pre& pre, int next_item, G1Pre& nxt, float (&w)[16], float& ba, int& hw) {
    LAS char* lds = (LAS char*)lds_;
    bf16_t* U = Uptr(p); bf16_t* GS = (bf16_t*)p.out; float* GD = (float*)(p.ws + WS_GD);
    const int tid = opaque_tid(), lane = tid & 63, wv = __builtin_amdgcn_readfirstlane(tid >> 6), half = lane >> 5;
    const int bh = item >> 6, n = item & 63, b = bh >> 2, h = bh & 3;
    bf16_t* Uc = U + ((size_t)b * SEQ + 64 * n) * LDU;
    const int d8 = tid & 15, tg = tid >> 4;
    const u32x4 qa = pre.qa, qb = pre.qb, ka = pre.ka, kb = pre.kb, gav = pre.gav;
    __syncthreads();
    if (tid < 128) *(LAS u32x4*)(lds + G1_GA + tid * 16) = gav;
    gla_stage_v(lds + G1_V, Uc, h, tid);
    if (next_item < 1024) gla_g1_load(p, next_item, tid, nxt);
    __syncthreads();
    { const int d = tid & 127, seg = tid >> 7;
      if (h != hw) {
#pragma unroll
          for (int r = 0; r < 16; ++r) w[r] = p.w_a_up[r * 512 + h * 128 + d];
          ba = p.b_a[h * 128 + d]; hw = h; }
      float bl[16]; float cum = 0.f;
#pragma unroll
      for (int i = 0; i < 16; ++i) {
          const u32x4 g0 = *(LAS const u32x4*)(lds + G1_GA + (16 * seg + i) * 32), g1 = *(LAS const u32x4*)(lds + G1_GA + (16 * seg + i) * 32 + 16);
          float x = ba;
          x += __uint_as_float(g0.x << 16) * w[0] + __uint_as_float(g0.x & 0xffff0000u) * w[1] + __uint_as_float(g0.y << 16) * w[2] + __uint_as_float(g0.y & 0xffff0000u) * w[3];
          x += __uint_as_float(g0.z << 16) * w[4] + __uint_as_float(g0.z & 0xffff0000u) * w[5] + __uint_as_float(g0.w << 16) * w[6] + __uint_as_float(g0.w & 0xffff0000u) * w[7];
          x += __uint_as_float(g1.x << 16) * w[8] + __uint_as_float(g1.x & 0xffff0000u) * w[9] + __uint_as_float(g1.y << 16) * w[10] + __uint_as_float(g1.y & 0xffff0000u) * w[11];
          x += __uint_as_float(g1.z << 16) * w[12] + __uint_as_float(g1.z & 0xffff0000u) * w[13] + __uint_as_float(g1.w << 16) * w[14] + __uint_as_float(g1.w & 0xffff0000u) * w[15];
          const float sp = __builtin_amdgcn_logf(1.f + __builtin_amdgcn_exp2f(-1.4426950408889634f * fmaxf(x, -80.f)));
          cum += -0.04332169878499658f * sp; bl[i] = cum;
      }
      LAS float* segsum = (LAS float*)(lds + G1_SEG);
      segsum[seg * 128 + d] = cum;
      __syncthreads();
      float off = 0.f, tot = 0.f;
#pragma unroll
      for (int s2 = 0; s2 < 4; ++s2) { const float v = segsum[s2 * 128 + d]; tot += v; if (s2 < seg) off += v; }
#pragma unroll
      for (int i = 0; i < 16; ++i) *(LAS float*)(lds + G1_B + ((16 * seg + i) * 128 + d) * 4) = bl[i] + off;
      if (seg == 0) { *(LAS float*)(lds + G1_BT + d * 4) = tot; GD[(size_t)item * 128 + d] = __builtin_amdgcn_exp2f(1.4426950408889634f * tot); } }
    __syncthreads();
    { unsigned qo[2][4], ko[2][4]; float kt_[2][8];
#pragma unroll
      for (int tt = 0; tt < 2; ++tt) { const int t = 2 * tg + tt; const u32x4 qv = tt ? qb : qa, kv = tt ? kb : ka;
          const f32x4 b0 = *(LAS const f32x4*)(lds + G1_B + (t * 128 + 8 * d8) * 4), b1 = *(LAS const f32x4*)(lds + G1_B + (t * 128 + 8 * d8 + 4) * 4);
          const f32x4 t0 = *(LAS const f32x4*)(lds + G1_BT + (8 * d8) * 4), t1 = *(LAS const f32x4*)(lds + G1_BT + (8 * d8 + 4) * 4);
          float qd[8], kd[8];
#pragma unroll
          for (int e = 0; e < 8; ++e) { const unsigned qw = e < 2 ? qv.x : e < 4 ? qv.y : e < 6 ? qv.z : qv.w, kw = e < 2 ? kv.x : e < 4 ? kv.y : e < 6 ? kv.z : kv.w;
              const float qf = (e & 1) ? __uint_as_float(qw & 0xffff0000u) : __uint_as_float(qw << 16), kf = (e & 1) ? __uint_as_float(kw & 0xffff0000u) : __uint_as_float(kw << 16);
              const float bb = e < 4 ? b0[e & 3] : b1[e & 3], bt = e < 4 ? t0[e & 3] : t1[e & 3];
              const float ep = __builtin_amdgcn_exp2f(1.4426950408889634f * bb), em = __builtin_amdgcn_exp2f(-1.4426950408889634f * bb);
              qd[e] = qf * 0.08838834764831845f * ep; kd[e] = kf * em; kt_[tt][e] = kf * __builtin_amdgcn_exp2f(1.4426950408889634f * (bt - bb)); }
#pragma unroll
          for (int e = 0; e < 4; ++e) { qo[tt][e] = pk2(qd[2 * e], qd[2 * e + 1]); ko[tt][e] = pk2(kd[2 * e], kd[2 * e + 1]); } }
      if (!dry) {
      if (!dry) {
      *(u32x4*)(Uc + (size_t)(2 * tg) * LDU + C_GQ + h * 128 + 8 * d8) = (u32x4){qo[0][0], qo[0][1], qo[0][2], qo[0][3]};
      *(u32x4*)(Uc + (size_t)(2 * tg + 1) * LDU + C_GQ + h * 128 + 8 * d8) = (u32x4){qo[1][0], qo[1][1], qo[1][2], qo[1][3]};
      *(u32x4*)(Uc + (size_t)(2 * tg) * LDU + C_GK + h * 128 + 8 * d8) = (u32x4){ko[0][0], ko[0][1], ko[0][2], ko[0][3]};
      *(u32x4*)(Uc + (size_t)(2 * tg + 1) * LDU + C_GK + h * 128 + 8 * d8) = (u32x4){ko[1][0], ko[1][1], ko[1][2], ko[1][3]}; } }
#pragma unroll
      for (int e = 0; e < 8; ++e) { const int d = 8 * d8 + e; const int ch = (tg >> 2) ^ ((d >> 1) & 7);
          *(LAS unsigned*)(lds + G1_KT + d * 128 + (ch << 4) + (tg & 3) * 4) = pk2(kt_[0][e], kt_[1][e]); } }
    asm volatile("s_waitcnt vmcnt(0)" ::: "memory");
    __syncthreads();
    f32x16 acc[4];
#pragma unroll
    for (int i = 0; i < 4; ++i)
#pragma unroll
        for (int r = 0; r < 16; ++r) acc[i][r] = 0.f;
    const int dk = 32 * (wv & 3) + (lane & 31), q4 = (lane & 15) >> 2, p4 = lane & 3, g1 = (lane >> 4) & 1;
#pragma unroll
    for (int s_ = 0; s_ < 4; ++s_) {
        const bf16x8 a = *(LAS const bf16x8*)(lds + G1_KT + dk * 128 + (((2 * s_ + half) ^ ((dk >> 1) & 7)) << 4));
#pragma unroll
        for (int i = 0; i < 4; ++i) { const int dtile = 4 * (wv >> 2) + i; const int ch = (dtile * 4 + 2 * g1 + (p4 >> 1)) ^ (q4 << 2);
            const s16x4 lo = ds_tr(lds + G1_V + (16 * s_ + 8 * half + q4) * 512 + (ch << 4) + (p4 & 1) * 8);
            const s16x4 hi = ds_tr(lds + G1_V + (16 * s_ + 8 * half + 4 + q4) * 512 + (ch << 4) + (p4 & 1) * 8);
            const bf16x8 vb = (bf16x8){lo[0], lo[1], lo[2], lo[3], hi[0], hi[1], hi[2], hi[3]};
            acc[i] = MFMA32(a, vb, acc[i]); }
    }
    bf16_t* gs = GS + (size_t)item * 32768;
#pragma unroll
    for (int i = 0; i < 4; ++i) { const int dv = 32 * (4 * (wv >> 2) + i) + (lane & 31);
#pragma unroll
        for (int pr = 0; pr < 2; ++pr) { const int re = 2 * pr, ro_ = 2 * pr + 1;
            const unsigned bx = pk2(acc[i][4 * re], acc[i][4 * re + 1]), by = pk2(acc[i][4 * re + 2], acc[i][4 * re + 3]);
            const unsigned ax = pk2(acc[i][4 * ro_], acc[i][4 * ro_ + 1]), ay = pk2(acc[i][4 * ro_ + 2], acc[i][4 * ro_ + 3]);
            const auto sx = __builtin_amdgcn_permlane32_swap(bx, ax, false, false), sy = __builtin_amdgcn_permlane32_swap(by, ay, false, false);
            *(u32x4*)(gs + (size_t)dv * 128 + 32 * (wv & 3) + 8 * (2 * pr + half)) = (u32x4){sx[0], sy[0], sx[1], sy[1]}; } }
}
__device__ __forceinline__ void phase_gla_g1(const Params& p, int bid, int nb, unsigned char* lds, bool dry) {
    if (bid >= 1024) return;
    const int tid = opaque_tid();
    G1Pre cur, nxt; float w[16]; float ba = 0.f; int hw = -1;
#pragma unroll
    for (int r = 0; r < 16; ++r) w[r] = 0.f;
    gla_g1_load(p, bid, tid, cur); nxt = cur;
#pragma unroll 1
    for (int it = bid; it < 1024; it += nb) { gla_g1_item(p, it, lds, dry, cur, it + nb, nxt, w, ba, hw); cur = nxt; }
}
__device__ __forceinline__ void phase_gla_g2(const Params& p, int bid, int nb, unsigned char* lds_, bool dry) {
    bf16_t* GS = (bf16_t*)p.out; const float* GD = (const float*)(p.ws + WS_GD);
    LAS float* dl = (LAS float*)lds_;
    const int tid = opaque_tid();
    for (int e0 = bid * NTHREADS; e0 < 16 * 8192; e0 += nb * NTHREADS) {
        const int e = e0 + tid, bh = e0 >> 13, w = e & 8191, dk4 = (w & 31) * 4;
        bf16_t* gp = GS + (size_t)bh * 64 * 32768 + (size_t)w * 4;
        u32x2 tb[2][16];
#pragma unroll
        for (int i = 0; i < 16; ++i) tb[0][i] = *(const u32x2*)(gp + (size_t)i * 32768);
        __syncthreads();
#pragma unroll
        for (int i = 0; i < 4; ++i) *(LAS f32x4*)(dl + (i * NTHREADS + tid) * 4) = *(const f32x4*)(GD + (size_t)bh * 64 * 128 + (i * NTHREADS + tid) * 4);
        __syncthreads();
        f32x4 S = (f32x4){0.f, 0.f, 0.f, 0.f};
#pragma unroll
        for (int bt = 0; bt < 4; ++bt) {
            if (bt < 3) {
#pragma unroll
                for (int i = 0; i < 16; ++i) tb[(bt + 1) & 1][i] = *(const u32x2*)(gp + (size_t)(16 * (bt + 1) + i) * 32768); }
            __builtin_amdgcn_sched_barrier(0);
#pragma unroll
            for (int i = 0; i < 16; ++i) { const int n = 16 * bt + i; const u32x2 t2 = tb[bt & 1][i]; const f32x4 dc = *(LAS const f32x4*)(dl + n * 128 + dk4);
                u32x2 o2; o2.x = pk2(S[0], S[1]); o2.y = pk2(S[2], S[3]); if (!dry) *(u32x2*)(gp + (size_t)n * 32768) = o2;
                S[0] = dc[0] * S[0] + __uint_as_float(t2.x << 16); S[1] = dc[1] * S[1] + __uint_as_float(t2.x & 0xffff0000u);
                S[2] = dc[2] * S[2] + __uint_as_float(t2.y << 16); S[3] = dc[3] * S[3] + __uint_as_float(t2.y & 0xffff0000u); }
            __builtin_amdgcn_sched_barrier(0);
        }
    }
}
constexpr int G3_QD = 0, G3_KD = 16384, G3_V = 32768, G3_BUF = 65536;
__device__ __forceinline__ void phase_gla_g3(const Params& p, int bid, int nb, unsigned char* lds_, bool dry) {
    LAS char* lds = (LAS char*)lds_;
    bf16_t* U = Uptr(p); const bf16_t* GS = (const bf16_t*)p.out;
    const int tid = opaque_tid(), lane = tid & 63, wv = __builtin_amdgcn_readfirstlane(tid >> 6), half = lane >> 5, q = lane & 31;
    if (bid >= 1024) return;
#define G3_LOAD(item_, bo_, sfd_) do { const int bh_ = (item_) >> 6, n_ = (item_) & 63, b_ = bh_ >> 2, h_ = bh_ & 3; const bf16_t* Uc_ = U + ((size_t)b_ * SEQ + 64 * n_) * LDU; \
        const int r4_ = lane >> 4, pc_ = lane & 15; \
        _Pragma("unroll") for (int i = 0; i < 2; ++i) { const int row = 4 * (wv + 8 * i) + r4_; const bf16_t* src = Uc_ + (size_t)row * LDU + h_ * 128 + ((pc_ ^ (row & 15)) << 3); \
            __builtin_amdgcn_global_load_lds((const unsigned*)(src + C_GQ), (LAS unsigned*)(lds + (bo_) + G3_QD + (wv + 8 * i) * 1024), 16, 0, 0); \
            __builtin_amdgcn_global_load_lds((const unsigned*)(src + C_GK), (LAS unsigned*)(lds + (bo_) + G3_KD + (wv + 8 * i) * 1024), 16, 0, 0); } \
        gla_stage_v(lds + (bo_) + G3_V, Uc_, h_, tid); \
        const bf16_t* sp_ = GS + (size_t)(item_) * 32768 + (size_t)(32 * wv + q) * 128 + 8 * half; \
        _Pragma("unroll") for (int kk = 0; kk < 8; ++kk) sfd_[kk] = *(const bf16x8*)(sp_ + kk * 16); } while (0)
    bf16x8 sf[8], sfn[8];
    f32x4 gg[8];
#pragma unroll
    for (int i = 0; i < 8; ++i) gg[i] = *(const f32x4*)(p.g_gla + 32 * (tid & 7) + 4 * i);
    __syncthreads();
    G3_LOAD(bid, 0, sf);
#pragma unroll
    for (int kk = 0; kk < 8; ++kk) sfn[kk] = sf[kk];
    unsigned bo = 0;
    const int q4 = (lane & 15) >> 2, p4 = lane & 3, g1 = (lane >> 4) & 1;
#pragma unroll 1
    for (int item = bid; item < 1024; item += nb) {
        const int bh = item >> 6, n = item & 63, b = bh >> 2, h = bh & 3;
        bf16_t* Uc = U + ((size_t)b * SEQ + 64 * n) * LDU;
        if (dry) asm volatile("s_waitcnt vmcnt(0)" ::: "memory"); else asm volatile("s_waitcnt vmcnt(4)" ::: "memory");
        __syncthreads();
        if (item + nb < 1024) G3_LOAD(item + nb, bo ^ G3_BUF, sfn);
        f32x16 o[2];
#pragma unroll
        for (int tt = 0; tt < 2; ++tt)
#pragma unroll
            for (int r = 0; r < 16; ++r) o[tt][r] = 0.f;
        const unsigned vA = bo + G3_V + (4 * half + q4) * 512 + ((((wv * 4 + 2 * g1 + (p4 >> 1))) ^ (q4 << 2)) << 4) + (p4 & 1) * 8;
#pragma unroll
        for (int tt = 0; tt < 2; ++tt) {
            bf16x8 qd[8];
#pragma unroll
            for (int kk = 0; kk < 8; ++kk) { const int t = 32 * tt + q; qd[kk] = *(LAS const bf16x8*)(lds + bo + G3_QD + t * 256 + (((2 * kk + half) ^ (t & 15)) << 4)); }
#pragma unroll
            for (int kk = 0; kk < 8; ++kk) o[tt] = MFMA32(qd[kk], sf[kk], o[tt]);
#pragma unroll
            for (int st = 0; st <= tt; ++st) {
                bf16x8 kd[8];
#pragma unroll
                for (int kk = 0; kk < 8; ++kk) { const int srow = 32 * st + q; kd[kk] = *(LAS const bf16x8*)(lds + bo + G3_KD + srow * 256 + (((2 * kk + half) ^ (srow & 15)) << 4)); }
                s16x4 lo0, hi0, lo1, hi1; const unsigned vb_ = (unsigned)(size_t)lds + vA;
                asm volatile("ds_read_b64_tr_b16 %0, %1 offset:%c2" : "=&v"(lo0) : "v"(vb_), "i"((32 * st) * 512) : "memory");
                asm volatile("ds_read_b64_tr_b16 %0, %1 offset:%c2" : "=&v"(hi0) : "v"(vb_), "i"((32 * st + 8) * 512) : "memory");
                asm volatile("ds_read_b64_tr_b16 %0, %1 offset:%c2" : "=&v"(lo1) : "v"(vb_), "i"((32 * st + 16) * 512) : "memory");
                asm volatile("ds_read_b64_tr_b16 %0, %1 offset:%c2" : "=&v"(hi1) : "v"(vb_), "i"((32 * st + 24) * 512) : "memory");
                f32x16 x;
#pragma unroll
                for (int r = 0; r < 16; ++r) x[r] = 0.f;
#pragma unroll
                for (int kk = 0; kk < 8; ++kk) x = MFMA32(kd[kk], qd[kk], x);
                if (st == tt) {
#pragma unroll
                    for (int r = 0; r < 16; ++r) x[r] = (crow(r, half) <= q) ? x[r] : 0.f;
                }
                asm volatile("s_waitcnt lgkmcnt(0)" : "+v"(lo0), "+v"(hi0), "+v"(lo1), "+v"(hi1) :: "memory");
#pragma unroll
                for (int ss = 0; ss < 2; ++ss) {
                    u32x4 pw; pw.x = pk2(x[8 * ss], x[8 * ss + 1]); pw.y = pk2(x[8 * ss + 2], x[8 * ss + 3]); pw.z = pk2(x[8 * ss + 4], x[8 * ss + 5]); pw.w = pk2(x[8 * ss + 6], x[8 * ss + 7]);
                    const bf16x8 pa = __builtin_bit_cast(bf16x8, pw);
                    const s16x4 lo = ss ? lo1 : lo0, hi = ss ? hi1 : hi0;
                    const bf16x8 vb = (bf16x8){lo[0], lo[1], lo[2], lo[3], hi[0], hi[1], hi[2], hi[3]};
                    o[tt] = MFMA32(pa, vb, o[tt]);
                }
            }
        }
        __syncthreads();
#pragma unroll
        for (int tt = 0; tt < 2; ++tt)
#pragma unroll
            for (int r = 0; r < 16; ++r) *(LAS float*)(lds + bo + ((32 * tt + crow(r, half)) * 256 + 32 * wv + q) * 4) = o[tt][r];
        __syncthreads();
        { const int t = tid >> 3, sg = tid & 7;
          f32x4 v[8]; float ss = 0.f;
#pragma unroll
          for (int i = 0; i < 8; ++i) { v[i] = *(LAS const f32x4*)(lds + bo + (t * 256 + 32 * sg + 4 * i) * 4); ss += (v[i][0] * v[i][0] + v[i][1] * v[i][1]) + (v[i][2] * v[i][2] + v[i][3] * v[i][3]); }
          ss += __shfl_xor(ss, 1); ss += __shfl_xor(ss, 2); ss += __shfl_xor(ss, 4);
          const float rstd = 1.f / sqrtf(ss * (1.f / 256.f) + EPS);
          bf16_t* dst = Uc + (size_t)t * LDU + C_GV + h * 256 + 32 * sg;
#pragma unroll
          for (int i = 0; i < 4; ++i) { if (!dry) st8bf(dst + 8 * i, v[2 * i] * gg[2 * i] * rstd, v[2 * i + 1] * gg[2 * i + 1] * rstd); } }
#pragma unroll
        for (int kk = 0; kk < 8; ++kk) sf[kk] = sfn[kk];
        bo ^= G3_BUF;
    }
#undef G3_LOAD
    asm volatile("s_waitcnt vmcnt(0)" ::: "memory");
}

__device__ void phase_cross_ref(const Params& p, int bid, int nb, unsigned char* lds) {
    float* qs = (float*)lds;
    float* lg = qs + 1024;
    bf16_t* U = Uptr(p); const bf16_t* MKV = (const bf16_t*)(p.ws + WS_MKV);
    const int tid = threadIdx.x, lane = tid & 63, wave = tid >> 6;
    for (int it = bid; it < MTOK; it += nb) {
        const int b = it / SEQ; const size_t m = (size_t)it; const bf16_t* mb = MKV + (size_t)b * NMEM * 2048;
        __syncthreads();
        qs[tid] = bf2f(U[m * LDU + C_XQ + tid]) * 0.0625f; qs[tid + 512] = bf2f(U[m * LDU + C_XQ + 512 + tid]) * 0.0625f;
        __syncthreads();
        { const int j = tid & 255, hp = tid >> 8;
          const bf16_t* kr = mb + (size_t)j * 2048 + hp * 512; float a0 = 0.f, a1 = 0.f;
          for (int d0 = 0; d0 < 256; d0 += 8) { const bf16x8 k0 = *(const bf16x8*)(kr + d0); const bf16x8 k1 = *(const bf16x8*)(kr + 256 + d0);
#pragma unroll
              for (int dd = 0; dd < 8; ++dd) { a0 += qs[hp * 512 + d0 + dd] * bf2f((bf16_t)k0[dd]); a1 += qs[hp * 512 + 256 + d0 + dd] * bf2f((bf16_t)k1[dd]); } }
          lg[(2 * hp) * 256 + j] = a0; lg[(2 * hp + 1) * 256 + j] = a1; }
        __syncthreads();
        if (wave < 4) { float v[4]; float mx = -3e38f;
#pragma unroll
            for (int i = 0; i < 4; ++i) { v[i] = lg[wave * 256 + lane + 64 * i]; mx = fmaxf(mx, v[i]); }
            mx = wave_max(mx); float sm = 0.f;
#pragma unroll
            for (int i = 0; i < 4; ++i) { v[i] = __expf(v[i] - mx); sm += v[i]; }
            sm = wave_sum(sm); const float inv = 1.f / sm;
#pragma unroll
            for (int i = 0; i < 4; ++i) lg[wave * 256 + lane + 64 * i] = v[i] * inv; }
        __syncthreads();
        { const int h = tid >> 7, d = (tid & 127) * 2; float o0 = 0.f, o1 = 0.f;
          for (int j = 0; j < NMEM; ++j) { const float pj = lg[h * 256 + j]; const unsigned w = *(const unsigned*)(mb + (size_t)j * 2048 + 1024 + h * 256 + d);
              o0 += pj * __uint_as_float(w << 16); o1 += pj * __uint_as_float(w & 0xffff0000u); }
          *(unsigned*)(U + m * LDU + C_XQ + h * 256 + d) = pk2(o0, o1); }
    }
}

__device__ __forceinline__ void phase_final(const Params& p, int bid, int nb, bool dry) {
    const int lane = threadIdx.x & 63, wave = threadIdx.x >> 6; const bf16_t* U = Uptr(p);
    for (int m = bid * NWAVES + wave; m < MTOK; m += nb * NWAVES) {
        f32x4* orow = (f32x4*)(p.out + (size_t)m * DM) + lane; const f32x4* xr = (const f32x4*)(p.x + (size_t)m * DM) + lane; const f32x4* gr = (const f32x4*)p.g_post + lane;
        const bf16_t* ob = U + (size_t)m * LDU + C_H + 4 * lane;
        f32x4 v[4]; float s = 0.f;
#pragma unroll
        for (int j = 0; j < 4; ++j) { v[j] = ld4bf(ob + 256 * j); s += (v[j].x * v[j].x + v[j].y * v[j].y) + (v[j].z * v[j].z + v[j].w * v[j].w); }
        const float rstd = 1.f / sqrtf(wave_sum(s) * (1.f / DM) + EPS);
#pragma unroll
        for (int j = 0; j < 4; ++j) { const f32x4 ov = xr[64 * j] + v[j] * rstd * gr[64 * j]; if (!dry) orow[64 * j] = ov; }
    }
}

#define XB_TMO      128
#define XB_XCNT(j)  (256  + 64 * (j))
#define XB_XSUB(j)  (1280 + 64 * (j))
#define XB_XGEN(j)  (2304 + 64 * (j))
#define XB_TOP      3328
#define XB_TOPGEN   3392
#define XCD_BAR_WORDS 3456
#define XB_SPIN_CAP (1u << 22)
constexpr size_t WS_BAR = 46 * MiB;
__device__ __forceinline__ unsigned xb_ld(unsigned* p)              { return __hip_atomic_load(p, __ATOMIC_RELAXED, __HIP_MEMORY_SCOPE_AGENT); }
__device__ __forceinline__ unsigned xb_add(unsigned* p, unsigned v) { return __hip_atomic_fetch_add(p, v, __ATOMIC_RELAXED, __HIP_MEMORY_SCOPE_AGENT); }
__device__ __forceinline__ unsigned xb_xcc_id() { return (unsigned)__builtin_amdgcn_s_getreg((3 << 11) | 20) & 0xFu; }
#define XB_SPIN(cond, bar) do { unsigned _sp = 0; while (cond) { __builtin_amdgcn_s_sleep(1); \
    if ((++_sp & 255u) == 0u) { if (xb_ld(&(bar)[XB_TMO])) break; if (_sp > XB_SPIN_CAP) { atomicAdd(&(bar)[XB_TMO], 1u); break; } } } } while (0)
struct XcdBarrier { unsigned* bar; unsigned x; volatile LAS unsigned* st; };
__device__ __forceinline__ XcdBarrier xcd_barrier_post(unsigned* bar, volatile LAS unsigned* st) {
    XcdBarrier b; b.bar = bar; b.x = xb_xcc_id(); b.st = st;
    if (threadIdx.x == 0) (void)xb_add(&bar[XB_XCNT(b.x)], 1u);
    return b;
}
__device__ __forceinline__ void xcd_barrier_complete(unsigned* bar, unsigned x, unsigned& nloc, unsigned& nx) {
    const unsigned G = gridDim.x * gridDim.y * gridDim.z;
    unsigned sum, cnt, mine, sp = 0u;
    for (;;) {
        sum = 0u; cnt = 0u; mine = 0u;
#pragma unroll
        for (unsigned j = 0; j < 16; ++j) { const unsigned c = xb_ld(&bar[XB_XCNT(j)]); sum += c; cnt += (c > 0u) ? 1u : 0u; mine = (j == x) ? c : mine; }
        if (sum == G) break;
        __builtin_amdgcn_s_sleep(1);
        if ((++sp & 255u) == 0u) { if (xb_ld(&bar[XB_TMO])) break; if (sp > XB_SPIN_CAP) { atomicAdd(&bar[XB_TMO], 1u); break; } }
    }
    nloc = mine > 0u ? mine : 1u; nx = cnt > 0u ? cnt : 1u;
}
__device__ __forceinline__ void xcd_barrier(const XcdBarrier& b) {
    asm volatile("s_waitcnt vmcnt(0)" ::: "memory");
    __syncthreads();
    if (threadIdx.x == 0) {
        unsigned* bar = b.bar;
        __builtin_amdgcn_s_waitcnt(0);
        unsigned nloc = b.st[0], nx = b.st[1];
        if (nloc == 0u) { xcd_barrier_complete(bar, b.x, nloc, nx); b.st[0] = nloc; b.st[1] = nx; }
        const unsigned old = xb_add(&bar[XB_XSUB(b.x)], 1u);
        const unsigned gen = old / nloc;
        if (old + 1u == (gen + 1u) * nloc) {
            __builtin_amdgcn_fence(__ATOMIC_RELEASE, "agent");
            asm volatile("s_waitcnt vmcnt(0)" ::: "memory");
            const unsigned og = xb_add(&bar[XB_TOP], 1u);
            const unsigned tg = og / nx;
            if (og + 1u == (tg + 1u) * nx) xb_add(&bar[XB_TOPGEN], 1u);
            else XB_SPIN(xb_ld(&bar[XB_TOPGEN]) == tg, bar);
            __builtin_amdgcn_fence(__ATOMIC_ACQUIRE, "agent");
            xb_add(&bar[XB_XGEN(b.x)], 1u);
            asm volatile("s_waitcnt vmcnt(0)" ::: "memory");
        } else {
            XB_SPIN(xb_ld(&bar[XB_XGEN(b.x)]) == gen, bar);
            __builtin_amdgcn_fence(__ATOMIC_ACQUIRE, "agent");
            asm volatile("s_waitcnt vmcnt(0)" ::: "memory");
        }
    }
    __syncthreads();
}

constexpr size_t WS_PART = WS_BAR + 64 * 1024;
#define XB_PCNT(pm) (XCD_BAR_WORDS + 16 * (pm))
#define XCD_BAR_WORDS_ALL (XCD_BAR_WORDS + 16 * 64)
struct EpiFinal { static constexpr bool PERM = true, CHAIN = false;
    const float* x; const float* g; float* out; float* part; unsigned* bar; unsigned char* lds;
    __device__ __forceinline__ void operator()(f32x4 (&acc)[2][2][4][2], const pg8::Unit& u, int wr, int wc, int fr, int fq) const {
        float* red = (float*)(lds + 131072); float* rs = red + 1024;
        const int t = threadIdx.x;
#pragma unroll
        for (int ai = 0; ai < 2; ++ai)
#pragma unroll
            for (int m = 0; m < 4; ++m) { float s = 0.f;
#pragma unroll
                for (int bj = 0; bj < 2; ++bj)
#pragma unroll
                    for (int n = 0; n < 2; ++n) { const f32x4 v = acc[ai][bj][m][n]; s += (v[0] * v[0] + v[1] * v[1]) + (v[2] * v[2] + v[3] * v[3]); }
                { const auto r16 = __builtin_amdgcn_permlane16_swap(__float_as_uint(s), __float_as_uint(s), false, false); s = __uint_as_float(r16[0]) + __uint_as_float(r16[1]); }
                s = xhalf_sum(s);
                if (fq == 0) red[wc * 256 + ai * 128 + wr * 64 + m * 16 + fr] = s; }
        __syncthreads();
        if (t < 256) { typedef __attribute__((address_space(1))) unsigned long long gu64_t; gu64_t* G = (gu64_t*)(unsigned long long)(size_t)part;
            const float mine = (red[t] + red[256 + t]) + (red[512 + t] + red[768 + t]);
            __hip_atomic_store(G + (size_t)u.pn * MTOK + u.pm * 256 + t, (1ull << 32) | (unsigned long long)__float_as_uint(mine), __ATOMIC_RELAXED, __HIP_MEMORY_SCOPE_AGENT);
            float q4[4]; unsigned spins = 0u;
            for (;;) { bool ok = true;
#pragma unroll
                for (int k = 0; k < 4; ++k) { const unsigned long long xg = __hip_atomic_load(G + (size_t)k * MTOK + u.pm * 256 + t, __ATOMIC_RELAXED, __HIP_MEMORY_SCOPE_AGENT); q4[k] = __uint_as_float((unsigned)xg); ok = ok && (xg >> 32) == 1ull; }
                if (__all(ok)) break;
                __builtin_amdgcn_s_sleep(1);
                if ((++spins & 255u) == 0u) { if (xb_ld(&bar[XB_TMO])) break; if (spins > XB_SPIN_CAP) { atomicAdd(&bar[XB_TMO], 1u); break; } } }
            rs[t] = 1.f / sqrtf(((q4[0] + q4[1]) + (q4[2] + q4[3])) * (1.f / DM) + EPS); }
        __syncthreads();
        f32x4 gv[2][2];
#pragma unroll
        for (int bj = 0; bj < 2; ++bj) { const float* gq = g + u.pn * 256 + bj * 128 + wc * 32 + 8 * fq; gv[bj][0] = *(const f32x4*)gq; gv[bj][1] = *(const f32x4*)(gq + 4); }
#pragma unroll
        for (int ai = 0; ai < 2; ++ai) {
            f32x4 X[4][2][2];
#pragma unroll
            for (int m = 0; m < 4; ++m) { const size_t ro = (size_t)(u.pm * 256 + ai * 128 + wr * 64 + m * 16 + fr) * DM;
#pragma unroll
                for (int bj = 0; bj < 2; ++bj) { const int col = u.pn * 256 + bj * 128 + wc * 32 + 8 * fq; X[m][bj][0] = *(const f32x4*)(x + ro + col); X[m][bj][1] = *(const f32x4*)(x + ro + col + 4); } }
#pragma unroll
            for (int m = 0; m < 4; ++m) { const int rl = ai * 128 + wr * 64 + m * 16 + fr; const float rstd = rs[rl]; const size_t ro = (size_t)(u.pm * 256 + rl) * DM;
#pragma unroll
                for (int bj = 0; bj < 2; ++bj) { const int col = u.pn * 256 + bj * 128 + wc * 32 + 8 * fq;
                    *(f32x4*)(out + ro + col) = X[m][bj][0] + acc[ai][bj][m][0] * rstd * gv[bj][0]; *(f32x4*)(out + ro + col + 4) = X[m][bj][1] + acc[ai][bj][m][1] * rstd * gv[bj][1]; } } }
    }
};

constexpr int NPHASE = 9;
constexpr int LDS_BYTES = 152 * 1024;
#ifndef USE_PG8
#define USE_PG8 1
#endif
__device__ __forceinline__ void run_phase(const Params& p, int ph, int bid, int nb, unsigned char* lds, bool dry = false) {
    bf16_t* U = Uptr(p); const bf16_t* WT = (const bf16_t*)(p.ws + WS_WTALL);
    bf16_t* S2 = (bf16_t*)p.out; float* oraw = p.out;
    PG8_LAS unsigned char* lds3 = (PG8_LAS unsigned char*)lds;
    switch (ph) {
    case 0: phase_prep(p, bid, nb, lds, 0); break;
    case 1: { OpStoreBf16 o1{U, LDU, 1024}; OpStoreBf16 o2{(bf16_t*)(p.ws + WS_MKV), 2048, 0};
#if USE_PG8
              pg8::Sched S{}; S.j[0] = pg8::Job{U + C_H, WT, MTOK / 256, N1 / 256}; S.j[1] = pg8::Job{(const bf16_t*)p.out, (const bf16_t*)(p.ws + WS_WTMKV), MMEM / 256, 2048 / 256};
              S.njobs = 2; S.rep = 1; S.G = nb; S.c = bid; S.lda = LDU; S.astride = 0; S.bstride = 0;
              { const int nun = (MTOK / 256) * (N1 / 256) + (MMEM / 256) * (2048 / 256), extra = nun % nb;
                if (extra == 0) phase_prep(p, bid, nb, lds, 1); else if (bid >= extra) phase_prep(p, bid - extra, nb - extra, lds, 1);
                __syncthreads(); }
              pg8::Epi<SelP1> E{SelP1{o1, o2}}; pg8::gemm_phase<pg8::Epi<SelP1>, true>(lds3, S, E);
#else
              gemm_simple(U + C_H, LDU, WT, MTOK, N1, DM, o1, bid, nb); gemm_simple((const bf16_t*)p.out, LDU, (const bf16_t*)(p.ws + WS_WTMKV), MMEM, 2048, DM, o2, bid, nb); phase_prep(p, bid, nb, lds, 1);
#endif
            } break;
#if !defined(DSA_REF) && !defined(GLA_REF)
    case 2: {
#pragma unroll 1
        for (int r_ = 0; r_ < 2; ++r_) { if (((r_ ^ bid) & 1) == 0) phase_gla_g1(p, bid, nb, lds, dry); else phase_dsa_select2(p, bid, nb, lds); } } break;
    case 3: {
#pragma unroll 1
        for (int r_ = 0; r_ < 2; ++r_) { if (((r_ ^ bid) & 1) == 0) phase_gla_g2(p, bid, nb, lds, dry); else phase_dsa_attend4(p, bid, nb, lds, dry); } } break;
#elif !defined(DSA_REF)
    case 2: phase_gla_rec(p, oraw, bid, nb, lds); phase_dsa_select(p, bid, nb, lds); break;
    case 3: phase_gla_norm(p, oraw, bid, nb); phase_dsa_attend(p, bid, nb, lds, dry); break;
#else
    case 2: phase_gla_rec(p, oraw, bid, nb, lds); break;
    case 3: phase_gla_norm(p, oraw, bid, nb); phase_dsa_ref(p, bid, nb, lds); break;
#endif
#ifndef CROSS_REF
    case 4:
#ifndef GLA_REF
        {
#pragma unroll 1
          for (int r_ = 0; r_ < 2; ++r_) { if (((r_ ^ bid) & 1) == 0) phase_gla_g3(p, bid, nb, lds, dry); else phase_cross_attend(p, bid, nb, lds, dry); } }
#else
        phase_cross_attend(p, bid, nb, lds, dry);
#endif
        break;
#else
    case 4: phase_cross_ref(p, bid, nb, lds); break;
#endif
    case 5: { OpZGate oz{U, dry}; OpSig os{S2, U};
#if USE_PG8
              pg8::Sched S{}; S.j[0] = pg8::Job{U + C_H, WT + (size_t)WT_Z * DM, MTOK / 256, 3072 / 256}; S.j[1] = pg8::Job{U + C_H, WT + (size_t)WT_G * DM, MTOK / 256, 3072 / 256};
              S.njobs = 2; S.rep = 1; S.G = nb; S.c = bid; S.lda = LDU; S.astride = 0; S.bstride = 0; S.alt = 1;
              EpiP5 E{oz, os}; pg8::gemm_phase<EpiP5, true>(lds3, S, E);
#else
              gemm_simple(U + C_H, LDU, WT + (size_t)WT_Z * DM, MTOK, 3072, DM, oz, bid, nb); gemm_simple(U + C_H, LDU, WT + (size_t)WT_G * DM, MTOK, 3072, DM, os, bid, nb);
#endif
            } break;
    case 6: {
#if USE_PG8
              pg8::Sched S{}; S.j[0] = pg8::Job{U + C_GV, (const bf16_t*)(p.ws + WS_WTGO), MTOK / 256, DM / 256};
              S.njobs = 1; S.rep = 3; S.G = nb; S.c = bid; S.lda = LDU; S.astride = 1024; S.bstride = (long)(WS_WTDO - WS_WTGO) / 2;
              EpiP6 E{S2, U}; pg8::gemm_phase<EpiP6, true>(lds3, S, E);
#else
              gemm_simple(U + C_GV, LDU, (const bf16_t*)(p.ws + WS_WTGO), MTOK, DM, DM, m0, bid, nb);
              gemm_simple(U + C_DQ, LDU, (const bf16_t*)(p.ws + WS_WTDO), MTOK, DM, DM, m1, bid, nb);
              gemm_simple(U + C_XQ, LDU, (const bf16_t*)(p.ws + WS_WTXO), MTOK, DM, DM, m2, bid, nb);
#endif
            } break;
    case 7: { OpStoreBf16 oo{U, LDU, C_H};
#if USE_PG8
              pg8::Sched S{}; S.j[0] = pg8::Job{U + C_MG, (const bf16_t*)(p.ws + WS_WTO), MTOK / 256, DM / 256};
              S.njobs = 1; S.rep = 1; S.G = nb; S.c = bid; S.lda = LDU; S.astride = 0; S.bstride = 0;
              pg8::Epi<SelP7> E{SelP7{oo}}; pg8::gemm_phase<pg8::Epi<SelP7>, false>(lds3, S, E);
#else
              gemm_simple(U + C_MG, LDU, (const bf16_t*)(p.ws + WS_WTO), MTOK, DM, DM, oo, bid, nb);
#endif
            } break;
    case 8: phase_final(p, bid, nb, dry); break;
    case 9: { pg8::Sched S{}; S.j[0] = pg8::Job{U + C_MG, (const bf16_t*)(p.ws + WS_WTO), MTOK / 256, DM / 256};
              S.njobs = 1; S.rep = 1; S.G = nb; S.c = bid; S.lda = LDU; S.astride = 0; S.bstride = 0;
              EpiFinal E{p.x, p.g_post, p.out, (float*)(p.ws + WS_PART), (unsigned*)(p.ws + WS_BAR), lds}; pg8::gemm_phase<EpiFinal, true>(lds3, S, E); } break;
    }
}

#if ONE_LAUNCH
__global__ void __launch_bounds__(NTHREADS) fwd_mega(Params p) {
    extern __shared__ __attribute__((aligned(16))) unsigned char lds[];
    cg::grid_group grid = cg::this_grid();
    const int bid = blockIdx.x, nb = gridDim.x;
    volatile LAS unsigned* xst = (volatile LAS unsigned*)((LAS unsigned char*)lds + LDS_BYTES - 16);
    unsigned* barw = (unsigned*)(p.ws + WS_BAR);
    if (threadIdx.x < 4) xst[threadIdx.x] = 0u;
    { typedef __attribute__((address_space(1))) unsigned long long gu64_t; gu64_t* G = (gu64_t*)(unsigned long long)(size_t)(p.ws + WS_PART);
      for (int e = bid * NTHREADS + threadIdx.x; e < 4 * MTOK; e += nb * NTHREADS) __hip_atomic_store(G + e, 0ull, __ATOMIC_RELAXED, __HIP_MEMORY_SCOPE_AGENT); }
    __syncthreads();
    if (p.ws == nullptr) grid.sync();
    const XcdBarrier xbar = xcd_barrier_post(barw, xst);
#ifdef PROF_PHASE
#define PROF_DUP(k) if (PROF_PHASE == (k)) { run_phase(p, (k), bid, nb, lds, p.g_pre != nullptr); GSYNC(); } \
    if (PROF_PHASE == 10 * (k) + 0) { const bool dry_ = p.g_pre != nullptr; if ((k) == 2) phase_gla_g1(p, bid, nb, lds, dry_); if ((k) == 3) phase_gla_g2(p, bid, nb, lds, dry_); if ((k) == 4) phase_gla_g3(p, bid, nb, lds, dry_); GSYNC(); } \
    if (PROF_PHASE == 10 * (k) + 1) { const bool dry_ = p.g_pre != nullptr; if ((k) == 2) phase_dsa_select2(p, bid, nb, lds); if ((k) == 3) phase_dsa_attend4(p, bid, nb, lds, dry_); if ((k) == 4) phase_cross_attend(p, bid, nb, lds, dry_); GSYNC(); }
#else
#define PROF_DUP(k)
#endif
#define GSYNC() xcd_barrier(xbar)
#if defined(PROF_PHASE) && PROF_PHASE >= 100
    unsigned long long ts_[10]; int nts_ = 0;
#define STAMP() do { ts_[nts_++] = __builtin_amdgcn_s_memrealtime(); } while (0)
#else
#define STAMP() do {} while (0)
#endif
    STAMP();
    PROF_DUP(0) run_phase(p, 0, bid, nb, lds); GSYNC(); STAMP();
    PROF_DUP(1) run_phase(p, 1, bid, nb, lds); GSYNC(); STAMP();
    PROF_DUP(2) run_phase(p, 2, bid, nb, lds); GSYNC(); STAMP();
    PROF_DUP(3) run_phase(p, 3, bid, nb, lds); GSYNC(); STAMP();
    PROF_DUP(4) run_phase(p, 4, bid, nb, lds); GSYNC(); STAMP();
    PROF_DUP(5) run_phase(p, 5, bid, nb, lds); GSYNC(); STAMP();
    PROF_DUP(6) run_phase(p, 6, bid, nb, lds); GSYNC(); STAMP();
    if (nb == (MTOK / 256) * (DM / 256)) { run_phase(p, 9, bid, nb, lds); STAMP(); }
    else {
    PROF_DUP(7) run_phase(p, 7, bid, nb, lds); GSYNC(); STAMP();
    PROF_DUP(8) run_phase(p, 8, bid, nb, lds);
    }
#if defined(PROF_PHASE) && PROF_PHASE >= 100
    GSYNC(); STAMP();
    if (bid == 0 && threadIdx.x == 0) { const int k_ = PROF_PHASE - 100; const float us_ = (PROF_PHASE == 200) ? (float)(ts_[9] - ts_[0]) * 0.01f * 0.2f : (float)(ts_[k_ + 1] - ts_[k_]) * 0.01f; p.out[0] = us_ * 0.2f; }
#endif
#undef GSYNC
}
#else
template <int PH> __global__ void __launch_bounds__(NTHREADS) fwd_phase(Params p) {
    extern __shared__ __attribute__((aligned(16))) unsigned char lds[];
    run_phase(p, PH, blockIdx.x, gridDim.x, lds);
}
#endif

extern "C" void kernel_launch(void* const* d_in, const int* in_sizes, int n_in, void* d_out, int out_size, void* d_ws, size_t ws_size, hipStream_t stream) {
    if (n_in != 15 || out_size != MTOK * DM || ws_size < WS_END) { fprintf(stderr, "kernel_launch: unexpected shapes (n_in %d out %d ws %zu)\n", n_in, out_size, ws_size); return; }
    Params p{};
    p.x = (const float*)d_in[0]; p.mem = (const float*)d_in[1]; p.g_pre = (const float*)d_in[2]; p.g_post = (const float*)d_in[3]; p.g_mem = (const float*)d_in[4];
    p.w_in = (const float*)d_in[5]; p.w_a_up = (const float*)d_in[6]; p.b_a = (const float*)d_in[7]; p.g_gla = (const float*)d_in[8]; p.rel_bias = (const float*)d_in[9];
    p.w_mem_kv = (const float*)d_in[10]; p.w_gla_out = (const float*)d_in[11]; p.w_dsa_out = (const float*)d_in[12]; p.w_x_out = (const float*)d_in[13]; p.w_o = (const float*)d_in[14];
    p.out = (float*)d_out; p.ws = (unsigned char*)d_ws;
#if ONE_LAUNCH
    static int grid_blocks = 0;
    if (!grid_blocks) {
        int dev = 0, cus = 0, per_cu = 0;
        hipGetDevice(&dev); hipDeviceGetAttribute(&cus, hipDeviceAttributeMultiprocessorCount, dev);
        hipFuncSetAttribute((const void*)fwd_mega, hipFuncAttributeMaxDynamicSharedMemorySize, LDS_BYTES);
        hipOccupancyMaxActiveBlocksPerMultiprocessor(&per_cu, (const void*)fwd_mega, NTHREADS, LDS_BYTES);
        if (per_cu < 1) per_cu = 1;
        grid_blocks = cus * per_cu;
    }
    (void)hipMemsetAsync((unsigned char*)d_ws + WS_BAR, 0, XCD_BAR_WORDS_ALL * 4, stream);
    void* args[] = {&p};
    hipError_t e = hipLaunchCooperativeKernel((void*)fwd_mega, dim3(grid_blocks), dim3(NTHREADS), args, LDS_BYTES, stream);
    if (e != hipSuccess) fprintf(stderr, "cooperative launch failed: %s (grid %d)\n", hipGetErrorString(e), grid_blocks);
#else
    const int G = 1024;
    static bool attr_done = false;
#define LAUNCH(PH) do { if (!attr_done) (void)hipFuncSetAttribute((const void*)fwd_phase<PH>, hipFuncAttributeMaxDynamicSharedMemorySize, LDS_BYTES); hipLaunchKernelGGL(fwd_phase<PH>, dim3(G), dim3(NTHREADS), LDS_BYTES, stream, p); } while (0)
    LAUNCH(0); LAUNCH(1); LAUNCH(2); LAUNCH(3); LAUNCH(4); LAUNCH(5); LAUNCH(6); LAUNCH(7); LAUNCH(8);
    attr_done = true;
#undef LAUNCH
#endif
}
```
